# Optimizing an MI355X kernel written in HIP

```python
import jax, jax.numpy as jnp
from jax import lax
import numpy as np

D_MODEL = 2048
BATCH = 2
SEQ = 4096
DEPTH = 1

CHUNK = 64
D_MIX = D_MODEL
D_CONV = D_MIX // 2
CONV_GROUPS = 16
D_RWKV = D_MIX - D_CONV
RWKV_HEAD = 64
N_RWKV_HEADS = D_RWKV // RWKV_HEAD
CONV_WIDTH = 31
D_DECAY_LORA = 64
D_AAA_LORA = 64
D_GATE_LORA = 160
N_GROUPS = 4
EXPERTS_PER_GROUP = 8
N_EXPERTS = N_GROUPS * EXPERTS_PER_GROUP
TOP_K = 2
D_EXPERT = 512
MOE_BLOCK = 128
RMS_EPS = 1e-6
LN_EPS = 1e-5
GN_EPS = 64e-5
D_IN = 2 * D_CONV + 3 * D_RWKV + D_DECAY_LORA + D_AAA_LORA + D_GATE_LORA
D_SHIFT = D_IN - 2 * D_CONV

kernel_name = 'hybrid_conformer_rwkv7_hmoe_block'


def rms_norm(x, g):
    xf = x.astype(jnp.float32)
    y = xf * lax.rsqrt(jnp.mean(xf * xf, axis=-1, keepdims=True) + RMS_EPS)
    return (y * g.astype(jnp.float32)).astype(x.dtype)


def layer_norm(u, g, b):
    uf = u.astype(jnp.float32)
    mu = jnp.mean(uf, axis=-1, keepdims=True)
    var = jnp.mean(jnp.square(uf - mu), axis=-1, keepdims=True)
    y = (uf - mu) * lax.rsqrt(var + LN_EPS) * g.astype(jnp.float32) + b.astype(jnp.float32)
    return y.astype(u.dtype)


def prev_frame(u):
    return jnp.pad(u, ((0, 0), (1, 0), (0, 0)))[:, :-1]


def conformer_conv(val, gate, dw, bias, ln_g, ln_b):
    u = val * jax.nn.sigmoid(gate)
    u = lax.conv_general_dilated(
        u, dw[:, None, :].astype(u.dtype), window_strides=(1,),
        padding=[(CONV_WIDTH - 1, 0)], dimension_numbers=('NWC', 'WIO', 'NWC'),
        feature_group_count=D_CONV) + bias
    u = layer_norm(u, ln_g, ln_b)
    return jax.nn.silu(u)


def rwkv7_scan(r, decay, k, v, a, b):
    B, T, H, N = r.shape
    def step(S, inp):
        rt, wt, kt, vt, at, bt = inp
        sa = jnp.einsum('bhvk,bhk->bhv', S, at)
        S = S * wt[:, :, None, :] + sa[..., None] * bt[:, :, None, :] + vt[..., None] * kt[:, :, None, :]
        return S, jnp.einsum('bhvk,bhk->bhv', S, rt)
    S0 = jnp.zeros((B, H, N, N), jnp.float32)
    xs = tuple(jnp.moveaxis(t, 1, 0) for t in (r, decay, k, v, a, b))
    _, y = lax.scan(step, S0, xs)
    return jnp.moveaxis(y, 0, 1)


def rwkv7_time_mix(proj, mu, w0, w_up, a0, a_up, g_up, k_k, k_a, r_k, gn_g, gn_b):
    B, T, _ = proj.shape
    f32 = jnp.float32
    proj = proj + (prev_frame(proj) - proj) * mu
    o1, o2, o3 = D_RWKV, 2 * D_RWKV, 3 * D_RWKV
    r, k, v, wd, ad, gd = jnp.split(
        proj, [o1, o2, o3, o3 + D_DECAY_LORA, o3 + D_DECAY_LORA + D_AAA_LORA], axis=-1)
    w = -jax.nn.softplus(-(w0 + jnp.tanh(wd) @ w_up)) - 0.5
    decay = jnp.exp(-jnp.exp(w.astype(f32)))
    a = jax.nn.sigmoid(a0 + ad @ a_up).astype(f32)
    g = jax.nn.sigmoid(gd) @ g_up
    heads = lambda t: t.astype(f32).reshape(B, T, N_RWKV_HEADS, RWKV_HEAD)
    kk = heads(k * k_k)
    kk = kk / jnp.maximum(jnp.sqrt(jnp.sum(kk * kk, axis=-1, keepdims=True)), 1e-12)
    k = k.astype(f32) * (1.0 + (a - 1.0) * k_a.astype(f32))
    rh, kh, vh, ah, wh = heads(r), heads(k), heads(v), heads(a), heads(decay)
    y = rwkv7_scan(rh, wh, kh, vh, -kk, kk * ah)
    mu_y = jnp.mean(y, axis=-1, keepdims=True)
    var_y = jnp.mean(jnp.square(y - mu_y), axis=-1, keepdims=True)
    y = ((y - mu_y) * lax.rsqrt(var_y + GN_EPS)).reshape(B, T, D_RWKV)
    y = y * gn_g.astype(f32) + gn_b.astype(f32)
    bonus = jnp.sum(rh * kh * r_k.astype(f32), axis=-1, keepdims=True) * vh
    y = y + bonus.reshape(B, T, D_RWKV)
    return (y * g.astype(f32)).astype(proj.dtype)


def hierarchical_moe(h, rg_w, rg_b, re_w, re_b, w_gate, w_up, w_down):
    B, T, D = h.shape
    xt = h.reshape(-1, D)
    NT = xt.shape[0]
    xf = xt.astype(jnp.float32)
    g_logits = xf @ rg_w.astype(jnp.float32) + rg_b.astype(jnp.float32)
    g_prob = jax.nn.softmax(g_logits, axis=-1)
    grp = jnp.argmax(g_logits, axis=-1)
    p_grp = jnp.take_along_axis(g_prob, grp[:, None], axis=-1)
    e_logits = (xf @ re_w.astype(jnp.float32) + re_b.astype(jnp.float32))
    e_logits = e_logits.reshape(NT, N_GROUPS, EXPERTS_PER_GROUP)
    e_logits = jnp.take_along_axis(e_logits, grp[:, None, None], axis=1)[:, 0]
    top_v, top_i = lax.top_k(e_logits, TOP_K)
    gates = p_grp * jax.nn.softmax(top_v, axis=-1)
    expert_id = (grp[:, None] * EXPERTS_PER_GROUP + top_i).astype(jnp.int32)

    A = NT * TOP_K
    flat_e = expert_id.reshape(-1)
    flat_tok = jnp.repeat(jnp.arange(NT, dtype=jnp.int32), TOP_K)
    flat_gate = gates.reshape(-1)
    order = jnp.argsort(flat_e)
    se, stok, sgate = flat_e[order], flat_tok[order], flat_gate[order]
    counts = jnp.zeros((N_EXPERTS,), jnp.int32).at[flat_e].add(1)
    starts = jnp.cumsum(counts) - counts
    padded = (counts + MOE_BLOCK - 1) // MOE_BLOCK * MOE_BLOCK
    pend = jnp.cumsum(padded)
    pstarts = pend - padded
    dest = pstarts[se] + (jnp.arange(A, dtype=jnp.int32) - starts[se])
    n_blocks = (A + N_EXPERTS * (MOE_BLOCK - 1) + MOE_BLOCK - 1) // MOE_BLOCK
    P = n_blocks * MOE_BLOCK
    slot_tok = jnp.full((P,), NT, jnp.int32).at[dest].set(stok)
    slot_gate = jnp.zeros((P,), jnp.float32).at[dest].set(sgate)
    block_e = jnp.minimum(
        jnp.searchsorted(pend, jnp.arange(n_blocks, dtype=jnp.int32) * MOE_BLOCK, side='right'),
        N_EXPERTS - 1)
    x_pad = jnp.concatenate([xt, jnp.zeros((1, D), xt.dtype)], axis=0)
    xb = x_pad[slot_tok].reshape(n_blocks, MOE_BLOCK, D)

    def expert_block(args):
        xblk, e = args
        hid = jax.nn.silu(xblk @ w_gate[e]) * (xblk @ w_up[e])
        return hid @ w_down[e]

    yb = lax.map(expert_block, (xb, block_e))
    y = yb.reshape(P, D) * slot_gate[:, None].astype(yb.dtype)
    out = jnp.zeros((NT + 1, D), yb.dtype).at[slot_tok].add(y)[:NT]
    return out.reshape(B, T, D).astype(h.dtype)


def setup_inputs(seed: int = 0) -> dict:
    key = jax.random.key(seed)
    ks = jax.random.split(key, 28)
    f32 = jnp.float32
    L = DEPTH
    def nrm(k, shape, scale):
        return jax.random.normal(k, shape, f32) * scale
    return {
        'x': nrm(ks[0], (BATCH, SEQ, D_MODEL), 1.0),
        'norm_mix': 1.0 + nrm(ks[1], (L, D_MODEL), 0.02),
        'w_in': nrm(ks[2], (L, D_MODEL, D_IN), D_MODEL ** -0.5),
        'conv_dw': nrm(ks[3], (L, CONV_WIDTH, D_CONV), CONV_WIDTH ** -0.5),
        'conv_b': nrm(ks[4], (L, D_CONV), 0.02),
        'conv_ln_g': 1.0 + nrm(ks[5], (L, D_CONV), 0.02),
        'conv_ln_b': nrm(ks[6], (L, D_CONV), 0.02),
        'shift_mu': jax.random.uniform(ks[7], (L, D_SHIFT), f32),
        'w0': -1.0 + nrm(ks[8], (L, D_RWKV), 0.5),
        'w_lora_up': nrm(ks[9], (L, D_DECAY_LORA, D_RWKV), 0.1 * D_DECAY_LORA ** -0.5),
        'a0': nrm(ks[10], (L, D_RWKV), 0.5),
        'a_lora_up': nrm(ks[11], (L, D_AAA_LORA, D_RWKV), 0.1 * D_AAA_LORA ** -0.5),
        'g_lora_up': nrm(ks[12], (L, D_GATE_LORA, D_RWKV), D_GATE_LORA ** -0.5),
        'k_k': 0.85 + nrm(ks[13], (L, D_RWKV), 0.05),
        'k_a': 1.0 + nrm(ks[14], (L, D_RWKV), 0.05),
        'r_k': nrm(ks[15], (L, N_RWKV_HEADS, RWKV_HEAD), 0.1),
        'gn_g': 1.0 + nrm(ks[16], (L, D_RWKV), 0.02),
        'gn_b': nrm(ks[17], (L, D_RWKV), 0.02),
        'w_out': nrm(ks[18], (L, D_MIX, D_MODEL), D_MIX ** -0.5),
        'norm_ffn': 1.0 + nrm(ks[19], (L, D_MODEL), 0.02),
        'router_group_w': nrm(ks[20], (L, D_MODEL, N_GROUPS), D_MODEL ** -0.5),
        'router_group_b': nrm(ks[21], (L, N_GROUPS), 0.01),
        'router_expert_w': nrm(ks[22], (L, D_MODEL, N_EXPERTS), D_MODEL ** -0.5),
        'router_expert_b': nrm(ks[23], (L, N_EXPERTS), 0.01),
        'expert_w_gate': nrm(ks[24], (L, N_EXPERTS, D_MODEL, D_EXPERT), D_MODEL ** -0.5),
        'expert_w_up': nrm(ks[25], (L, N_EXPERTS, D_MODEL, D_EXPERT), D_MODEL ** -0.5),
        'expert_w_down': nrm(ks[26], (L, N_EXPERTS, D_EXPERT, D_MODEL), D_EXPERT ** -0.5),
        'norm_final': 1.0 + nrm(ks[27], (D_MODEL,), 0.02),
    }


def reference(x, norm_mix, w_in, conv_dw, conv_b, conv_ln_g, conv_ln_b, shift_mu, w0,
              w_lora_up, a0, a_lora_up, g_lora_up, k_k, k_a, r_k, gn_g, gn_b, w_out,
              norm_ffn, router_group_w, router_group_b, router_expert_w, router_expert_b,
              expert_w_gate, expert_w_up, expert_w_down, norm_final):
    h = x
    for l in range(DEPTH):
        u = rms_norm(h, norm_mix[l])
        proj = u @ w_in[l]
        conv_val = proj[..., :D_CONV]
        conv_gate = proj[..., D_CONV:2 * D_CONV]
        rwkv_cols = proj[..., 2 * D_CONV:]
        y_conv = conformer_conv(conv_val, conv_gate, conv_dw[l], conv_b[l], conv_ln_g[l], conv_ln_b[l])
        y_rwkv = rwkv7_time_mix(rwkv_cols, shift_mu[l], w0[l], w_lora_up[l], a0[l], a_lora_up[l],
                                g_lora_up[l], k_k[l], k_a[l], r_k[l], gn_g[l], gn_b[l])
        mixed = jnp.concatenate([y_conv, y_rwkv], axis=-1)
        h = h + mixed @ w_out[l]
        v = rms_norm(h, norm_ffn[l])
        h = h + hierarchical_moe(v, router_group_w[l], router_group_b[l], router_expert_w[l],
                                 router_expert_b[l], expert_w_gate[l], expert_w_up[l], expert_w_down[l])
    return rms_norm(h, norm_final)
```

```cpp
#include <hip/hip_runtime.h>
#include <cstdio>
#include <cstdint>

constexpr int BATCH = 2, T = 4096, NT = BATCH * T, D = 2048, DIN = 5408, DC = 1024, DR = 1024, NH = 16, HN = 64, CW = 31;
constexpr int DSH = 3360, LW = 64, LA = 64, LG = 160;
constexpr int NE = 32, NG = 4, EPG = 8, DE = 512;
constexpr size_t MiB = 1u << 20;
constexpr size_t WS_U = 0, WS_GLU = 0, WS_G = 0, WS_BONUS = 32, WS_LIST = 0, WS_CNT = 2, WS_EID = 3, WS_GATE = 4;
constexpr size_t WS_PROJ = 64, WS_H = 64, WS_VN = 128, WS_HID = 192;
constexpr size_t WS_MIXED = 240;
constexpr size_t WS_R = 304, WS_W = 336, WS_K = 368, WS_V = 400, WS_A = 432, WS_B = 464, WS_Y2 = 304;
constexpr size_t WS_END = 496;

__device__ __forceinline__ float wave_sum(float v) {
#pragma unroll
    for (int o = 32; o > 0; o >>= 1) v += __shfl_xor(v, o);
    return v;
}
__device__ __forceinline__ float block_sum256(float v, float* red) {
    v = wave_sum(v);
    __syncthreads();
    if ((threadIdx.x & 63) == 0) red[threadIdx.x >> 6] = v;
    __syncthreads();
    return (red[0] + red[1]) + (red[2] + red[3]);
}
__device__ __forceinline__ float sigmoidf_(float x) { return 1.0f / (1.0f + expf(-x)); }

__global__ __launch_bounds__(256) void k_rmsnorm(const float* __restrict__ x, const float* __restrict__ g, float* __restrict__ out) {
    __shared__ float red[4];
    const int m = blockIdx.x, t = threadIdx.x;
    const float4* xr = (const float4*)(x + (size_t)m * D);
    float4 a = xr[t], b = xr[t + 256];
    float s = a.x * a.x + a.y * a.y + a.z * a.z + a.w * a.w + b.x * b.x + b.y * b.y + b.z * b.z + b.w * b.w;
    s = block_sum256(s, red);
    const float rs = rsqrtf(s * (1.0f / D) + 1e-6f);
    const float4* g4 = (const float4*)g;
    float4 ga = g4[t], gb = g4[t + 256];
    float4* o = (float4*)(out + (size_t)m * D);
    o[t] = make_float4(a.x * rs * ga.x, a.y * rs * ga.y, a.z * rs * ga.z, a.w * rs * ga.w);
    o[t + 256] = make_float4(b.x * rs * gb.x, b.y * rs * gb.y, b.z * rs * gb.z, b.w * rs * gb.w);
}

template <int MODE>
__global__ __launch_bounds__(256) void k_gemm(const float* __restrict__ A, int lda, const float* __restrict__ W, const float* __restrict__ W2, int ldw,
                                              float* __restrict__ C, int ldc, const float* __restrict__ Res, int M, int N, int K,
                                              const int* __restrict__ list, const int* __restrict__ cnt, size_t wstride) {
    __shared__ __attribute__((aligned(16))) float sA[32][36];
    __shared__ int srow[32];
    const int tid = threadIdx.x;
    const int n = blockIdx.x * 256 + tid;
    const int m0 = blockIdx.y * 32;
    int Mrows = M;
    if (MODE >= 2) {
        const int e = blockIdx.z;
        Mrows = cnt[e];
        if (m0 >= Mrows) return;
        W += (size_t)e * wstride;
        if (MODE == 2) W2 += (size_t)e * wstride;
        list += (size_t)e * NT;
    }
    if (tid < 32) {
        int r = m0 + tid, id = -1;
        if (r < Mrows) id = (MODE >= 2) ? list[r] : r;
        srow[tid] = id;
    }
    __syncthreads();
    float acc[32], acc2[MODE == 2 ? 32 : 1];
#pragma unroll
    for (int r = 0; r < 32; ++r) acc[r] = 0.f;
    if constexpr (MODE == 2) {
#pragma unroll
        for (int r = 0; r < 32; ++r) acc2[r] = 0.f;
    }
    const int lr = tid >> 3, lk = (tid & 7) * 4;
    const int lid = srow[lr];
    const float* arow = nullptr;
    if (lid >= 0) arow = A + (size_t)((MODE == 2) ? (lid >> 1) : lid) * lda;
    const bool nok = n < N;
    for (int k0 = 0; k0 < K; k0 += 32) {
        float4 av = make_float4(0.f, 0.f, 0.f, 0.f);
        if (arow) av = *(const float4*)(arow + k0 + lk);
        __syncthreads();
        *(float4*)&sA[lr][lk] = av;
        __syncthreads();
#pragma unroll 2
        for (int kk = 0; kk < 32; kk += 4) {
            float w0 = 0.f, w1 = 0.f, w2 = 0.f, w3 = 0.f, u0 = 0.f, u1 = 0.f, u2 = 0.f, u3 = 0.f;
            if (nok) {
                const float* wp = W + (size_t)(k0 + kk) * ldw + n;
                w0 = wp[0]; w1 = wp[ldw]; w2 = wp[2 * (size_t)ldw]; w3 = wp[3 * (size_t)ldw];
                if (MODE == 2) { const float* up = W2 + (size_t)(k0 + kk) * ldw + n; u0 = up[0]; u1 = up[ldw]; u2 = up[2 * (size_t)ldw]; u3 = up[3 * (size_t)ldw]; }
            }
#pragma unroll
            for (int r = 0; r < 32; ++r) {
                const float4 a4 = *(const float4*)&sA[r][kk];
                acc[r] += a4.x * w0 + a4.y * w1 + a4.z * w2 + a4.w * w3;
                if constexpr (MODE == 2) acc2[r] += a4.x * u0 + a4.y * u1 + a4.z * u2 + a4.w * u3;
            }
        }
    }
    if (!nok) return;
#pragma unroll
    for (int r = 0; r < 32; ++r) {
        const int id = srow[r];
        if (id < 0) continue;
        float v = acc[r];
        if (MODE == 1) v += Res[(size_t)id * ldc + n];
        if constexpr (MODE == 2) { const float g = acc[r]; v = g * sigmoidf_(g) * acc2[r]; }
        C[(size_t)id * ldc + n] = v;
    }
}

__global__ __launch_bounds__(256) void k_glu(const float* __restrict__ proj, float* __restrict__ glu) {
    const int m = blockIdx.x;
    const float* p = proj + (size_t)m * DIN;
    for (int c = threadIdx.x; c < DC; c += 256) glu[(size_t)m * DC + c] = p[c] * sigmoidf_(p[DC + c]);
}
__global__ __launch_bounds__(256) void k_conv(const float* __restrict__ glu, const float* __restrict__ dw, const float* __restrict__ cb,
                                              const float* __restrict__ lg, const float* __restrict__ lb, float* __restrict__ mixed) {
    __shared__ float red[4];
    const int m = blockIdx.x, t = m % T, tid = threadIdx.x;
    float y[4];
    float s = 0.f;
#pragma unroll
    for (int i = 0; i < 4; ++i) {
        const int c = tid + 256 * i;
        float acc = cb[c];
        for (int j = 0; j < CW; ++j) {
            const int tt = t - (CW - 1) + j;
            if (tt >= 0) acc += dw[j * DC + c] * glu[(size_t)(m - (CW - 1) + j) * DC + c];
        }
        y[i] = acc; s += acc;
    }
    const float mu = block_sum256(s, red) * (1.0f / DC);
    float q = 0.f;
#pragma unroll
    for (int i = 0; i < 4; ++i) { const float d = y[i] - mu; q += d * d; }
    const float var = block_sum256(q, red) * (1.0f / DC);
    const float rs = rsqrtf(var + 1e-5f);
#pragma unroll
    for (int i = 0; i < 4; ++i) {
        const int c = tid + 256 * i;
        const float z = (y[i] - mu) * rs * lg[c] + lb[c];
        mixed[(size_t)m * D + c] = z * sigmoidf_(z);
    }
}

__global__ __launch_bounds__(256) void k_prep(const float* __restrict__ proj, const float* __restrict__ mu, const float* __restrict__ w0, const float* __restrict__ w_up,
                                              const float* __restrict__ a0, const float* __restrict__ a_up, const float* __restrict__ g_up,
                                              const float* __restrict__ k_k, const float* __restrict__ k_a, const float* __restrict__ r_k,
                                              float* __restrict__ R, float* __restrict__ Wd, float* __restrict__ Kk, float* __restrict__ V,
                                              float* __restrict__ Aa, float* __restrict__ Bb, float* __restrict__ G, float* __restrict__ BON) {
    __shared__ float lo[LW + LA + LG];
    const int m = blockIdx.x, t = m % T, tid = threadIdx.x;
    const float* p = proj + (size_t)m * DIN + 2 * DC;
    const float* pp = p - DIN;
    const bool hasprev = t > 0;
#define SHIFTED(j) (p[(j)] + ((hasprev ? pp[(j)] : 0.f) - p[(j)]) * mu[(j)])
    for (int j = tid; j < LW + LA + LG; j += 256) {
        const float x = SHIFTED(3 * DR + j);
        lo[j] = (j < LW) ? tanhf(x) : (j < LW + LA) ? x : sigmoidf_(x);
    }
    __syncthreads();
#pragma unroll 1
    for (int i = 0; i < 4; ++i) {
        const int c = tid + 256 * i;
        const float r = SHIFTED(c), k = SHIFTED(DR + c), v = SHIFTED(2 * DR + c);
        float wl = w0[c], al = a0[c], g = 0.f;
        for (int j = 0; j < LW; ++j) wl += lo[j] * w_up[j * DR + c];
        for (int j = 0; j < LA; ++j) al += lo[LW + j] * a_up[j * DR + c];
        for (int j = 0; j < LG; ++j) g += lo[LW + LA + j] * g_up[j * DR + c];
        const float nx = -wl;
        const float sp = fmaxf(nx, 0.f) + log1pf(expf(-fabsf(nx)));
        const float wlog = -sp - 0.5f;
        const float decay = expf(-expf(wlog));
        const float a = sigmoidf_(al);
        const float kkc = k * k_k[c];
        const float ss = wave_sum(kkc * kkc);
        const float kk = kkc / fmaxf(sqrtf(ss), 1e-12f);
        const float k2 = k * (1.0f + (a - 1.0f) * k_a[c]);
        const float bs = wave_sum(r * k2 * r_k[c]);
        const size_t o = (size_t)m * DR + c;
        R[o] = r; Wd[o] = decay; Kk[o] = k2; V[o] = v; Aa[o] = -kk; Bb[o] = kk * a; G[o] = g; BON[o] = bs * v;
    }
#undef SHIFTED
}

__global__ __launch_bounds__(64) void k_scan(const float* __restrict__ R, const float* __restrict__ Wd, const float* __restrict__ Kk, float* V,
                                             const float* __restrict__ Aa, const float* __restrict__ Bb) {
    __shared__ __attribute__((aligned(16))) float sh[2][5][64];
    const int bh = blockIdx.x, b = bh >> 4, h = bh & 15, i = threadIdx.x;
    float S[64];
#pragma unroll
    for (int k = 0; k < 64; ++k) S[k] = 0.f;
    const size_t base = (size_t)b * T * DR + h * HN + i;
    float nr = R[base], nw = Wd[base], nk = Kk[base], na = Aa[base], nb = Bb[base], nv = V[base];
    for (int t = 0; t < T; ++t) {
        float* s = &sh[t & 1][0][0];
        s[i] = nr; s[64 + i] = nw; s[128 + i] = nk; s[192 + i] = na; s[256 + i] = nb;
        const float vv = nv;
        const size_t o = base + (size_t)t * DR;
        if (t + 1 < T) { const size_t o2 = o + DR; nr = R[o2]; nw = Wd[o2]; nk = Kk[o2]; na = Aa[o2]; nb = Bb[o2]; nv = V[o2]; }
        __syncthreads();
        float sa = 0.f;
#pragma unroll
        for (int k = 0; k < 64; k += 4) { const float4 a4 = *(const float4*)&s[192 + k]; sa += S[k] * a4.x + S[k + 1] * a4.y + S[k + 2] * a4.z + S[k + 3] * a4.w; }
        float y = 0.f;
#pragma unroll
        for (int k = 0; k < 64; k += 4) {
            const float4 w4 = *(const float4*)&s[64 + k], b4 = *(const float4*)&s[256 + k], k4 = *(const float4*)&s[128 + k], r4 = *(const float4*)&s[k];
            S[k] = S[k] * w4.x + sa * b4.x + vv * k4.x; y += S[k] * r4.x;
            S[k + 1] = S[k + 1] * w4.y + sa * b4.y + vv * k4.y; y += S[k + 1] * r4.y;
            S[k + 2] = S[k + 2] * w4.z + sa * b4.z + vv * k4.z; y += S[k + 2] * r4.z;
            S[k + 3] = S[k + 3] * w4.w + sa * b4.w + vv * k4.w; y += S[k + 3] * r4.w;
        }
        V[o] = y;
    }
}

__global__ __launch_bounds__(256) void k_post(const float* __restrict__ Y, const float* __restrict__ BON, const float* __restrict__ G,
                                              const float* __restrict__ gn_g, const float* __restrict__ gn_b, float* __restrict__ mixed) {
    const int m = blockIdx.x, tid = threadIdx.x;
#pragma unroll
    for (int i = 0; i < 4; ++i) {
        const int c = tid + 256 * i;
        const size_t o = (size_t)m * DR + c;
        const float y = Y[o];
        const float mu = wave_sum(y) * (1.0f / 64.0f);
        const float d = y - mu;
        const float var = wave_sum(d * d) * (1.0f / 64.0f);
        const float yn = d * rsqrtf(var + 64e-5f) * gn_g[c] + gn_b[c];
        mixed[(size_t)m * D + DC + c] = (yn + BON[o]) * G[o];
    }
}

__global__ __launch_bounds__(256) void k_router(const float* __restrict__ h, const float* __restrict__ nf, const float* __restrict__ rgw, const float* __restrict__ rgb,
                                                const float* __restrict__ rew, const float* __restrict__ reb, float* __restrict__ vn,
                                                int* __restrict__ list, int* __restrict__ cnt, float* __restrict__ gate) {
    __shared__ float red[4];
    __shared__ __attribute__((aligned(16))) float sv[D];
    __shared__ float lg[NG + NE];
    const int m = blockIdx.x, t = threadIdx.x;
    const float4* xr = (const float4*)(h + (size_t)m * D);
    float4 a = xr[t], b = xr[t + 256];
    float s = a.x * a.x + a.y * a.y + a.z * a.z + a.w * a.w + b.x * b.x + b.y * b.y + b.z * b.z + b.w * b.w;
    s = block_sum256(s, red);
    const float rs = rsqrtf(s * (1.0f / D) + 1e-6f);
    const float4* g4 = (const float4*)nf;
    float4 ga = g4[t], gb = g4[t + 256];
    float4 va = make_float4(a.x * rs * ga.x, a.y * rs * ga.y, a.z * rs * ga.z, a.w * rs * ga.w);
    float4 vb = make_float4(b.x * rs * gb.x, b.y * rs * gb.y, b.z * rs * gb.z, b.w * rs * gb.w);
    float4* o = (float4*)(vn + (size_t)m * D);
    o[t] = va; o[t + 256] = vb;
    ((float4*)sv)[t] = va; ((float4*)sv)[t + 256] = vb;
    __syncthreads();
    if (t < NG + NE) {
        float acc;
        if (t < NG) { acc = rgb[t]; for (int d = 0; d < D; ++d) acc += sv[d] * rgw[d * NG + t]; }
        else { const int e = t - NG; acc = reb[e]; for (int d = 0; d < D; ++d) acc += sv[d] * rew[d * NE + e]; }
        lg[t] = acc;
    }
    __syncthreads();
    if (t == 0) {
        int grp = 0; float gm = lg[0];
        for (int j = 1; j < NG; ++j) if (lg[j] > gm) { gm = lg[j]; grp = j; }
        float den = 0.f;
        for (int j = 0; j < NG; ++j) den += expf(lg[j] - gm);
        const float pg = 1.0f / den;
        const float* el = lg + NG + grp * EPG;
        int i1 = 0; float v1 = el[0];
        for (int j = 1; j < EPG; ++j) if (el[j] > v1) { v1 = el[j]; i1 = j; }
        int i2 = -1; float v2 = -3.0e38f;
        for (int j = 0; j < EPG; ++j) if (j != i1 && el[j] > v2) { v2 = el[j]; i2 = j; }
        const float e2 = expf(v2 - v1);
        const float g1 = pg / (1.0f + e2), g2 = pg * e2 / (1.0f + e2);
        const int e1id = grp * EPG + i1, e2id = grp * EPG + i2;
        gate[2 * m] = g1; gate[2 * m + 1] = g2;
        int p1 = atomicAdd(&cnt[e1id], 1); list[(size_t)e1id * NT + p1] = 2 * m;
        int p2 = atomicAdd(&cnt[e2id], 1); list[(size_t)e2id * NT + p2] = 2 * m + 1;
    }
}

__global__ __launch_bounds__(256) void k_final(const float* __restrict__ h, const float* __restrict__ y2, const float* __restrict__ gate, const float* __restrict__ nf, float* __restrict__ out) {
    __shared__ float red[4];
    const int m = blockIdx.x, t = threadIdx.x;
    const float g1 = gate[2 * m], g2 = gate[2 * m + 1];
    const float4* hr = (const float4*)(h + (size_t)m * D);
    const float4* y1r = (const float4*)(y2 + (size_t)(2 * m) * D);
    const float4* y2r = (const float4*)(y2 + (size_t)(2 * m + 1) * D);
    float4 v[2]; float s = 0.f;
#pragma unroll
    for (int i = 0; i < 2; ++i) {
        const float4 a = hr[t + 256 * i], p = y1r[t + 256 * i], q = y2r[t + 256 * i];
        v[i] = make_float4(a.x + g1 * p.x + g2 * q.x, a.y + g1 * p.y + g2 * q.y, a.z + g1 * p.z + g2 * q.z, a.w + g1 * p.w + g2 * q.w);
        s += v[i].x * v[i].x + v[i].y * v[i].y + v[i].z * v[i].z + v[i].w * v[i].w;
    }
    s = block_sum256(s, red);
    const float rs = rsqrtf(s * (1.0f / D) + 1e-6f);
    const float4* g4 = (const float4*)nf;
    float4* o = (float4*)(out + (size_t)m * D);
#pragma unroll
    for (int i = 0; i < 2; ++i) { const float4 g = g4[t + 256 * i]; o[t + 256 * i] = make_float4(v[i].x * rs * g.x, v[i].y * rs * g.y, v[i].z * rs * g.z, v[i].w * rs * g.w); }
}

extern "C" void kernel_launch(void* const* d_in, const int* in_sizes, int n_in, void* d_out, int out_size, void* d_ws, size_t ws_size, hipStream_t stream) {
    if (n_in != 28 || in_sizes[0] != NT * D || out_size != NT * D || ws_size < WS_END * MiB) {
        fprintf(stderr, "kernel_launch: unexpected shapes (n_in %d, in0 %d, out %d, ws %zu)\n", n_in, n_in > 0 ? in_sizes[0] : -1, out_size, ws_size);
        return;
    }
    const float* const* in = (const float* const*)d_in;
    char* ws = (char*)d_ws;
    auto F = [&](size_t mib) { return (float*)(ws + mib * MiB); };
    float* out = (float*)d_out;
    k_rmsnorm<<<NT, 256, 0, stream>>>(in[0], in[1], F(WS_U));
    k_gemm<0><<<dim3((DIN + 255) / 256, NT / 32, 1), 256, 0, stream>>>(F(WS_U), D, in[2], nullptr, DIN, F(WS_PROJ), DIN, nullptr, NT, DIN, D, nullptr, nullptr, 0);
    k_glu<<<NT, 256, 0, stream>>>(F(WS_PROJ), F(WS_GLU));
    k_conv<<<NT, 256, 0, stream>>>(F(WS_GLU), in[3], in[4], in[5], in[6], F(WS_MIXED));
    k_prep<<<NT, 256, 0, stream>>>(F(WS_PROJ), in[7], in[8], in[9], in[10], in[11], in[12], in[13], in[14], in[15],
                                   F(WS_R), F(WS_W), F(WS_K), F(WS_V), F(WS_A), F(WS_B), F(WS_G), F(WS_BONUS));
    k_scan<<<BATCH * NH, 64, 0, stream>>>(F(WS_R), F(WS_W), F(WS_K), F(WS_V), F(WS_A), F(WS_B));
    k_post<<<NT, 256, 0, stream>>>(F(WS_V), F(WS_BONUS), F(WS_G), in[16], in[17], F(WS_MIXED));
    k_gemm<1><<<dim3(D / 256, NT / 32, 1), 256, 0, stream>>>(F(WS_MIXED), D, in[18], nullptr, D, F(WS_H), D, in[0], NT, D, D, nullptr, nullptr, 0);
    int* list = (int*)(ws + WS_LIST * MiB); int* cnt = (int*)(ws + WS_CNT * MiB); float* gate = (float*)(ws + WS_GATE * MiB);
    hipMemsetAsync(cnt, 0, NE * sizeof(int), stream);
    k_router<<<NT, 256, 0, stream>>>(F(WS_H), in[19], in[20], in[21], in[22], in[23], F(WS_VN), list, cnt, gate);
    k_gemm<2><<<dim3(DE / 256, NT / 32, NE), 256, 0, stream>>>(F(WS_VN), D, in[24], in[25], DE, F(WS_HID), DE, nullptr, 0, DE, D, list, cnt, (size_t)D * DE);
    k_gemm<3><<<dim3(D / 256, NT / 32, NE), 256, 0, stream>>>(F(WS_HID), DE, in[26], nullptr, D, F(WS_Y2), D, nullptr, 0, D, DE, list, cnt, (size_t)DE * D);
    k_final<<<NT, 256, 0, stream>>>(F(WS_H), F(WS_Y2), gate, in[27], out);
}
```

```cpp
#include <hip/hip_runtime.h>
#include <cstdio>
#include <cstdint>

constexpr int BATCH = 2, T = 4096, NT = BATCH * T, D = 2048, DIN = 5408, DC = 1024, DR = 1024, NH = 16, HN = 64, CW = 31;
constexpr int DSH = 3360, LW = 64, LA = 64, LG = 160;
constexpr int NE = 32, NG = 4, EPG = 8, DE = 512;
constexpr size_t MiB = 1u << 20;
constexpr int LDP = 3584;

__device__ __forceinline__ float wave_sum(float v) {
#pragma unroll
    for (int o = 32; o > 0; o >>= 1) v += __shfl_xor(v, o);
    return v;
}
__device__ __forceinline__ float block_sum256(float v, float* red) {
    v = wave_sum(v);
    __syncthreads();
    if ((threadIdx.x & 63) == 0) red[threadIdx.x >> 6] = v;
    __syncthreads();
    return (red[0] + red[1]) + (red[2] + red[3]);
}
__device__ __forceinline__ float sigmoidf_(float x) { return 1.0f / (1.0f + expf(-x)); }
__device__ __forceinline__ unsigned f2bf_n(float f) { unsigned u = __builtin_bit_cast(unsigned, f); return (u + 0x7fffu + ((u >> 16) & 1u)) >> 16; }

__device__ __forceinline__ int lane_id_fresh() { int l; asm volatile("v_mbcnt_lo_u32_b32 %0, -1, 0\n\tv_mbcnt_hi_u32_b32 %0, -1, %0" : "=v"(l)); return l; }
namespace pg8 {
#define PG8_LAS __attribute__((address_space(3)))
typedef unsigned short bf16_t;
typedef short bf16x8 __attribute__((ext_vector_type(8)));
typedef float f32x4 __attribute__((ext_vector_type(4)));
typedef unsigned u32x4 __attribute__((ext_vector_type(4)));
constexpr int BM = 256, BK = 64, HALF = 128, HTB = HALF * BK * 2  , STAGE_BYTES = 8 * HTB, NXCD = 8, WGM = 8;

__host__ __device__ __forceinline__ int lds_byte(int r, int c) { const int st = (r >> 4) * 2 + (c >> 5), rr = r & 15, cc = c & 31, ob = rr * 64 + cc * 2; return st * 1024 + (ob ^ (((ob >> 9) & 1) << 5)); }
__host__ __device__ __forceinline__ void stage_rc(int b, int& R, int& C) { const int st = b / 1024, sb = b % 1024, swz = sb ^ (((sb >> 9) & 1) << 5); R = (st >> 1) * 16 + swz / 64; C = (st & 1) * 32 + (swz % 64) / 2; }
__host__ __device__ __forceinline__ int perm32(int rho) { const int n = rho >> 4, i = rho & 15; return 8 * (i >> 2) + 4 * n + (i & 3); }

struct Unit { int pm, pn; };
struct Gemm { const bf16_t* A; const bf16_t* Bt; int M, N, K; };

struct StaticOrder {
    int nM, nN, nwg, G, c;
    __host__ __device__ void init(int M, int N, int G_, int c_) { nM = M / BM; nN = N / BM; nwg = nM * nN; G = G_; c = c_; }
    __host__ __device__ bool next(int i, Unit& u) const {
        const long L = (long)i * G + c; if (L >= nwg) return false;
        int wgid = (int)L; { const int q = nwg / NXCD, r = nwg % NXCD, xcd = wgid % NXCD, off = wgid / NXCD; wgid = (xcd < r ? xcd * (q + 1) : r * (q + 1) + (xcd - r) * q) + off; }
        const int nig = WGM * nN, gid = wgid / nig, fm = gid * WGM, gsz = (nM - fm) < WGM ? (nM - fm) : WGM;
        u.pm = fm + ((wgid % nig) % gsz); u.pn = (wgid % nig) / gsz; return true;
    }
    __device__ __forceinline__ void a_ready(const Unit&) const {}
    __device__ __forceinline__ void done(const Unit&) const {}
    __device__ __forceinline__ size_t kofs(const Unit&) const { return 0; }
    __device__ __forceinline__ int ntiles(const Unit&, int nt) const { return nt; }
};
struct LoraOrder : StaticOrder {
    __device__ __forceinline__ size_t kofs(const Unit& u) const { return u.pn < 8 ? 0 : 256; }
    __device__ __forceinline__ int ntiles(const Unit& u, int) const { return u.pn < 8 ? 2 : 4; }
};
__device__ __forceinline__ unsigned cvt_pk_bf16(float lo, float hi) { unsigned r; asm volatile("v_cvt_pk_bf16_f32 %0, %1, %2" : "=v"(r) : "v"(lo), "v"(hi)); return r; }
typedef float f32x2 __attribute__((ext_vector_type(2)));
__device__ __forceinline__ f32x2 gelu_pk(f32x2 v) {
    const f32x2 av = __builtin_elementwise_abs(v), d = av * 0.2316418882f + 1.0f;
    f32x2 t; t.x = __builtin_amdgcn_rcpf(d.x); t.y = __builtin_amdgcn_rcpf(d.y);
    f32x2 q = t * 0.5307027145f + (-0.7265760135f); q = q * t + 0.7107068705f; q = q * t + (-0.142248368f); q = q * t + 0.127414796f; q = q * t;
    const f32x2 s = (v * v) * (-0.72134752044f);
    f32x2 e; e.x = __builtin_amdgcn_exp2f(s.x); e.y = __builtin_amdgcn_exp2f(s.y);
    const f32x2 m = v * (q * e), r = v - m;
    f32x2 o; o.x = v.x < 0.f ? m.x : r.x; o.y = v.y < 0.f ? m.y : r.y; return o;
}

struct EpiF32 {
    static constexpr bool PERM = false, AFTER_DRAIN = false;
    float* C; int ldc; const float* bias;
    template <class U> __device__ __forceinline__ void operator()(const f32x4 (&acc)[2][2][4][2], const U& u, int wr, int wc, int fr, int fq) const {
        const int row0 = u.pm * BM + wr * 64 + fr, col0 = u.pn * BM + wc * 32 + 4 * fq;
        f32x4 bv[2][2];
#pragma unroll
        for (int bj = 0; bj < 2; ++bj)
#pragma unroll
            for (int n = 0; n < 2; ++n) bv[bj][n] = bias ? *(const f32x4*)(bias + col0 + bj * HALF + n * 16) : (f32x4){0.f, 0.f, 0.f, 0.f};
#pragma unroll
        for (int ai = 0; ai < 2; ++ai)
#pragma unroll
            for (int m = 0; m < 4; ++m) { float* rowp = C + (size_t)(row0 + ai * HALF + m * 16) * ldc + col0;
#pragma unroll
                for (int bj = 0; bj < 2; ++bj)
#pragma unroll
                    for (int n = 0; n < 2; ++n) *(f32x4*)(rowp + bj * HALF + n * 16) = acc[ai][bj][m][n] + bv[bj][n]; }
    }
};
struct EpiResF32 {
    static constexpr bool PERM = false, AFTER_DRAIN = false;
    float* C; int ldc; const float* res;
    template <class U> __device__ __forceinline__ void operator()(const f32x4 (&acc)[2][2][4][2], const U& u, int wr, int wc, int fr, int fq) const {
        const int row0 = u.pm * BM + wr * 64 + fr, col0 = u.pn * BM + wc * 32 + 4 * fq;
#pragma unroll
        for (int ai = 0; ai < 2; ++ai)
#pragma unroll
            for (int m = 0; m < 4; ++m) { const size_t off = (size_t)(row0 + ai * HALF + m * 16) * ldc + col0;
#pragma unroll
                for (int bj = 0; bj < 2; ++bj)
#pragma unroll
                    for (int n = 0; n < 2; ++n) *(f32x4*)(C + off + bj * HALF + n * 16) = acc[ai][bj][m][n] + *(const f32x4*)(res + off + bj * HALF + n * 16); }
    }
};
struct EpiResBf16 {
    static constexpr bool PERM = true, AFTER_DRAIN = false;
    bf16_t* O; int ldc; const float* res;
    template <class U> __device__ __forceinline__ void operator()(const f32x4 (&acc)[2][2][4][2], const U& u, int wr, int wc, int fr, int fq) const {
        const int row0 = u.pm * BM + wr * 64 + fr, col0 = u.pn * BM + wc * 32 + 8 * fq;
#pragma unroll
        for (int ai = 0; ai < 2; ++ai)
#pragma unroll
            for (int m = 0; m < 4; ++m) { const size_t off = (size_t)(row0 + ai * HALF + m * 16) * ldc + col0;
#pragma unroll
                for (int bj = 0; bj < 2; ++bj) { const f32x4 v0 = acc[ai][bj][m][0] + __builtin_nontemporal_load((const f32x4*)(res + off + bj * HALF)), v1 = acc[ai][bj][m][1] + __builtin_nontemporal_load((const f32x4*)(res + off + bj * HALF + 4));
                    u32x4 w; w.x = cvt_pk_bf16(v0[0], v0[1]); w.y = cvt_pk_bf16(v0[2], v0[3]); w.z = cvt_pk_bf16(v1[0], v1[1]); w.w = cvt_pk_bf16(v1[2], v1[3]);
                    *(u32x4*)(O + off + bj * HALF) = w; } }
    }
};
template <int ACT  > struct EpiBf16 {
    static constexpr bool PERM = true, AFTER_DRAIN = false;
    bf16_t* O; int ldc; const float* bias; int split_cols; size_t split_stride;
    template <class U> __device__ __forceinline__ void operator()(const f32x4 (&acc)[2][2][4][2], const U& u, int wr, int wc, int fr, int fq) const {
        const int row0 = u.pm * BM + wr * 64 + fr; int colt = u.pn * BM; bf16_t* base = O;
        if (split_cols) { const int t = colt / split_cols; base += (size_t)t * split_stride; colt -= t * split_cols; }
        const int col0 = colt + wc * 32 + 8 * fq, bcol0 = u.pn * BM + wc * 32 + 8 * fq;
        f32x4 bv[2][2];
#pragma unroll
        for (int bj = 0; bj < 2; ++bj)
#pragma unroll
            for (int n = 0; n < 2; ++n) bv[bj][n] = bias ? *(const f32x4*)(bias + bcol0 + bj * HALF + 4 * n) : (f32x4){0.f, 0.f, 0.f, 0.f};
#pragma unroll
        for (int ai = 0; ai < 2; ++ai)
#pragma unroll
            for (int m = 0; m < 4; ++m) { bf16_t* rowp = base + (size_t)(row0 + ai * HALF + m * 16) * ldc + col0;
#pragma unroll
                for (int bj = 0; bj < 2; ++bj) { f32x4 v0 = acc[ai][bj][m][0] + bv[bj][0], v1 = acc[ai][bj][m][1] + bv[bj][1];
                    if (ACT == 1) { f32x2 a = gelu_pk((f32x2){v0[0], v0[1]}), b = gelu_pk((f32x2){v0[2], v0[3]}), c = gelu_pk((f32x2){v1[0], v1[1]}), d = gelu_pk((f32x2){v1[2], v1[3]});
                        v0 = (f32x4){a.x, a.y, b.x, b.y}; v1 = (f32x4){c.x, c.y, d.x, d.y}; }
                    if (ACT == 2) {
#pragma unroll
                        for (int j = 0; j < 4; ++j) { v0[j] = 0.5f * v0[j] * (1.0f + erff(v0[j] * 0.70710678f)); v1[j] = 0.5f * v1[j] * (1.0f + erff(v1[j] * 0.70710678f)); } }
                    u32x4 w; w.x = cvt_pk_bf16(v0[0], v0[1]); w.y = cvt_pk_bf16(v0[2], v0[3]); w.z = cvt_pk_bf16(v1[0], v1[1]); w.w = cvt_pk_bf16(v1[2], v1[3]);
                    *(u32x4*)(rowp + bj * HALF) = w; } }
    }
};

template <class Epi, class Sched, bool STAMP = false>
__device__ __forceinline__ void gemm_phase(PG8_LAS unsigned char* lds, const Gemm g, const Sched& S, const Epi& E, unsigned long long* stamps, int wid) {
    const int lane = lane_id_fresh(), tid = wid * 64 + lane, wr = wid >> 2, wc = wid & 3, fr = lane & 15, fq = lane >> 4;
    const int K = g.K, nt = K / BK;
    int ts_lo = 0, ts_hi = 0, nts = 0; const unsigned long long rt_entry = STAMP ? (unsigned long long)wall_clock64() : 0ull;
#define PG8_STAMP() do { if (STAMP && wid == 0 && nts < 64) { const unsigned long long _c = (unsigned long long)clock64(); \
        ts_lo = (lane == nts) ? (int)(unsigned)_c : ts_lo; ts_hi = (lane == nts) ? (int)(unsigned)(_c >> 32) : ts_hi; ++nts; } } while (0)
    PG8_STAMP();
    unsigned voffA[2], voffB[2];
#pragma unroll
    for (int i = 0; i < 2; ++i) { int R, C; stage_rc(tid * 16 + i * 8192, R, C); const int Rb = Epi::PERM ? ((R & ~31) + perm32(R & 31)) : R;
        voffA[i] = (unsigned)(R * K + C) * 2u; voffB[i] = (unsigned)(Rb * K + C) * 2u; }
    const size_t kstep = (size_t)(BK * 2);
    const size_t hstep = (size_t)HALF * K * 2;
    const size_t tstep = 2 * hstep;
    const unsigned ldsw = (unsigned)wid * 1024u;
    const int aoff = lds_byte(wr * 64 + fr, fq * 8), boff = lds_byte(wc * 32 + fr, fq * 8);
#define PG8_SA(b, h) (((b) * 2 + (h)) * HTB)
#define PG8_SB(b, h) ((4 + (b) * 2 + (h)) * HTB)
#define PG8_STAGE(bufoff, gbase, voff) do { _Pragma("unroll") for (int _i = 0; _i < 2; ++_i) \
        __builtin_amdgcn_global_load_lds((const unsigned*)((const char*)(gbase) + (voff)[_i]), (PG8_LAS unsigned*)(lds + (bufoff) + ldsw + _i * 8192), 16, 0, 0); } while (0)
#define PG8_LDA(dst, b, h) do { _Pragma("unroll") for (int m = 0; m < 4; ++m) _Pragma("unroll") for (int k = 0; k < 2; ++k) dst[m][k] = *(const PG8_LAS bf16x8*)(lds + PG8_SA(b, h) + aoff + m * 2048 + k * 1024); } while (0)
#define PG8_LDB(dst, b, h) do { _Pragma("unroll") for (int n = 0; n < 2; ++n) _Pragma("unroll") for (int k = 0; k < 2; ++k) dst[n][k] = *(const PG8_LAS bf16x8*)(lds + PG8_SB(b, h) + boff + n * 2048 + k * 1024); } while (0)
#define PG8_MMA(ai, bj, At, Bt) do { __builtin_amdgcn_s_setprio(1); _Pragma("unroll") for (int m = 0; m < 4; ++m) _Pragma("unroll") for (int n = 0; n < 2; ++n) _Pragma("unroll") for (int k = 0; k < 2; ++k) \
        acc[ai][bj][m][n] = __builtin_amdgcn_mfma_f32_16x16x32_bf16(Bt[n][k], At[m][k], acc[ai][bj][m][n], 0, 0, 0); __builtin_amdgcn_s_setprio(0); } while (0)
#define PG8_WAIT_V(n) asm volatile("s_waitcnt vmcnt(" #n ")" ::: "memory")
#define PG8_WAIT_L(n) asm volatile("s_waitcnt lgkmcnt(" #n ")" ::: "memory")
#define PG8_BAR __builtin_amdgcn_s_barrier()
#define PG8_SCHED __builtin_amdgcn_sched_barrier(0)
    Unit cur, nxt; int ui = 0;
    if (!S.next(0, cur)) return;
    f32x4 acc[2][2][4][2];
    bf16x8 At[4][2], B0[2][2], B1[2][2];
    const char* cA = (const char*)g.A + (size_t)cur.pm * tstep + S.kofs(cur); const char* cB = (const char*)g.Bt + (size_t)cur.pn * tstep + S.kofs(cur);
    S.a_ready(cur);
    { const char* p0 = cB; const char* p1 = cB + hstep; const char* p2 = cA; const char* p3 = cA + hstep; const char* p4 = cB + kstep; const char* p5 = cA + kstep; const char* p6 = cB + hstep + kstep;
      asm volatile("" : "+s"(p0), "+s"(p1), "+s"(p2), "+s"(p3), "+s"(p4), "+s"(p5), "+s"(p6));
      PG8_STAGE(PG8_SB(0, 0), p0, voffB); PG8_STAGE(PG8_SB(0, 1), p1, voffB); PG8_STAGE(PG8_SA(0, 0), p2, voffA); PG8_STAGE(PG8_SA(0, 1), p3, voffA);
      if (wr == 1) PG8_BAR;
      PG8_WAIT_V(2); PG8_BAR;
      PG8_STAGE(PG8_SB(1, 0), p4, voffB); PG8_STAGE(PG8_SA(1, 0), p5, voffA); PG8_STAGE(PG8_SB(1, 1), p6, voffB);
      PG8_WAIT_V(6); PG8_BAR; }
#pragma unroll
    for (int a = 0; a < 2; ++a)
#pragma unroll
        for (int b = 0; b < 2; ++b)
#pragma unroll
            for (int m = 0; m < 4; ++m)
#pragma unroll
                for (int n = 0; n < 2; ++n) acc[a][b][m][n] = (f32x4){0.f, 0.f, 0.f, 0.f};
    PG8_STAMP();
    for (;;) {
        const bool has_next = S.next(ui + 1, nxt);
        const char* nA = has_next ? (const char*)g.A + (size_t)nxt.pm * tstep + S.kofs(nxt) : cA; const char* nB = has_next ? (const char*)g.Bt + (size_t)nxt.pn * tstep + S.kofs(nxt) : cB;
        const int ntc = S.ntiles(cur, nt);
#pragma unroll 1
        for (int t = 0; t < ntc; t += 2) {
            const bool last = (t == ntc - 2);
            const char* a1 = cA + (size_t)(t + 1) * kstep;
            const char* a2 = last ? nA : cA + (size_t)(t + 2) * kstep; const char* b2 = last ? nB : cB + (size_t)(t + 2) * kstep;
            const char* a3 = a2 + kstep; const char* b3 = b2 + kstep;
            if (last && has_next) S.a_ready(nxt);
            PG8_LDB(B0, 0, 0); PG8_LDB(B1, 0, 1); PG8_SCHED; PG8_LDA(At, 0, 0); PG8_STAGE(PG8_SA(1, 1), a1 + hstep, voffA);
            PG8_WAIT_V(8); PG8_WAIT_L(0); PG8_BAR; PG8_MMA(0, 0, At, B0); PG8_MMA(0, 1, At, B1); PG8_BAR; PG8_SCHED;
            PG8_LDA(At, 0, 1); PG8_STAGE(PG8_SB(0, 0), b2, voffB); PG8_STAGE(PG8_SB(0, 1), b2 + hstep, voffB); PG8_STAGE(PG8_SA(0, 0), a2, voffA);
            PG8_WAIT_V(8); PG8_WAIT_L(0); PG8_BAR; PG8_MMA(1, 0, At, B0); PG8_MMA(1, 1, At, B1); PG8_BAR; PG8_SCHED;
            PG8_LDB(B0, 1, 0); PG8_LDB(B1, 1, 1); PG8_SCHED; PG8_LDA(At, 1, 0); PG8_STAGE(PG8_SA(0, 1), a2 + hstep, voffA);
            PG8_WAIT_V(8); PG8_WAIT_L(0); PG8_BAR; PG8_MMA(0, 0, At, B0); PG8_MMA(0, 1, At, B1); PG8_BAR; PG8_SCHED;
            PG8_LDA(At, 1, 1); PG8_STAGE(PG8_SB(1, 0), b3, voffB); PG8_STAGE(PG8_SB(1, 1), b3 + hstep, voffB); PG8_STAGE(PG8_SA(1, 0), a3, voffA);
            PG8_WAIT_V(8); PG8_WAIT_L(0); PG8_BAR; PG8_MMA(1, 0, At, B0); PG8_MMA(1, 1, At, B1); PG8_BAR; PG8_SCHED;
        }
        PG8_STAMP();
        if (wr == 0) PG8_BAR;
        if constexpr (!Epi::AFTER_DRAIN) { const int l2 = lane_id_fresh(); E(acc, cur, wr, wc, l2 & 15, l2 >> 4); S.done(cur); }
        PG8_STAMP();
        if (!has_next) break;
#pragma unroll
        for (int a = 0; a < 2; ++a)
#pragma unroll
            for (int b = 0; b < 2; ++b)
#pragma unroll
                for (int m = 0; m < 4; ++m)
#pragma unroll
                    for (int n = 0; n < 2; ++n) acc[a][b][m][n] = (f32x4){0.f, 0.f, 0.f, 0.f};
        cur = nxt; cA = nA; cB = nB; ++ui;
        if (wr == 1) PG8_BAR;
    }
    PG8_WAIT_V(0);
    PG8_BAR;
    if constexpr (Epi::AFTER_DRAIN) { E.fused(acc, cur, wr, wc, fr, fq, lds, wid, lane); S.done(cur); }
    PG8_STAMP();
    if (STAMP && wid == 0) { stamps[lane] = lane < nts ? (((unsigned long long)(unsigned)ts_hi << 32) | (unsigned)ts_lo) : 0ull;
        if (lane == 62) stamps[62] = rt_entry; if (lane == 63) stamps[63] = (unsigned long long)wall_clock64(); }
#undef PG8_STAMP
#undef PG8_SA
#undef PG8_SB
#undef PG8_STAGE
#undef PG8_LDA
#undef PG8_LDB
#undef PG8_MMA
#undef PG8_WAIT_V
#undef PG8_WAIT_L
#undef PG8_BAR
#undef PG8_SCHED
}
struct GUnit { int pm, pn; const char* aBase; const char* bBase; const int* rows; int nvalid; };
struct EpiSwiGLU {
    static constexpr bool PERM = false, AFTER_DRAIN = false;
    bf16_t* O; int ldh;
    template <class U> __device__ __forceinline__ void operator()(const f32x4 (&acc)[2][2][4][2], const U& u, int wr, int wc, int fr, int fq) const {
        const int row0 = u.pm * BM + wr * 64 + fr, col0 = u.pn * (BM / 2) + wc * 16 + 4 * fq;
#pragma unroll
        for (int ai = 0; ai < 2; ++ai)
#pragma unroll
            for (int m = 0; m < 4; ++m) { bf16_t* rowp = O + (size_t)(row0 + ai * HALF + m * 16) * ldh + col0;
#pragma unroll
                for (int bj = 0; bj < 2; ++bj) { const f32x4 g = acc[ai][bj][m][0], up = acc[ai][bj][m][1]; f32x4 h;
#pragma unroll
                    for (int j = 0; j < 4; ++j) h[j] = g[j] * __builtin_amdgcn_rcpf(1.0f + __expf(-g[j])) * up[j];
                    typedef unsigned u32x2 __attribute__((ext_vector_type(2))); u32x2 w; w.x = cvt_pk_bf16(h[0], h[1]); w.y = cvt_pk_bf16(h[2], h[3]);
                    *(u32x2*)(rowp + bj * (HALF / 2)) = w; } }
    }
};
struct EpiProj {
    static constexpr bool PERM = false, AFTER_DRAIN = false;
    bf16_t* GLU; bf16_t* P16;
    template <class U> __device__ __forceinline__ void operator()(const f32x4 (&acc)[2][2][4][2], const U& u, int wr, int wc, int fr, int fq) const {
        typedef unsigned u32x2 __attribute__((ext_vector_type(2)));
        const int row0 = u.pm * BM + wr * 64 + fr;
        if (u.pn < 8) {
            const int col0 = u.pn * (BM / 2) + wc * 16 + 4 * fq;
#pragma unroll
            for (int ai = 0; ai < 2; ++ai)
#pragma unroll
                for (int m = 0; m < 4; ++m) { bf16_t* rowp = GLU + (size_t)(row0 + ai * HALF + m * 16) * 1024 + col0;
#pragma unroll
                    for (int bj = 0; bj < 2; ++bj) { const f32x4 v = acc[ai][bj][m][0], g = acc[ai][bj][m][1]; f32x4 h;
#pragma unroll
                        for (int j = 0; j < 4; ++j) h[j] = v[j] * __builtin_amdgcn_rcpf(1.0f + __expf(-g[j]));
                        u32x2 w; w.x = cvt_pk_bf16(h[0], h[1]); w.y = cvt_pk_bf16(h[2], h[3]); *(u32x2*)(rowp + bj * (HALF / 2)) = w; } }
        } else {
            const int col0 = (u.pn - 8) * BM + wc * 32 + 4 * fq;
#pragma unroll
            for (int ai = 0; ai < 2; ++ai)
#pragma unroll
                for (int m = 0; m < 4; ++m) { bf16_t* rowp = P16 + (size_t)(row0 + ai * HALF + m * 16) * 3584 + col0;
#pragma unroll
                    for (int bj = 0; bj < 2; ++bj)
#pragma unroll
                        for (int n = 0; n < 2; ++n) { const f32x4 v = acc[ai][bj][m][n]; u32x2 w; w.x = cvt_pk_bf16(v[0], v[1]); w.y = cvt_pk_bf16(v[2], v[3]); *(u32x2*)(rowp + bj * HALF + n * 16) = w; } }
        }
    }
};
template <bool GATHER, class Epi, class Sched>
__device__ __forceinline__ void gemm_phase_g(PG8_LAS unsigned char* lds, const char* Agather, int K, const Sched& S, const Epi& E, int wid) {
    const int lane = lane_id_fresh(), tid = wid * 64 + lane, wr = wid >> 2, wc = wid & 3, fr = lane & 15, fq = lane >> 4;
    const int nt = K / BK;
    unsigned voffA[2], voffB[2]; int RA[2], CA[2];
#pragma unroll
    for (int i = 0; i < 2; ++i) { int R, C; stage_rc(tid * 16 + i * 8192, R, C); const int Rb = Epi::PERM ? ((R & ~31) + perm32(R & 31)) : R;
        voffA[i] = (unsigned)(R * K + C) * 2u; voffB[i] = (unsigned)(Rb * K + C) * 2u; RA[i] = R; CA[i] = C; }
    const size_t kstep = (size_t)(BK * 2);
    const size_t hstep = (size_t)HALF * K * 2;
    const unsigned ldsw = (unsigned)wid * 1024u;
    const int aoff = lds_byte(wr * 64 + fr, fq * 8), boff = lds_byte(wc * 32 + fr, fq * 8);
#define PG8_SA(b, h) (((b) * 2 + (h)) * HTB)
#define PG8_SB(b, h) ((4 + (b) * 2 + (h)) * HTB)
#define PG8_STAGE(bufoff, gbase, voff) do { _Pragma("unroll") for (int _i = 0; _i < 2; ++_i) \
        __builtin_amdgcn_global_load_lds((const unsigned*)((const char*)(gbase) + (voff)[_i]), (PG8_LAS unsigned*)(lds + (bufoff) + ldsw + _i * 8192), 16, 0, 0); } while (0)
#define PG8_STAGE_A(bufoff, ub, h, OFFS) do { if (GATHER) PG8_STAGE(bufoff, ub, OFFS[h]); else PG8_STAGE(bufoff, (ub) + (h) * hstep, voffA); } while (0)
#define PG8_GOFF(dst, un) do { _Pragma("unroll") for (int _h = 0; _h < 2; ++_h) _Pragma("unroll") for (int _i = 0; _i < 2; ++_i) { const int _r = _h * HALF + RA[_i]; \
        const int _tok = (un).rows[_r < (un).nvalid ? _r : 0]; dst[_h][_i] = (unsigned)(_tok * K + CA[_i]) * 2u; } asm volatile("s_waitcnt vmcnt(0)" ::: "memory"); } while (0)
#define PG8_LDA(dst, b, h) do { _Pragma("unroll") for (int m = 0; m < 4; ++m) _Pragma("unroll") for (int k = 0; k < 2; ++k) dst[m][k] = *(const PG8_LAS bf16x8*)(lds + PG8_SA(b, h) + aoff + m * 2048 + k * 1024); } while (0)
#define PG8_LDB(dst, b, h) do { _Pragma("unroll") for (int n = 0; n < 2; ++n) _Pragma("unroll") for (int k = 0; k < 2; ++k) dst[n][k] = *(const PG8_LAS bf16x8*)(lds + PG8_SB(b, h) + boff + n * 2048 + k * 1024); } while (0)
#define PG8_MMA(ai, bj, At, Bt) do { __builtin_amdgcn_s_setprio(1); _Pragma("unroll") for (int m = 0; m < 4; ++m) _Pragma("unroll") for (int n = 0; n < 2; ++n) _Pragma("unroll") for (int k = 0; k < 2; ++k) \
        acc[ai][bj][m][n] = __builtin_amdgcn_mfma_f32_16x16x32_bf16(Bt[n][k], At[m][k], acc[ai][bj][m][n], 0, 0, 0); __builtin_amdgcn_s_setprio(0); } while (0)
#define PG8_WAIT_V(n) asm volatile("s_waitcnt vmcnt(" #n ")" ::: "memory")
#define PG8_WAIT_L(n) asm volatile("s_waitcnt lgkmcnt(" #n ")" ::: "memory")
#define PG8_BAR __builtin_amdgcn_s_barrier()
#define PG8_SCHED __builtin_amdgcn_sched_barrier(0)
    GUnit cur, nxt; int ui = 0;
    if (!S.next(0, cur)) return;
    f32x4 acc[2][2][4][2];
    bf16x8 At[4][2], B0[2][2], B1[2][2];
    unsigned ga[2][2] = {{0u, 0u}, {0u, 0u}}, nga[2][2] = {{0u, 0u}, {0u, 0u}};
    const char* cA = GATHER ? Agather : cur.aBase; const char* cB = cur.bBase;
    if (GATHER) PG8_GOFF(ga, cur);
    PG8_STAGE(PG8_SB(0, 0), cB, voffB); PG8_STAGE(PG8_SB(0, 1), cB + hstep, voffB); PG8_STAGE_A(PG8_SA(0, 0), cA, 0, ga); PG8_STAGE_A(PG8_SA(0, 1), cA, 1, ga);
    if (wr == 1) PG8_BAR;
    PG8_WAIT_V(2); PG8_BAR;
    PG8_STAGE(PG8_SB(1, 0), cB + kstep, voffB); PG8_STAGE_A(PG8_SA(1, 0), cA + kstep, 0, ga); PG8_STAGE(PG8_SB(1, 1), cB + hstep + kstep, voffB);
    PG8_WAIT_V(6); PG8_BAR;
#pragma unroll
    for (int a = 0; a < 2; ++a)
#pragma unroll
        for (int b = 0; b < 2; ++b)
#pragma unroll
            for (int m = 0; m < 4; ++m)
#pragma unroll
                for (int n = 0; n < 2; ++n) acc[a][b][m][n] = (f32x4){0.f, 0.f, 0.f, 0.f};
    for (;;) {
        const bool has_next = S.next(ui + 1, nxt);
        if (GATHER) { if (has_next) PG8_GOFF(nga, nxt); else {
#pragma unroll
            for (int h = 0; h < 2; ++h)
#pragma unroll
                for (int i = 0; i < 2; ++i) nga[h][i] = ga[h][i]; } }
        const char* nA = GATHER ? Agather : (has_next ? nxt.aBase : cA); const char* nB = has_next ? nxt.bBase : cB;
#pragma unroll 1
        for (int t = 0; t < nt; t += 2) {
            const bool last = (t == nt - 2);
            const char* a1 = cA + (size_t)(t + 1) * kstep;
            const char* a2 = last ? nA : cA + (size_t)(t + 2) * kstep; const char* b2 = last ? nB : cB + (size_t)(t + 2) * kstep;
            const char* a3 = a2 + kstep; const char* b3 = b2 + kstep;
            unsigned o2[2][2];
#pragma unroll
            for (int h = 0; h < 2; ++h)
#pragma unroll
                for (int i = 0; i < 2; ++i) o2[h][i] = last ? nga[h][i] : ga[h][i];
            PG8_LDB(B0, 0, 0); PG8_LDB(B1, 0, 1); PG8_SCHED; PG8_LDA(At, 0, 0); PG8_STAGE_A(PG8_SA(1, 1), a1, 1, ga);
            PG8_WAIT_V(8); PG8_WAIT_L(0); PG8_BAR; PG8_MMA(0, 0, At, B0); PG8_MMA(0, 1, At, B1); PG8_BAR; PG8_SCHED;
            PG8_LDA(At, 0, 1); PG8_STAGE(PG8_SB(0, 0), b2, voffB); PG8_STAGE(PG8_SB(0, 1), b2 + hstep, voffB); PG8_STAGE_A(PG8_SA(0, 0), a2, 0, o2);
            PG8_WAIT_V(8); PG8_WAIT_L(0); PG8_BAR; PG8_MMA(1, 0, At, B0); PG8_MMA(1, 1, At, B1); PG8_BAR; PG8_SCHED;
            PG8_LDB(B0, 1, 0); PG8_LDB(B1, 1, 1); PG8_SCHED; PG8_LDA(At, 1, 0); PG8_STAGE_A(PG8_SA(0, 1), a2, 1, o2);
            PG8_WAIT_V(8); PG8_WAIT_L(0); PG8_BAR; PG8_MMA(0, 0, At, B0); PG8_MMA(0, 1, At, B1); PG8_BAR; PG8_SCHED;
            PG8_LDA(At, 1, 1); PG8_STAGE(PG8_SB(1, 0), b3, voffB); PG8_STAGE(PG8_SB(1, 1), b3 + hstep, voffB); PG8_STAGE_A(PG8_SA(1, 0), a3, 0, o2);
            PG8_WAIT_V(8); PG8_WAIT_L(0); PG8_BAR; PG8_MMA(1, 0, At, B0); PG8_MMA(1, 1, At, B1); PG8_BAR; PG8_SCHED;
        }
        if (wr == 0) PG8_BAR;
        { const int l2 = lane_id_fresh(); E(acc, cur, wr, wc, l2 & 15, l2 >> 4); }
        if (!has_next) break;
#pragma unroll
        for (int a = 0; a < 2; ++a)
#pragma unroll
            for (int b = 0; b < 2; ++b)
#pragma unroll
                for (int m = 0; m < 4; ++m)
#pragma unroll
                    for (int n = 0; n < 2; ++n) acc[a][b][m][n] = (f32x4){0.f, 0.f, 0.f, 0.f};
        cur = nxt; cA = nA; cB = nB; ++ui;
#pragma unroll
        for (int h = 0; h < 2; ++h)
#pragma unroll
            for (int i = 0; i < 2; ++i) ga[h][i] = nga[h][i];
        if (wr == 1) PG8_BAR;
    }
    PG8_WAIT_V(0);
    PG8_BAR;
#undef PG8_SA
#undef PG8_SB
#undef PG8_STAGE
#undef PG8_STAGE_A
#undef PG8_GOFF
#undef PG8_LDA
#undef PG8_LDB
#undef PG8_MMA
#undef PG8_WAIT_V
#undef PG8_WAIT_L
#undef PG8_BAR
#undef PG8_SCHED
}
}


#define XB_TMO      128
#define XB_XCNT(j)  (256  + 64 * (j))
#define XB_XSUB(j)  (1280 + 64 * (j))
#define XB_XGEN(j)  (2304 + 64 * (j))
#define XB_TOP      3328
#define XB_TOPGEN   3392
#define XCD_BAR_WORDS 3456
#define XB_SPIN_CAP (1u << 18)
#define LAS __attribute__((address_space(3)))

__device__ __forceinline__ unsigned xb_ld(unsigned* p)              { return __hip_atomic_load(p, __ATOMIC_RELAXED, __HIP_MEMORY_SCOPE_AGENT); }
__device__ __forceinline__ unsigned xb_add(unsigned* p, unsigned v) { return __hip_atomic_fetch_add(p, v, __ATOMIC_RELAXED, __HIP_MEMORY_SCOPE_AGENT); }
__device__ __forceinline__ unsigned xb_xcc_id() { return (unsigned)__builtin_amdgcn_s_getreg((3 << 11) | 20) & 0xFu; }
#define XB_SPIN(cond, bar) do { unsigned _sp = 0; while (cond) { __builtin_amdgcn_s_sleep(1); \
    if ((++_sp & 255u) == 0u) { if (xb_ld(&(bar)[XB_TMO])) break; if (_sp > XB_SPIN_CAP) { atomicAdd(&(bar)[XB_TMO], 1u); break; } } } } while (0)

struct XcdBarrier {
    unsigned* bar; unsigned x; unsigned w0;
    volatile LAS unsigned* st;
};

__device__ __forceinline__ XcdBarrier xcd_barrier_post(unsigned* bar, volatile LAS unsigned* st) {
    XcdBarrier b; b.bar = bar; b.x = xb_xcc_id(); b.st = st; b.w0 = (__builtin_amdgcn_readfirstlane(threadIdx.x >> 6) == 0) ? 1u : 0u;
    if (threadIdx.x == 0) (void)xb_add(&bar[XB_XCNT(b.x)], 1u);
    return b;
}
__device__ __forceinline__ void xcd_barrier_complete(unsigned* bar, unsigned x, unsigned& nloc, unsigned& nx) {
    const unsigned G = gridDim.x * gridDim.y * gridDim.z;
    unsigned sum, cnt, mine, sp = 0u;
    for (;;) {
        sum = 0u; cnt = 0u; mine = 0u;
#pragma unroll
        for (unsigned j = 0; j < 16; ++j) { const unsigned c = xb_ld(&bar[XB_XCNT(j)]); sum += c; cnt += (c > 0u) ? 1u : 0u; mine = (j == x) ? c : mine; }
        if (sum == G) break;
        __builtin_amdgcn_s_sleep(1);
        if ((++sp & 255u) == 0u) { if (xb_ld(&bar[XB_TMO])) break; if (sp > XB_SPIN_CAP) { atomicAdd(&bar[XB_TMO], 1u); break; } }
    }
    nloc = mine > 0u ? mine : 1u; nx = cnt > 0u ? cnt : 1u;
}

__device__ __forceinline__ void xcd_barrier(const XcdBarrier& b) {
    asm volatile("s_waitcnt vmcnt(0)" ::: "memory");
    __syncthreads();
    if (b.w0 != 0u && lane_id_fresh() == 0) {
        unsigned* bar = b.bar;
        __builtin_amdgcn_s_waitcnt(0);
        unsigned nloc = b.st[0], nx = b.st[1];
        if (nloc == 0u) { xcd_barrier_complete(bar, b.x, nloc, nx); b.st[0] = nloc; b.st[1] = nx; }
        const unsigned old = xb_add(&bar[XB_XSUB(b.x)], 1u);
        const unsigned gen = old / nloc;
        if (old + 1u == (gen + 1u) * nloc) {
            __builtin_amdgcn_fence(__ATOMIC_RELEASE, "agent");
            asm volatile("s_waitcnt vmcnt(0)" ::: "memory");
            const unsigned og = xb_add(&bar[XB_TOP], 1u);
            const unsigned tg = og / nx;
            if (og + 1u == (tg + 1u) * nx) xb_add(&bar[XB_TOPGEN], 1u);
            else XB_SPIN(xb_ld(&bar[XB_TOPGEN]) == tg, bar);
            __builtin_amdgcn_fence(__ATOMIC_ACQUIRE, "agent");
            xb_add(&bar[XB_XGEN(b.x)], 1u);
            asm volatile("s_waitcnt vmcnt(0)" ::: "memory");
        } else {
            XB_SPIN(xb_ld(&bar[XB_XGEN(b.x)]) == gen, bar);
            __builtin_amdgcn_fence(__ATOMIC_ACQUIRE, "agent");
            asm volatile("s_waitcnt vmcnt(0)" ::: "memory");
        }
    }
    __syncthreads();
}


#define GAS __attribute__((address_space(1)))
typedef unsigned short bf16;
typedef unsigned v4u __attribute__((ext_vector_type(4)));
typedef float f32x4 __attribute__((ext_vector_type(4)));
#define LDS_WAIT() asm volatile("s_waitcnt lgkmcnt(0)" ::: "memory")
#define VM_WAIT() asm volatile("s_waitcnt vmcnt(0)" ::: "memory")
__device__ __forceinline__ unsigned f2bf(float f) { unsigned u = __builtin_bit_cast(unsigned, f); return (u + 0x7fffu + ((u >> 16) & 1u)) >> 16; }
__device__ __forceinline__ unsigned pk2(float lo, float hi) { return f2bf(lo) | (f2bf(hi) << 16); }
__device__ __forceinline__ float bf2f(unsigned short b) { return __builtin_bit_cast(float, (unsigned)b << 16); }

constexpr int NWAVES = 8, NTHR = NWAVES * 64;
constexpr int RING_OFF = 0, RING_BYTES = 131072;
constexpr int LDSCTL_OFF = 148480, MISC_OFF = LDSCTL_OFF + 320;
constexpr int LDS_BYTES = LDSCTL_OFF + 1024;
constexpr int DINP = 5632;
constexpr int CW_BAR = 4096;

struct Frame {
    LAS unsigned char* lds;
    volatile LAS unsigned* MISC;
    unsigned* ctl;
    int tid, lane, wave, vcu, G;
};

template <class RowMap>
__device__ __forceinline__ void transpose_item(const float* __restrict__ W, int K, int N, bf16* __restrict__ WT, int ldt, const RowMap& rm, LAS float* scr, int item, int lane) {
    const int nblk = N / 32, kb = item / nblk, nb = item % nblk, k0 = 64 * kb, n0 = 32 * nb;
#pragma unroll 8
    for (int i = 0; i < 32; ++i) { const int kk = 2 * i + (lane >> 5); scr[kk * 33 + (lane & 31)] = __builtin_nontemporal_load(W + (size_t)(k0 + kk) * N + n0 + (lane & 31)); }
    LDS_WAIT(); asm volatile("" ::: "memory");
    const int c = lane & 7;
#pragma unroll
    for (int j = 0; j < 4; ++j) { const int n = (lane >> 3) + 8 * j; const LAS float* s = scr + (8 * c) * 33 + n;
        v4u o; o.x = pk2(s[0 * 33], s[1 * 33]); o.y = pk2(s[2 * 33], s[3 * 33]); o.z = pk2(s[4 * 33], s[5 * 33]); o.w = pk2(s[6 * 33], s[7 * 33]);
        *(v4u*)(WT + (size_t)rm(n0 + n) * ldt + k0 + 8 * c) = o; }
    LDS_WAIT(); asm volatile("" ::: "memory");
}
struct RowId { int off; __device__ __forceinline__ int operator()(int n) const { return off + n; } };

__device__ __forceinline__ float wave_sum_x(float v) {
#pragma unroll
    for (int o = 1; o < 64; o <<= 1) v += __shfl_xor(v, o);
    return v;
}
__device__ __forceinline__ void rms_row_to_bf16(const float* __restrict__ xrow, const float* __restrict__ g, bf16* __restrict__ orow, int lane) {
    const f32x4* xr = (const f32x4*)xrow + lane;
    f32x4 v[8]; float s = 0.f;
#pragma unroll
    for (int j = 0; j < 8; ++j) { v[j] = __builtin_nontemporal_load(xr + 64 * j); s += (v[j].x * v[j].x + v[j].y * v[j].y) + (v[j].z * v[j].z + v[j].w * v[j].w); }
    const float rs = rsqrtf(wave_sum_x(s) * (1.0f / D) + 1e-6f);
    const f32x4* g4 = (const f32x4*)g + lane;
    unsigned long long* o8 = (unsigned long long*)orow + lane;
#pragma unroll
    for (int j = 0; j < 8; ++j) { const f32x4 gg = g4[64 * j];
        o8[64 * j] = (unsigned long long)pk2(v[j].x * rs * gg.x, v[j].y * rs * gg.y) | ((unsigned long long)pk2(v[j].z * rs * gg.z, v[j].w * rs * gg.w) << 32); }
}

struct MoeOrder {
    const LAS int* tp; const int* cnt; const int* list;
    int nN, G, c;
    const char* Abase; size_t a_tile_bytes;
    const char* Bbase; size_t b_exp_bytes, b_tile_bytes;
    __device__ __forceinline__ bool next(int i, pg8::GUnit& u) const {
        const int L0 = i * G + c, total = tp[NE] * nN; if (L0 >= total) return false;
        const int q = total >> 3, r = total & 7, xcd = L0 & 7, off = L0 >> 3;
        const int L = (xcd < r ? xcd * (q + 1) : r * (q + 1) + (xcd - r) * q) + off;
        const int mt = L / nN, pn = L - mt * nN;
        const int e = tp[40 + mt];
        const int lt = mt - tp[e];
        u.pm = mt; u.pn = pn;
        u.aBase = Abase + (size_t)mt * a_tile_bytes;
        u.bBase = Bbase + (size_t)e * b_exp_bytes + (size_t)pn * b_tile_bytes;
        u.rows = list + (size_t)e * NT + lt * 256;
        const int rem = cnt[e] - lt * 256; u.nvalid = rem < 256 ? rem : 256;
        return true;
    }
};
struct RowVG { __device__ __forceinline__ int operator()(int n) const { return n >= 2048 ? n : (n < 1024 ? 32 * (n >> 4) + (n & 15) : 32 * ((n - 1024) >> 4) + 16 + (n & 15)); } };
struct RowGU { int up; __device__ __forceinline__ int operator()(int j) const { return 32 * (j >> 4) + (j & 15) + up; } };

__device__ __forceinline__ void router_token(const float* __restrict__ hrow, const float* __restrict__ nf, const float* __restrict__ rgw, const float* __restrict__ rgb,
                                             const float* __restrict__ rew, const float* __restrict__ reb, bf16* __restrict__ vrow, int m, int lane,
                                             int* __restrict__ cnt, int* __restrict__ list, int* __restrict__ asg_e, int* __restrict__ asg_pos, float* __restrict__ gate) {
    const f32x4* xr = (const f32x4*)hrow + lane;
    float s = 0.f;
#pragma unroll
    for (int j = 0; j < 8; ++j) { const f32x4 t = xr[64 * j]; s += (t.x * t.x + t.y * t.y) + (t.z * t.z + t.w * t.w); }
    const float rs = rsqrtf(wave_sum_x(s) * (1.0f / D) + 1e-6f);
    const f32x4* g4 = (const f32x4*)nf + lane;
    unsigned long long* o8 = (unsigned long long*)vrow + lane;
    float lg[NG + NE];
#pragma unroll
    for (int i = 0; i < NG + NE; ++i) lg[i] = 0.f;
#pragma unroll 1
    for (int j = 0; j < 8; ++j) {
        const f32x4 gg = g4[64 * j], hv = xr[64 * j];
        f32x4 vv; vv.x = hv.x * rs * gg.x; vv.y = hv.y * rs * gg.y; vv.z = hv.z * rs * gg.z; vv.w = hv.w * rs * gg.w;
        o8[64 * j] = (unsigned long long)pk2(vv.x, vv.y) | ((unsigned long long)pk2(vv.z, vv.w) << 32);
        const int d0 = 4 * (lane + 64 * j);
#pragma unroll
        for (int q = 0; q < 4; ++q) {
            const float x = vv[q];
            const f32x4 rg = *(const f32x4*)(rgw + (size_t)(d0 + q) * NG);
            lg[0] += x * rg.x; lg[1] += x * rg.y; lg[2] += x * rg.z; lg[3] += x * rg.w;
            const f32x4* re = (const f32x4*)(rew + (size_t)(d0 + q) * NE);
#pragma unroll
            for (int e4 = 0; e4 < 8; ++e4) { const f32x4 w = re[e4]; lg[4 + 4 * e4] += x * w.x; lg[5 + 4 * e4] += x * w.y; lg[6 + 4 * e4] += x * w.z; lg[7 + 4 * e4] += x * w.w; }
        }
    }
    const float* rgb_o = rgb; const float* reb_o = reb;
    asm volatile("" : "+s"(rgb_o), "+s"(reb_o));
#pragma unroll
    for (int i = 0; i < NG + NE; ++i) lg[i] = wave_sum_x(lg[i]) + (i < NG ? rgb_o[i] : reb_o[i - NG]);
    int grp = 0; float gm = lg[0];
#pragma unroll
    for (int j = 1; j < NG; ++j) if (lg[j] > gm) { gm = lg[j]; grp = j; }
    float den = 0.f;
#pragma unroll
    for (int j = 0; j < NG; ++j) den += expf(lg[j] - gm);
    const float pg = 1.0f / den;
    int i1 = 0, i2 = 0; float v1 = 0.f, v2 = 0.f;
#pragma unroll
    for (int g = 0; g < NG; ++g) {
        int a1 = 0; float w1 = lg[NG + g * EPG];
#pragma unroll
        for (int j = 1; j < EPG; ++j) if (lg[NG + g * EPG + j] > w1) { w1 = lg[NG + g * EPG + j]; a1 = j; }
        int a2 = 0; float w2 = -3.0e38f;
#pragma unroll
        for (int j = 0; j < EPG; ++j) if (j != a1 && lg[NG + g * EPG + j] > w2) { w2 = lg[NG + g * EPG + j]; a2 = j; }
        if (g == 0 || grp == g) { i1 = a1; i2 = a2; v1 = w1; v2 = w2; }
    }
    const float e2 = expf(v2 - v1);
    if (lane == 0) {
        const int ea = grp * EPG + i1, eb = grp * EPG + i2;
        gate[2 * m] = pg / (1.0f + e2); gate[2 * m + 1] = pg * e2 / (1.0f + e2);
        const int pa = atomicAdd(&cnt[ea], 1); list[(size_t)ea * NT + pa] = m; asg_e[2 * m] = ea; asg_pos[2 * m] = pa;
        const int pb = atomicAdd(&cnt[eb], 1); list[(size_t)eb * NT + pb] = m; asg_e[2 * m + 1] = eb; asg_pos[2 * m + 1] = pb;
    }
}
__device__ __forceinline__ void final_token(const bf16* __restrict__ hrow, const bf16* __restrict__ y1, const bf16* __restrict__ y2, float g1, float g2,
                                            const float* __restrict__ nf, float* __restrict__ orow, int lane) {
    f32x4 v[8]; float s = 0.f;
#pragma unroll
    for (int j = 0; j < 4; ++j) {
        const int c = lane + 64 * j;
        const v4u hq = __builtin_nontemporal_load((const v4u*)hrow + c); f32x4 ha, hb;
        ha.x = __builtin_bit_cast(float, hq.x << 16); ha.y = __builtin_bit_cast(float, hq.x & 0xffff0000u); ha.z = __builtin_bit_cast(float, hq.y << 16); ha.w = __builtin_bit_cast(float, hq.y & 0xffff0000u);
        hb.x = __builtin_bit_cast(float, hq.z << 16); hb.y = __builtin_bit_cast(float, hq.z & 0xffff0000u); hb.z = __builtin_bit_cast(float, hq.w << 16); hb.w = __builtin_bit_cast(float, hq.w & 0xffff0000u);
        const v4u a = __builtin_nontemporal_load((const v4u*)y1 + c), b = __builtin_nontemporal_load((const v4u*)y2 + c);
        f32x4 ya, yb, za, zb;
        ya.x = __builtin_bit_cast(float, a.x << 16); ya.y = __builtin_bit_cast(float, a.x & 0xffff0000u); ya.z = __builtin_bit_cast(float, a.y << 16); ya.w = __builtin_bit_cast(float, a.y & 0xffff0000u);
        yb.x = __builtin_bit_cast(float, a.z << 16); yb.y = __builtin_bit_cast(float, a.z & 0xffff0000u); yb.z = __builtin_bit_cast(float, a.w << 16); yb.w = __builtin_bit_cast(float, a.w & 0xffff0000u);
        za.x = __builtin_bit_cast(float, b.x << 16); za.y = __builtin_bit_cast(float, b.x & 0xffff0000u); za.z = __builtin_bit_cast(float, b.y << 16); za.w = __builtin_bit_cast(float, b.y & 0xffff0000u);
        zb.x = __builtin_bit_cast(float, b.z << 16); zb.y = __builtin_bit_cast(float, b.z & 0xffff0000u); zb.z = __builtin_bit_cast(float, b.w << 16); zb.w = __builtin_bit_cast(float, b.w & 0xffff0000u);
        v[2 * j] = ha + g1 * ya + g2 * za; v[2 * j + 1] = hb + g1 * yb + g2 * zb;
        s += (v[2 * j].x * v[2 * j].x + v[2 * j].y * v[2 * j].y) + (v[2 * j].z * v[2 * j].z + v[2 * j].w * v[2 * j].w);
        s += (v[2 * j + 1].x * v[2 * j + 1].x + v[2 * j + 1].y * v[2 * j + 1].y) + (v[2 * j + 1].z * v[2 * j + 1].z + v[2 * j + 1].w * v[2 * j + 1].w);
    }
    const float rs = rsqrtf(wave_sum_x(s) * (1.0f / D) + 1e-6f);
#pragma unroll
    for (int j = 0; j < 4; ++j) {
        const int c = lane + 64 * j;
        const f32x4 ga = ((const f32x4*)nf)[2 * c], gb = ((const f32x4*)nf)[2 * c + 1];
        __builtin_nontemporal_store(v[2 * j] * rs * ga, (f32x4*)orow + 2 * c); __builtin_nontemporal_store(v[2 * j + 1] * rs * gb, (f32x4*)orow + 2 * c + 1);
    }
}
typedef short bf16x8_t __attribute__((ext_vector_type(8)));
typedef float f32x16 __attribute__((ext_vector_type(16)));
constexpr int TS = 144;
constexpr int FS = 68;
constexpr int SX_AT = 0, SX_RT = 9216, SX_BT = 18432, SX_KT = 27648, SX_VT = 36864, SX_BHT = 46080, SX_KHT = 55296,
              SX_AAK = 64512, SX_ARB = 73728, SX_ARK = 82944, SX_WT = 92160, SX_U0T = 101376, SX_AABT = 110592, SX_XU = SX_BT,
              SX_XW = 128000, SX_TOT = 145408, SX_PC = 147456;
static_assert(SX_AABT + 64 * FS * 4 <= SX_XW && SX_XW + 64 * FS * 4 <= SX_TOT && SX_TOT + 2048 <= SX_PC && SX_PC + 256 <= LDSCTL_OFF && 64 * FS * 4 <= 2 * 9216, "scan X LDS map");
constexpr int NUNITS = BATCH * NH * (T / 64);

__device__ __forceinline__ f32x16 mma_nt(const LAS unsigned char* X, int rx, const LAS unsigned char* Y, int ry, f32x16 acc, int lane) {
    const int r = lane & 31, h = lane >> 5;
#pragma unroll
    for (int s = 0; s < 4; ++s) {
        const bf16x8_t a = *(const LAS bf16x8_t*)(X + (rx + r) * TS + (16 * s + 8 * h) * 2);
        const bf16x8_t b = *(const LAS bf16x8_t*)(Y + (ry + r) * TS + (16 * s + 8 * h) * 2);
        acc = __builtin_amdgcn_mfma_f32_32x32x16_bf16(a, b, acc, 0, 0, 0);
    }
    return acc;
}
#define CROW(reg, lane) (((reg) & 3) + 8 * ((reg) >> 2) + 4 * ((lane) >> 5))
__device__ __forceinline__ f32x16 zero16() { f32x16 z;
#pragma unroll
    for (int i = 0; i < 16; ++i) z[i] = 0.f; return z; }

struct PrepIn { const bf16* proj; const bf16* lora; const float* mu; const float* w0; const float* a0; const float* k_k; const float* k_a; const float* r_k; bf16* bonus; bf16* g16; };
__device__ __forceinline__ float wave_sum_dpp(float v) {
    v += __builtin_bit_cast(float, __builtin_amdgcn_update_dpp(0, __builtin_bit_cast(int, v), 0xB1, 0xF, 0xF, true));
    v += __builtin_bit_cast(float, __builtin_amdgcn_update_dpp(0, __builtin_bit_cast(int, v), 0x4E, 0xF, 0xF, true));
    v += __builtin_bit_cast(float, __builtin_amdgcn_update_dpp(0, __builtin_bit_cast(int, v), 0x141, 0xF, 0xF, true));
    v += __builtin_bit_cast(float, __builtin_amdgcn_update_dpp(0, __builtin_bit_cast(int, v), 0x140, 0xF, 0xF, true));
    const int iv = __builtin_bit_cast(int, v);
    const float s0 = __builtin_bit_cast(float, __builtin_amdgcn_readlane(iv, 0)), s1 = __builtin_bit_cast(float, __builtin_amdgcn_readlane(iv, 16));
    const float s2 = __builtin_bit_cast(float, __builtin_amdgcn_readlane(iv, 32)), s3 = __builtin_bit_cast(float, __builtin_amdgcn_readlane(iv, 48));
    return (s0 + s1) + (s2 + s3);
}
__device__ __forceinline__ unsigned cvt_pk(float lo, float hi) { unsigned r; asm volatile("v_cvt_pk_bf16_f32 %0, %1, %2" : "=v"(r) : "v"(lo), "v"(hi)); return r; }
#define LDS_BARRIER() do { asm volatile("s_waitcnt lgkmcnt(0)" ::: "memory"); __builtin_amdgcn_s_barrier(); asm volatile("" ::: "memory"); } while (0)
struct XRaw { unsigned r[9], k[9], v[9], wl[8], al[8]; float par[8]; };
__device__ __forceinline__ void scan_x_load(const PrepIn& P, int u, int w, int lane, XRaw& X) {
    const int bh = u >> 6, c = u & 63, b = bh >> 4, h = bh & 15, tq = w, col = h * HN + lane;
    const size_t mrow0 = (size_t)b * T + (size_t)c * 64 + tq * 8;
    const bf16* pr = P.proj + mrow0 * LDP;
    const bf16* lo = P.lora + mrow0 * 3072;
    const bool hasprev = (c * 64 + tq * 8) > 0;
    const bf16* pp = pr - (hasprev ? LDP : 0);
    X.par[0] = P.mu[col]; X.par[1] = P.mu[DR + col]; X.par[2] = P.mu[2 * DR + col]; X.par[3] = P.w0[col]; X.par[4] = P.a0[col]; X.par[5] = P.k_k[col]; X.par[6] = P.k_a[col]; X.par[7] = P.r_k[col];
    X.r[0] = pp[col]; X.k[0] = pp[DR + col]; X.v[0] = pp[2 * DR + col];
#pragma unroll
    for (int i = 0; i < 8; ++i) {
        const bf16* ri = pr + (size_t)i * LDP; const bf16* li = lo + (size_t)i * 3072;
        X.r[i + 1] = ri[col]; X.k[i + 1] = ri[DR + col]; X.v[i + 1] = ri[2 * DR + col];
        X.wl[i] = li[col]; X.al[i] = li[1024 + col];
    }
}

constexpr int CV_ITEMS = 3 * NE * 256, CV_SCR = 64 * 65 * 4;
static_assert(8 * CV_SCR <= LDSCTL_OFF, "conversion LDS");
struct CvIn { const float* const* in; bf16* WguT; bf16* WdT; };
struct CvRegs { f32x4 v[16]; };
__device__ __forceinline__ void cv_load64(const CvIn& C, int item, int lane, CvRegs& R) {
    const int m = item / (NE * 256), r = item - m * (NE * 256), e = r >> 8, blk = r & 255;
    const int N = (m == 2) ? D : DE, nb = (m == 2) ? 32 : 8, kb = blk / nb, n0 = (blk - kb * nb) * 64;
    const float* W = C.in[24 + m] + (size_t)e * D * DE + (size_t)(64 * kb) * N + n0;
#pragma unroll
    for (int i = 0; i < 16; ++i) R.v[i] = __builtin_nontemporal_load((const f32x4*)(W + (size_t)(4 * i + (lane >> 4)) * N + 4 * (lane & 15)));
}
__device__ __forceinline__ void cv_finish64(const CvIn& C, int item, LAS float* scr, int lane, const CvRegs& R) {
    const int m = item / (NE * 256), r = item - m * (NE * 256), e = r >> 8, blk = r & 255;
    const int K = (m == 2) ? DE : D, nb = (m == 2) ? 32 : 8, kb = blk / nb, n0 = (blk - kb * nb) * 64;
#pragma unroll
    for (int i = 0; i < 16; ++i) { LAS float* d = scr + (4 * i + (lane >> 4)) * 65 + 4 * (lane & 15); d[0] = R.v[i].x; d[1] = R.v[i].y; d[2] = R.v[i].z; d[3] = R.v[i].w; }
    asm volatile("s_waitcnt lgkmcnt(0)" ::: "memory");
    const int c = lane & 7, nl = lane >> 3;
    bf16* WT = (m == 2) ? C.WdT + (size_t)e * D * DE : C.WguT + (size_t)e * 1024 * D;
#pragma unroll
    for (int i = 0; i < 8; ++i) {
        const int n = n0 + 8 * i + nl, row = (m == 2) ? n : 32 * (n >> 4) + (n & 15) + 16 * m;
        const LAS float* sp = scr + (8 * c) * 65 + 8 * i + nl;
        v4u o; o.x = cvt_pk(sp[0], sp[65]); o.y = cvt_pk(sp[2 * 65], sp[3 * 65]); o.z = cvt_pk(sp[4 * 65], sp[5 * 65]); o.w = cvt_pk(sp[6 * 65], sp[7 * 65]);
        __builtin_nontemporal_store(o, (v4u*)(WT + (size_t)row * K + 64 * kb + 8 * c));
    }
    asm volatile("s_waitcnt lgkmcnt(0)" ::: "memory");
}
constexpr int CV_CHUNK = 8;
__device__ __forceinline__ void cv_queue_run(const CvIn& C, unsigned* qword, int lo, int hi, LAS float* scr, int lane, int max_items = 1 << 30) {
    const int per = (hi - lo) >> 3, x0 = (int)(xb_xcc_id() & 7u);
    int done = 0;
    for (int att = 0; att < 8 && done < max_items; ++att) {
        const int sh = (x0 + att) & 7, slo = lo + sh * per, shi = slo + per;
        while (done < max_items) {
            const int want = (max_items - done) < CV_CHUNK ? (max_items - done) : CV_CHUNK;
            unsigned first = 0u;
            if (lane == 0) first = __hip_atomic_fetch_add(qword + 64 * sh, (unsigned)want, __ATOMIC_RELAXED, __HIP_MEMORY_SCOPE_AGENT);
            const int it0 = slo + (int)__builtin_amdgcn_readfirstlane(first);
            if (it0 >= shi) break;
            {
                const int nit = (shi - it0) < want ? (shi - it0) : want;
                CvRegs A, B;
                cv_load64(C, it0, lane, A);
#pragma unroll 1
                for (int i = 0; i < nit; i += 2) {
                    if (i + 1 < nit) cv_load64(C, it0 + i + 1, lane, B);
                    cv_finish64(C, it0 + i, scr, lane, A);
                    if (i + 2 < nit) cv_load64(C, it0 + i + 2, lane, A);
                    if (i + 1 < nit) cv_finish64(C, it0 + i + 1, scr, lane, B);
                }
            }
            done += want;
        }
    }
}
template <int MODE>
__device__ __forceinline__ void scan_x_phase(Frame& F, const PrepIn& P, bf16* __restrict__ QH, bf16* __restrict__ Y0, bf16* __restrict__ Mc, bf16* __restrict__ Nc, int nsx) {
    LAS unsigned char* L = F.lds + RING_OFF;
    const int w = F.wave;
    int u = blockIdx.x;
    if (u >= NUNITS) return;
    XRaw X; scan_x_load(P, u, w, lane_id_fresh(), X);
#pragma unroll 1
    for (; u < NUNITS; u += nsx) {
    const int lane = lane_id_fresh(), tid = w * 64 + lane;
    const int bh = u >> 6, c = u & 63, b = bh >> 4, h = bh & 15;
    const size_t m0 = (size_t)b * T + (size_t)c * 64;
    {
        const int ch = lane, tq = w, col = h * HN + ch;
        const size_t mrow0 = m0 + tq * 8;
        const float mur = X.par[0], muk = X.par[1], muv = X.par[2], w0c = X.par[3], a0c = X.par[4], kkc_ = X.par[5], kac = X.par[6], rkc = X.par[7];
        float cum[8], rr_[8], kk2[8], vv_[8], al_[8], be_[8]; float run = 1.f;
#pragma unroll
        for (int i = 0; i < 8; ++i) {
#define XF(x) __builtin_bit_cast(float, (x) << 16)
            const float cr = XF(X.r[i + 1]), ck = XF(X.k[i + 1]), cv = XF(X.v[i + 1]);
            const bool zp = (i == 0) && (c * 64 + tq * 8 == 0);
            const float pr_ = zp ? 0.f : XF(X.r[i]), pk_ = zp ? 0.f : XF(X.k[i]), pv_ = zp ? 0.f : XF(X.v[i]);
            const float r = cr + (pr_ - cr) * mur, k = ck + (pk_ - ck) * muk, v = cv + (pv_ - cv) * muv;
            const float wl = w0c + XF(X.wl[i]), al = a0c + XF(X.al[i]);
            const float nx = -wl, sp = fmaxf(nx, 0.f) + __logf(1.0f + __expf(-fabsf(nx)));
            const float dec = __expf(-__expf(-sp - 0.5f));
            const float a = __builtin_amdgcn_rcpf(1.0f + __expf(-al));
            const float kkc = k * kkc_;
            const float kk = kkc * __builtin_amdgcn_rsqf(fmaxf(wave_sum_dpp(kkc * kkc), 1e-24f));
            const float k2 = k * (1.0f + (a - 1.0f) * kac);
            const float bs = wave_sum_dpp(r * k2 * rkc);
            *(LAS unsigned short*)(L + SX_WT + tq * 1024 + i * 128 + ch * 2) = (unsigned short)(cvt_pk(bs * v, 0.f) & 0xffffu);
            rr_[i] = r; kk2[i] = k2; vv_[i] = v; al_[i] = -kk; be_[i] = kk * a;
            run *= dec; cum[i] = run;
        }
        if (MODE == 0) { asm volatile("s_waitcnt lgkmcnt(0)" ::: "memory");
            const v4u bo = *(const LAS v4u*)(L + SX_WT + tq * 1024 + lane * 16);
            *(v4u*)(P.bonus + (size_t)u * 4096 + (tq * 8 + (lane >> 3)) * 64 + 8 * (lane & 7)) = bo; }
        { const int un = u + nsx; if (un < NUNITS) scan_x_load(P, un, w, lane, X); }
        LAS float* tot = (LAS float*)(L + SX_TOT);
        tot[tq * 64 + ch] = run;
        LDS_BARRIER();
        float off = 1.f, pc = 1.f;
#pragma unroll
        for (int q = 0; q < 8; ++q) { const float x = tot[q * 64 + ch]; off *= (q < tq) ? x : 1.f; pc *= x; }
        if (tq == 0) ((LAS float*)(L + SX_PC))[ch] = pc;
        unsigned vt[4], bht[4], kht[4]; float atf[8];
#pragma unroll
        for (int i = 0; i < 8; ++i) {
            const float Pp = off * cum[i], Pex = (i == 0) ? off : off * cum[i > 0 ? i - 1 : 0], Pi = __builtin_amdgcn_rcpf(Pp), Pc = pc * Pi;
            const float r = rr_[i], k = kk2[i], v = vv_[i], al = al_[i], be = be_[i];
            const int t = tq * 8 + i;
            atf[i] = al * Pex;
            const unsigned ar = cvt_pk(atf[i], r * Pp), bk = cvt_pk(be * Pi, k * Pi);
            *(LAS unsigned short*)(L + SX_AT + t * TS + ch * 2) = (unsigned short)(ar & 0xffffu);
            *(LAS unsigned short*)(L + SX_RT + t * TS + ch * 2) = (unsigned short)(ar >> 16);
            *(LAS unsigned short*)(L + SX_BT + t * TS + ch * 2) = (unsigned short)(bk & 0xffffu);
            *(LAS unsigned short*)(L + SX_KT + t * TS + ch * 2) = (unsigned short)(bk >> 16);
            if (i & 1) { vt[i >> 1] = cvt_pk(vv_[i - 1], v); bht[i >> 1] = cvt_pk(be_[i - 1] * (pc * __builtin_amdgcn_rcpf(off * cum[i - 1])), be * Pc); kht[i >> 1] = cvt_pk(kk2[i - 1] * (pc * __builtin_amdgcn_rcpf(off * cum[i - 1])), k * Pc); }
        }
        { LAS float* xw = (LAS float*)(L + SX_XW) + ch * FS + tq * 8; *(LAS f32x4*)xw = (f32x4){atf[0], atf[1], atf[2], atf[3]}; *(LAS f32x4*)(xw + 4) = (f32x4){atf[4], atf[5], atf[6], atf[7]}; }
        v4u o; o.x = vt[0]; o.y = vt[1]; o.z = vt[2]; o.w = vt[3]; *(LAS v4u*)(L + SX_VT + ch * TS + tq * 16) = o;
        o.x = bht[0]; o.y = bht[1]; o.z = bht[2]; o.w = bht[3]; *(LAS v4u*)(L + SX_BHT + ch * TS + tq * 16) = o;
        o.x = kht[0]; o.y = kht[1]; o.z = kht[2]; o.w = kht[3]; *(LAS v4u*)(L + SX_KHT + ch * TS + tq * 16) = o;
    }
    LDS_BARRIER();
    if (MODE == 1) continue;
    {
        const int mat = w >> 1, ib = w & 1, r = lane & 31;
        const LAS unsigned char* Xp = L + ((mat < 2) ? SX_AT : SX_RT);
        const LAS unsigned char* Yp = L + ((mat & 1) ? SX_KT : SX_BT);
        const int incl = (mat >= 2) ? 1 : 0;
#pragma unroll
        for (int jb = 0; jb < 2; ++jb) {
            f32x16 acc = zero16();
            if (jb <= ib) acc = mma_nt(Xp, 32 * ib, Yp, 32 * jb, acc, lane);
#pragma unroll
            for (int reg = 0; reg < 16; ++reg) {
                const int t = 32 * ib + CROW(reg, lane), j = 32 * jb + r;
                acc[reg] = (j < t + incl) ? acc[reg] : 0.f;
            }
            if (mat == 0) {
#pragma unroll
                for (int rg = 0; rg < 4; ++rg)
                    *(LAS f32x4*)((LAS float*)(L + SX_AABT) + (32 * jb + r) * FS + 32 * ib + 8 * rg + 4 * (lane >> 5)) = (f32x4){acc[4 * rg], acc[4 * rg + 1], acc[4 * rg + 2], acc[4 * rg + 3]};
            } else {
                LAS unsigned char* dstm = L + (mat == 1 ? SX_AAK : mat == 2 ? SX_ARB : SX_ARK);
#pragma unroll
                for (int reg = 0; reg < 16; reg += 2) { const unsigned pkv = cvt_pk(acc[reg], acc[reg + 1]); const int t = 32 * ib + CROW(reg, lane), j = 32 * jb + r;
                    *(LAS unsigned short*)(dstm + t * TS + j * 2) = (unsigned short)(pkv & 0xffffu); *(LAS unsigned short*)(dstm + (t + 1) * TS + j * 2) = (unsigned short)(pkv >> 16); }
            }
        }
    }
    LDS_BARRIER();
    if (w < 4) {
        const int ib = w >> 1, vb = w & 1, r = lane & 31;
        f32x16 acc = mma_nt(L + SX_AAK, 32 * ib, L + SX_VT, 32 * vb, zero16(), lane);
#pragma unroll
        for (int rg = 0; rg < 4; ++rg)
            *(LAS f32x4*)((LAS float*)(L + SX_XU) + (32 * vb + r) * FS + 32 * ib + 8 * rg + 4 * (lane >> 5)) = (f32x4){acc[4 * rg], acc[4 * rg + 1], acc[4 * rg + 2], acc[4 * rg + 3]};
    } else if (w == 4) {
        const LAS float* ATm = (const LAS float*)(L + SX_AABT);
        const int bb = lane >> 4, j = lane & 15;
        float t[16];
#pragma unroll
        for (int i = 0; i < 16; ++i) t[i] = (i == j) ? 1.f : 0.f;
#pragma unroll
        for (int m = 0; m < 15; ++m) {
            const LAS float* cp = ATm + (16 * bb + m) * FS + 16 * bb;
#pragma unroll
            for (int i4 = (m + 1) / 4; i4 < 4; ++i4) {
                const f32x4 l = *(const LAS f32x4*)(cp + 4 * i4);
                if (4 * i4 + 0 > m) t[4 * i4 + 0] += l.x * t[m];
                if (4 * i4 + 1 > m) t[4 * i4 + 1] += l.y * t[m];
                if (4 * i4 + 2 > m) t[4 * i4 + 2] += l.z * t[m];
                if (4 * i4 + 3 > m) t[4 * i4 + 3] += l.w * t[m];
            }
        }
        LAS float* TBw = (LAS float*)(L + SX_AT) + bb * 320 + j;
#pragma unroll
        for (int i = 0; i < 16; ++i) TBw[i * 20] = t[i];
    }
    LDS_BARRIER();
    {
        const LAS float* AT = (const LAS float*)(L + SX_AABT);
        const LAS float* TB = (const LAS float*)(L + SX_AT);
        LAS float* xb = (LAS float*)(L + (w < 4 ? SX_XW : SX_XU)) + (16 * (w & 3)) * FS;
        const int n = lane & 15, q = lane >> 4;
        LAS float* xcol = xb + n * FS;
#pragma unroll
        for (int b = 0; b < 4; ++b) {
            f32x4 acc0 = (f32x4){0.f, 0.f, 0.f, 0.f}, acc1 = acc0, acc2 = acc0, acc3 = acc0;
#pragma unroll
            for (int k0 = 0; k0 < 16 * b; k0 += 16) {
                const int k = k0 + q;
                const float a0 = AT[k * FS + 16 * b + n], a1 = AT[(k + 4) * FS + 16 * b + n], a2 = AT[(k + 8) * FS + 16 * b + n], a3 = AT[(k + 12) * FS + 16 * b + n];
                const float x0 = xcol[k], x1 = xcol[k + 4], x2 = xcol[k + 8], x3 = xcol[k + 12];
                acc0 = __builtin_amdgcn_mfma_f32_16x16x4f32(a0, x0, acc0, 0, 0, 0); acc1 = __builtin_amdgcn_mfma_f32_16x16x4f32(a1, x1, acc1, 0, 0, 0);
                acc2 = __builtin_amdgcn_mfma_f32_16x16x4f32(a2, x2, acc2, 0, 0, 0); acc3 = __builtin_amdgcn_mfma_f32_16x16x4f32(a3, x3, acc3, 0, 0, 0);
            }
            const f32x4 rhs = *(const LAS f32x4*)(xcol + 16 * b + 4 * q);
            const f32x4 z = (rhs + acc0) + (acc1 + acc2) + acc3;
            const f32x4 tb = *(const LAS f32x4*)(TB + b * 320 + n * 20 + 4 * q);
            f32x4 c = (f32x4){0.f, 0.f, 0.f, 0.f};
            c = __builtin_amdgcn_mfma_f32_16x16x4f32(z.x, tb.x, c, 0, 0, 0); c = __builtin_amdgcn_mfma_f32_16x16x4f32(z.y, tb.y, c, 0, 0, 0);
            c = __builtin_amdgcn_mfma_f32_16x16x4f32(z.z, tb.z, c, 0, 0, 0); c = __builtin_amdgcn_mfma_f32_16x16x4f32(z.w, tb.w, c, 0, 0, 0);
            LAS float* xo = xb + (4 * q) * FS + 16 * b + n;
            xo[0] = c.x; xo[FS] = c.y; xo[2 * FS] = c.z; xo[3 * FS] = c.w;
        }
        LAS unsigned char* dst = L + (w < 4 ? SX_WT : SX_U0T) + (16 * (w & 3) + n) * TS + q * 32;
        const f32x4 p0 = *(const LAS f32x4*)(xcol + 16 * q), p1 = *(const LAS f32x4*)(xcol + 16 * q + 4), p2 = *(const LAS f32x4*)(xcol + 16 * q + 8), p3 = *(const LAS f32x4*)(xcol + 16 * q + 12);
        v4u o; o.x = cvt_pk(p0.x, p0.y); o.y = cvt_pk(p0.z, p0.w); o.z = cvt_pk(p1.x, p1.y); o.w = cvt_pk(p1.z, p1.w); *(LAS v4u*)dst = o;
        o.x = cvt_pk(p2.x, p2.y); o.y = cvt_pk(p2.z, p2.w); o.z = cvt_pk(p3.x, p3.y); o.w = cvt_pk(p3.z, p3.w); *(LAS v4u*)(dst + 16) = o;
    }
    LDS_BARRIER();
    if (MODE == 2) continue;
    asm volatile("" :: "v"(X.r[0]), "v"(X.r[1]), "v"(X.r[2]), "v"(X.r[3]), "v"(X.r[4]), "v"(X.r[5]), "v"(X.r[6]), "v"(X.r[7]), "v"(X.r[8]), "v"(X.k[0]), "v"(X.k[1]), "v"(X.k[2]), "v"(X.k[3]), "v"(X.k[4]), "v"(X.k[5]), "v"(X.k[6]), "v"(X.k[7]), "v"(X.k[8]));
    asm volatile("" :: "v"(X.v[0]), "v"(X.v[1]), "v"(X.v[2]), "v"(X.v[3]), "v"(X.v[4]), "v"(X.v[5]), "v"(X.v[6]), "v"(X.v[7]), "v"(X.v[8]), "v"(X.wl[0]), "v"(X.wl[1]), "v"(X.wl[2]), "v"(X.wl[3]), "v"(X.wl[4]), "v"(X.wl[5]), "v"(X.wl[6]), "v"(X.wl[7]));
    asm volatile("" :: "v"(X.al[0]), "v"(X.al[1]), "v"(X.al[2]), "v"(X.al[3]), "v"(X.al[4]), "v"(X.al[5]), "v"(X.al[6]), "v"(X.al[7]));
    {
        const int mat = w >> 1, ib = w & 1, r = lane & 31;
        LAS float* stg = (LAS float*)(L + (w == 0 ? SX_AT : w == 1 ? SX_AAK : w == 2 ? SX_BT : w == 3 ? SX_KT : SX_AABT + (w - 4) * 8704));
        const LAS unsigned char* XA = L + (mat < 2 ? SX_ARB : SX_BHT);
        const LAS unsigned char* YA = L + ((mat & 1) ? SX_U0T : SX_WT);
        const LAS unsigned char* XB = L + (mat < 2 ? SX_ARK : SX_KHT);
#pragma unroll
        for (int jb = 0; jb < 2; ++jb) {
            f32x16 acc = mma_nt(XA, 32 * ib, YA, 32 * jb, zero16(), lane);
            if (mat & 1) acc = mma_nt(XB, 32 * ib, L + SX_VT, 32 * jb, acc, lane);
#pragma unroll
            for (int reg = 0; reg < 16; ++reg) stg[CROW(reg, lane) * FS + 32 * jb + r] = acc[reg];
        }
        asm volatile("s_waitcnt lgkmcnt(0)" ::: "memory");
        if (MODE != 0) { if (stg[lane] == 123.456f) ((LAS float*)(L + SX_TOT))[lane] = 1.f; }
        else {
            bf16* O = (mat == 0 ? QH : mat == 1 ? Y0 : mat == 2 ? Mc : Nc) + (size_t)u * 4096 + (32 * ib) * 64 + 8 * (lane & 7);
            f32x4 a[4], b[4]; v4u rt[4]; float pcv[4];
#pragma unroll
            for (int it = 0; it < 4; ++it) { const int rl = 8 * it + (lane >> 3);
                a[it] = *(const LAS f32x4*)(stg + rl * FS + 8 * (lane & 7)); b[it] = *(const LAS f32x4*)(stg + rl * FS + 8 * (lane & 7) + 4);
                rt[it] = *(const LAS v4u*)(L + SX_RT + (32 * ib + rl) * TS + 16 * (lane & 7)); pcv[it] = ((const LAS float*)(L + SX_PC))[32 * ib + rl]; }
#pragma unroll
            for (int it = 0; it < 4; ++it) { const int rl = 8 * it + (lane >> 3);
                f32x4 x = a[it], y = b[it];
                if (mat == 0) { x.x += __builtin_bit_cast(float, rt[it].x << 16); x.y += __builtin_bit_cast(float, rt[it].x & 0xffff0000u); x.z += __builtin_bit_cast(float, rt[it].y << 16); x.w += __builtin_bit_cast(float, rt[it].y & 0xffff0000u);
                                y.x += __builtin_bit_cast(float, rt[it].z << 16); y.y += __builtin_bit_cast(float, rt[it].z & 0xffff0000u); y.z += __builtin_bit_cast(float, rt[it].w << 16); y.w += __builtin_bit_cast(float, rt[it].w & 0xffff0000u); }
                if (mat == 2) { const int d = 32 * ib + rl - 8 * (lane & 7); const float p = pcv[it];
                    x.x += (d == 0) ? p : 0.f; x.y += (d == 1) ? p : 0.f; x.z += (d == 2) ? p : 0.f; x.w += (d == 3) ? p : 0.f;
                    y.x += (d == 4) ? p : 0.f; y.y += (d == 5) ? p : 0.f; y.z += (d == 6) ? p : 0.f; y.w += (d == 7) ? p : 0.f; }
                v4u o; o.x = cvt_pk(x.x, x.y); o.y = cvt_pk(x.z, x.w); o.z = cvt_pk(y.x, y.y); o.w = cvt_pk(y.z, y.w);
                *(v4u*)(O + rl * 64) = o; }
        }
    }
    LDS_BARRIER();
    }
}

constexpr int SY_M = 0, SY_S = 64 * 65 * 4, SY_P = SY_S + 64 * FS * 4;
__device__ __forceinline__ void scan_y_chain(Frame& F, int bh, const float* __restrict__ Mc, const float* __restrict__ Nc, float* __restrict__ SS) {
    LAS unsigned char* L = F.lds + RING_OFF;
    LAS float* Ms = (LAS float*)(L + SY_M); LAS float* Ss = (LAS float*)(L + SY_S); LAS float* Ps = (LAS float*)(L + SY_P);
    const int tid = F.tid, lane = F.lane, w = F.wave, r = lane & 31, hh = lane >> 5;
    const int tile = w & 3, ti = tile >> 1, tj = tile & 1, kh = w >> 2;
    f32x16 S = zero16();
    for (int i = tid; i < 64 * FS; i += NTHR) Ss[i] = 0.f;
    f32x4 mA, mB; f32x16 nn = zero16();
    { const float* Mg = Mc + (size_t)(bh * 64) * 4096; mA = *(const f32x4*)(Mg + tid * 8); mB = *(const f32x4*)(Mg + tid * 8 + 4);
      if (kh == 0) { const float* Ng = Nc + (size_t)(bh * 64) * 4096;
#pragma unroll
          for (int reg = 0; reg < 16; ++reg) nn[reg] = Ng[(32 * ti + CROW(reg, lane)) * 64 + 32 * tj + r]; } }
    for (int c = 0; c < 64; ++c) {
        const size_t u = (size_t)bh * 64 + c;
        { const int e0 = tid * 8, row = e0 >> 6, col = e0 & 63; LAS float* d = Ms + row * 65 + col;
          d[0] = mA.x; d[1] = mA.y; d[2] = mA.z; d[3] = mA.w; d[4] = mB.x; d[5] = mB.y; d[6] = mB.z; d[7] = mB.w; }
        const f32x16 ncur = nn;
        if (kh == 0) {
#pragma unroll
            for (int reg = 0; reg < 16; ++reg) SS[u * 4096 + (32 * ti + CROW(reg, lane)) * 64 + 32 * tj + r] = S[reg];
        }
        if (c + 1 < 64) {
            const float* Mg = Mc + (u + 1) * 4096; mA = *(const f32x4*)(Mg + tid * 8); mB = *(const f32x4*)(Mg + tid * 8 + 4);
            if (kh == 0) { const float* Ng = Nc + (u + 1) * 4096;
#pragma unroll
                for (int reg = 0; reg < 16; ++reg) nn[reg] = Ng[(32 * ti + CROW(reg, lane)) * 64 + 32 * tj + r]; }
        }
        __syncthreads();
        f32x16 acc = zero16();
#pragma unroll
        for (int s = 0; s < 16; ++s) {
            const int k = 32 * kh + 2 * s + hh;
            acc = __builtin_amdgcn_mfma_f32_32x32x2f32(Ms[(32 * ti + r) * 65 + k], Ss[k * FS + 32 * tj + r], acc, 0, 0, 0);
        }
        if (kh == 1) {
#pragma unroll
            for (int reg = 0; reg < 16; ++reg) Ps[(tile * 16 + reg) * 64 + lane] = acc[reg];
        }
        __syncthreads();
        if (kh == 0) {
#pragma unroll
            for (int reg = 0; reg < 16; ++reg) { S[reg] = acc[reg] + Ps[(tile * 16 + reg) * 64 + lane] + ncur[reg]; Ss[(32 * ti + CROW(reg, lane)) * FS + 32 * tj + r] = S[reg]; }
        }
    }
    __syncthreads();
}

constexpr int SY4_MB = 64 * 65 * 4, SY4_SB = 64 * 17 * 4, SY4_M = 0, SY4_S = 2 * SY4_MB;
__device__ __forceinline__ void scan_y_chain4(Frame& F, int job, const bf16* __restrict__ Mc, const bf16* __restrict__ Nc, bf16* __restrict__ SS) {
    LAS unsigned char* L = F.lds + RING_OFF;
    const int tid = F.tid, lane = F.lane, w = F.wave, bh = job >> 2, cq = job & 3;
    const int li = lane & 15, lq = lane >> 4;
    const size_t u0 = (size_t)bh * 64;
    for (int i = tid; i < 64 * 17; i += NTHR) ((LAS float*)(L + SY4_S))[i] = 0.f;
    if (w >= 4) {
        const int lt = tid - 256, row = (16 * lt) >> 6, col = (16 * lt) & 63;
        v4u a[2], b[2];
#pragma unroll
        for (int q = 0; q < 2; ++q) { a[q] = *(const v4u*)(Mc + u0 * 4096 + 16 * lt + 8 * q); b[q] = *(const v4u*)(Mc + (u0 + 1) * 4096 + 16 * lt + 8 * q); }
#define SY4_PUT(d, r) do { _Pragma("unroll") for (int q = 0; q < 2; ++q) { \
            (d)[8 * q] = __builtin_bit_cast(float, (r)[q].x << 16); (d)[8 * q + 1] = __builtin_bit_cast(float, (r)[q].x & 0xffff0000u); (d)[8 * q + 2] = __builtin_bit_cast(float, (r)[q].y << 16); (d)[8 * q + 3] = __builtin_bit_cast(float, (r)[q].y & 0xffff0000u); \
            (d)[8 * q + 4] = __builtin_bit_cast(float, (r)[q].z << 16); (d)[8 * q + 5] = __builtin_bit_cast(float, (r)[q].z & 0xffff0000u); (d)[8 * q + 6] = __builtin_bit_cast(float, (r)[q].w << 16); (d)[8 * q + 7] = __builtin_bit_cast(float, (r)[q].w & 0xffff0000u); } } while (0)
        { LAS float* d = (LAS float*)(L + SY4_M) + row * 65 + col;
          SY4_PUT(d, a); }
        LDS_BARRIER();
#pragma unroll 1
        for (int c = 0; c < 64; ++c) {
            LAS float* d = (LAS float*)(L + SY4_M + ((c + 1) & 1) * SY4_MB) + row * 65 + col;
            SY4_PUT(d, b);
            if (c + 2 < 64) {
#pragma unroll
                for (int q = 0; q < 2; ++q) b[q] = *(const v4u*)(Mc + (u0 + c + 2) * 4096 + 16 * lt + 8 * q);
            }
            LDS_BARRIER();
        }
#undef SY4_PUT
    } else {
        const int rb = w;
        f32x4 S = (f32x4){0.f, 0.f, 0.f, 0.f}, n0, n1;
        { const bf16* Ng = Nc + u0 * 4096 + 16 * cq + li;
#pragma unroll
          for (int reg = 0; reg < 4; ++reg) { n0[reg] = bf2f(Ng[(16 * rb + 4 * lq + reg) * 64]); n1[reg] = bf2f(Ng[4096 + (16 * rb + 4 * lq + reg) * 64]); } }
        LDS_BARRIER();
#pragma unroll 1
        for (int c = 0; c < 64; ++c) {
            const size_t u = u0 + c;
            const LAS float* Ms = (const LAS float*)(L + SY4_M + (c & 1) * SY4_MB); const LAS float* Ss = (const LAS float*)(L + SY4_S + (c & 1) * SY4_SB);
            LAS float* Sn = (LAS float*)(L + SY4_S + ((c + 1) & 1) * SY4_SB);
            { typedef unsigned u32x2 __attribute__((ext_vector_type(2)));
              *(u32x2*)(SS + u * 4096 + (size_t)(16 * cq + li) * 64 + 16 * rb + 4 * lq) = (u32x2){cvt_pk(S[0], S[1]), cvt_pk(S[2], S[3])}; }
            f32x4 acc0 = n0, acc1 = (f32x4){0.f, 0.f, 0.f, 0.f};
            n0 = n1;
            if (c + 2 < 64) { const bf16* Ng = Nc + (u + 2) * 4096 + 16 * cq + li;
#pragma unroll
                for (int reg = 0; reg < 4; ++reg) n1[reg] = bf2f(Ng[(16 * rb + 4 * lq + reg) * 64]); }
#pragma unroll
            for (int s = 0; s < 16; s += 2) {
                const int k = 4 * s + lq;
                acc0 = __builtin_amdgcn_mfma_f32_16x16x4f32(Ms[(16 * rb + li) * 65 + k], Ss[k * 17 + li], acc0, 0, 0, 0);
                acc1 = __builtin_amdgcn_mfma_f32_16x16x4f32(Ms[(16 * rb + li) * 65 + k + 4], Ss[(k + 4) * 17 + li], acc1, 0, 0, 0);
            }
#pragma unroll
            for (int reg = 0; reg < 4; ++reg) { S[reg] = acc0[reg] + acc1[reg]; Sn[(16 * rb + 4 * lq + reg) * 17 + li] = S[reg]; }
            LDS_BARRIER();
        }
    }
    LDS_BARRIER();
}

constexpr int SZ_Q = 0, SZ_S = 64 * TS, SZ_Y = 2 * 64 * TS, SZ_UNIT = SZ_Y + 64 * 65 * 4;
struct PostIn { const float* gn_g; const float* gn_b; const bf16* bonus; const bf16* lout; bf16* mixed; };
struct ZRaw { v4u q[2], s[2]; unsigned y0[16]; };
__device__ __forceinline__ void scan_z_load(int u, int w, int lane, const bf16* __restrict__ QH, const bf16* __restrict__ Y0, const bf16* __restrict__ SS, ZRaw& R) {
    const int bh = u >> 6, c = u & 63, b = bh >> 4, h = bh & 15, lt = (w & 3) * 64 + lane, r = lane & 31;
    const size_t m0 = (size_t)b * T + (size_t)c * 64;
#pragma unroll
    for (int i = 0; i < 2; ++i) { const int ck = lt + 256 * i, row = ck >> 3, c8 = (ck & 7) * 8;
        R.q[i] = *(const v4u*)(QH + (size_t)u * 4096 + row * 64 + c8);
        R.s[i] = *(const v4u*)(SS + (size_t)u * 4096 + row * 64 + c8); }
    const int tile = w & 3, ti = tile >> 1, tj = tile & 1;
#pragma unroll
    for (int reg = 0; reg < 16; ++reg) R.y0[reg] = Y0[(size_t)u * 4096 + (32 * ti + CROW(reg, lane)) * 64 + 32 * tj + r];
}
__device__ __forceinline__ void scan_z_phase(Frame& F, const bf16* __restrict__ QH, const bf16* __restrict__ Y0, const bf16* __restrict__ SS, const PostIn& Z) {
    typedef unsigned u32x2 __attribute__((ext_vector_type(2)));
    const int w = F.wave, half = w >> 2;
    LAS unsigned char* L = F.lds + RING_OFF + half * SZ_UNIT;
    LAS float* Qs = (LAS float*)(L + SZ_Y);
    int u = half * (int)F.G + (int)blockIdx.x;
    ZRaw R;
    if (u < NUNITS) scan_z_load(u, w, lane_id_fresh(), QH, Y0, SS, R);
#pragma unroll 1
    for (int base = 0; base < NUNITS; base += 2 * (int)F.G, u += 2 * (int)F.G) {
        const bool valid = u < NUNITS;
        const int lane = lane_id_fresh(), lt = (w & 3) * 64 + lane, r = lane & 31, hh = lane >> 5;
        const int uu = valid ? u : 0, bh = uu >> 6, c = uu & 63, b = bh >> 4, h = bh & 15;
        const size_t m0 = (size_t)b * T + (size_t)c * 64;
        const int tile = w & 3, ti = tile >> 1, tj = tile & 1;
        f32x16 acc = zero16();
        if (valid) {
#pragma unroll
            for (int i = 0; i < 2; ++i) { const int ck = lt + 256 * i, row = ck >> 3, c8 = (ck & 7) * 8;
                *(LAS v4u*)(L + SZ_Q + row * TS + c8 * 2) = R.q[i]; *(LAS v4u*)(L + SZ_S + row * TS + c8 * 2) = R.s[i]; }
#pragma unroll
            for (int reg = 0; reg < 16; ++reg) acc[reg] = __builtin_bit_cast(float, R.y0[reg] << 16);
        }
        if (u + 2 * (int)F.G < NUNITS) scan_z_load(u + 2 * (int)F.G, w, lane, QH, Y0, SS, R);
        const int t = lt >> 2, q = lt & 3, col = h * HN + 16 * q;
        const size_t o = (m0 + t) * DR + col;
        v4u bo0 = (v4u){0u, 0u, 0u, 0u}, bo1 = bo0, gt0 = bo0, gt1 = bo0;
        if (valid) { const bf16* bp = Z.bonus + (size_t)uu * 4096 + t * 64 + 16 * q; bo0 = *(const v4u*)bp; bo1 = *(const v4u*)(bp + 8); const bf16* gp = Z.lout + (m0 + t) * 3072 + 2048 + col; gt0 = *(const v4u*)gp; gt1 = *(const v4u*)(gp + 8); }
        LDS_BARRIER();
        if (valid) {
            acc = mma_nt(L + SZ_Q, 32 * ti, L + SZ_S, 32 * tj, acc, lane);
        }
        if (valid) {
#pragma unroll
            for (int reg = 0; reg < 16; ++reg) Qs[(32 * ti + CROW(reg, lane)) * 65 + 32 * tj + r] = acc[reg];
        }
        LDS_BARRIER();
        if (valid) {
            float y[16]; float sm = 0.f;
#pragma unroll
            for (int i = 0; i < 16; ++i) { y[i] = Qs[t * 65 + 16 * q + i]; sm += y[i]; }
            sm += __builtin_bit_cast(float, __builtin_amdgcn_update_dpp(0, __builtin_bit_cast(int, sm), 0xB1, 0xF, 0xF, true));
            sm += __builtin_bit_cast(float, __builtin_amdgcn_update_dpp(0, __builtin_bit_cast(int, sm), 0x4E, 0xF, 0xF, true));
            const float mean = sm * (1.0f / 64.0f); float qv = 0.f;
#pragma unroll
            for (int i = 0; i < 16; ++i) { y[i] -= mean; qv += y[i] * y[i]; }
            qv += __builtin_bit_cast(float, __builtin_amdgcn_update_dpp(0, __builtin_bit_cast(int, qv), 0xB1, 0xF, 0xF, true));
            qv += __builtin_bit_cast(float, __builtin_amdgcn_update_dpp(0, __builtin_bit_cast(int, qv), 0x4E, 0xF, 0xF, true));
            const float rs = rsqrtf(qv * (1.0f / 64.0f) + 64e-5f);
            const unsigned bw[8] = {bo0.x, bo0.y, bo0.z, bo0.w, bo1.x, bo1.y, bo1.z, bo1.w}, gw8[8] = {gt0.x, gt0.y, gt0.z, gt0.w, gt1.x, gt1.y, gt1.z, gt1.w};
            unsigned pk[8];
#pragma unroll
            for (int i4 = 0; i4 < 4; ++i4) {
                const f32x4 gg = *(const f32x4*)(Z.gn_g + col + 4 * i4), gb = *(const f32x4*)(Z.gn_b + col + 4 * i4);
                const unsigned bA = bw[2 * i4], bB = bw[2 * i4 + 1], gA = gw8[2 * i4], gB = gw8[2 * i4 + 1];
                pk[2 * i4] = cvt_pk((y[4 * i4] * rs * gg.x + gb.x + __builtin_bit_cast(float, bA << 16)) * __builtin_bit_cast(float, gA << 16),
                                    (y[4 * i4 + 1] * rs * gg.y + gb.y + __builtin_bit_cast(float, bA & 0xffff0000u)) * __builtin_bit_cast(float, gA & 0xffff0000u));
                pk[2 * i4 + 1] = cvt_pk((y[4 * i4 + 2] * rs * gg.z + gb.z + __builtin_bit_cast(float, bB << 16)) * __builtin_bit_cast(float, gB << 16),
                                        (y[4 * i4 + 3] * rs * gg.w + gb.w + __builtin_bit_cast(float, bB & 0xffff0000u)) * __builtin_bit_cast(float, gB & 0xffff0000u));
            }
            bf16* dst = Z.mixed + (m0 + t) * D + DC + col;
            *(v4u*)dst = (v4u){pk[0], pk[1], pk[2], pk[3]}; *(v4u*)(dst + 8) = (v4u){pk[4], pk[5], pk[6], pk[7]};
        }
        LDS_BARRIER();
    }
}
__device__ __forceinline__ void lora_in_token(const bf16* __restrict__ proj, const float* __restrict__ mu, bf16* __restrict__ lin, int m, int lane) {
    const bf16* p = proj + (size_t)m * LDP + 3 * DR;
    const bool hasprev = (m % T) > 0;
#pragma unroll
    for (int i = 0; i < 6; ++i) {
        const int j = lane + 64 * i;
        float o = 0.f;
        if (j < LW + LA + LG) {
            const float cur = bf2f(p[j]), prv = hasprev ? bf2f(p[j - LDP]) : 0.f;
            const float x = cur + (prv - cur) * mu[3 * DR + j];
            o = (j < LW) ? (1.0f - 2.0f * __builtin_amdgcn_rcpf(1.0f + __expf(2.0f * x))) : (j < LW + LA) ? x : __builtin_amdgcn_rcpf(1.0f + __expf(-x));
        }
        lin[(size_t)m * 384 + j] = (bf16)f2bf(o);
    }
}
constexpr int CV_TT = 32, CV_ROWS = CV_TT + CW - 1, CV_RH = CV_ROWS / 2;
constexpr int CV_RED = CV_ROWS * DC * 2;
static_assert(CV_ROWS % 2 == 0 && CV_RED + 8 * 2 * CV_TT * 4 + 2 * CV_TT * 4 <= LDSCTL_OFF, "conv LDS");
__device__ __forceinline__ void conv_unit(Frame& F, int unit, const bf16* __restrict__ glu, const float* __restrict__ dw, const float* __restrict__ cb,
                                          const float* __restrict__ lng, const float* __restrict__ lnb, bf16* __restrict__ mixed) {
    LAS unsigned char* L = F.lds + RING_OFF;
    const int w = F.wave, lane = lane_id_fresh(), tid = w * 64 + lane;
    const int m0 = unit * CV_TT, tseq0 = m0 % T;
    {
        const int cq = tid & 255, rh = tid >> 8;
        typedef unsigned u32x2 __attribute__((ext_vector_type(2)));
        u32x2 gq[CV_RH];
#pragma unroll
        for (int q = 0; q < CV_RH; ++q) {
            const int rr = rh * CV_RH + q, ts = tseq0 - (CW - 1) + rr;
            gq[q] = (u32x2){0u, 0u};
            if (ts >= 0) gq[q] = *(const u32x2*)(glu + (size_t)(m0 - (CW - 1) + rr) * DC + 4 * cq);
        }
#pragma unroll
        for (int q = 0; q < CV_RH; ++q) *(LAS u32x2*)(L + (rh * CV_RH + q) * (DC * 2) + cq * 8) = gq[q];
    }
    __syncthreads();
    const int c0 = 2 * tid;
    float g0[CV_ROWS], g1[CV_ROWS];
#pragma unroll
    for (int rr = 0; rr < CV_ROWS; ++rr) { const unsigned x = *(const LAS unsigned*)(L + rr * (DC * 2) + c0 * 2); g0[rr] = __builtin_bit_cast(float, x << 16); g1[rr] = __builtin_bit_cast(float, x & 0xffff0000u); }
    float a0[CV_TT], a1[CV_TT];
    { const float b0 = cb[c0], b1 = cb[c0 + 1];
#pragma unroll
      for (int t = 0; t < CV_TT; ++t) { a0[t] = b0; a1[t] = b1; } }
#pragma unroll
    for (int j = 0; j < CW; ++j) {
        const float w0 = dw[j * DC + c0], w1 = dw[j * DC + c0 + 1];
#pragma unroll
        for (int t = 0; t < CV_TT; ++t) { a0[t] += w0 * g0[t + j]; a1[t] += w1 * g1[t + j]; }
        if ((j & 7) == 7) asm volatile("" ::: "memory");
    }
    LAS float* red = (LAS float*)(L + CV_RED);
#pragma unroll
    for (int t = 0; t < CV_TT; ++t) {
        float s = a0[t] + a1[t], q = a0[t] * a0[t] + a1[t] * a1[t];
        s = wave_sum_dpp(s); q = wave_sum_dpp(q);
        if (lane == 0) { red[w * 2 * CV_TT + t] = s; red[w * 2 * CV_TT + CV_TT + t] = q; }
    }
    __syncthreads();
    if (tid < 2 * CV_TT) { float s = 0.f;
#pragma unroll
        for (int k = 0; k < 8; ++k) s += red[k * 2 * CV_TT + tid];
        red[8 * 2 * CV_TT + tid] = s; }
    __syncthreads();
    const float lg0 = lng[c0], lg1 = lng[c0 + 1], lb0 = lnb[c0], lb1 = lnb[c0 + 1];
#pragma unroll
    for (int t = 0; t < CV_TT; ++t) {
        const float mu = red[8 * 2 * CV_TT + t] * (1.0f / DC), var = red[8 * 2 * CV_TT + CV_TT + t] * (1.0f / DC) - mu * mu;
        const float rs = rsqrtf(fmaxf(var, 0.f) + 1e-5f);
        const float z0 = (a0[t] - mu) * rs * lg0 + lb0, z1 = (a1[t] - mu) * rs * lg1 + lb1;
        *(unsigned*)(mixed + (size_t)(m0 + t) * D + c0) = cvt_pk(z0 * __builtin_amdgcn_rcpf(1.0f + __expf(-z0)), z1 * __builtin_amdgcn_rcpf(1.0f + __expf(-z1)));
    }
    __syncthreads();
}

__device__ __forceinline__ void rms_row16_to_bf16(const bf16* __restrict__ hrow, const float* __restrict__ g, bf16* __restrict__ orow, int lane) {
    float v[32]; float s = 0.f;
#pragma unroll
    for (int j = 0; j < 4; ++j) { const v4u a = ((const v4u*)hrow)[lane + 64 * j];
        v[8 * j] = __builtin_bit_cast(float, a.x << 16); v[8 * j + 1] = __builtin_bit_cast(float, a.x & 0xffff0000u); v[8 * j + 2] = __builtin_bit_cast(float, a.y << 16); v[8 * j + 3] = __builtin_bit_cast(float, a.y & 0xffff0000u);
        v[8 * j + 4] = __builtin_bit_cast(float, a.z << 16); v[8 * j + 5] = __builtin_bit_cast(float, a.z & 0xffff0000u); v[8 * j + 6] = __builtin_bit_cast(float, a.w << 16); v[8 * j + 7] = __builtin_bit_cast(float, a.w & 0xffff0000u);
#pragma unroll
        for (int q = 0; q < 8; ++q) s += v[8 * j + q] * v[8 * j + q]; }
    const float rs = rsqrtf(wave_sum_x(s) * (1.0f / D) + 1e-6f);
#pragma unroll
    for (int j = 0; j < 4; ++j) { const int c = lane + 64 * j; const f32x4 ga = ((const f32x4*)g)[2 * c], gb = ((const f32x4*)g)[2 * c + 1];
        v4u o; o.x = pk2(v[8 * j] * rs * ga.x, v[8 * j + 1] * rs * ga.y); o.y = pk2(v[8 * j + 2] * rs * ga.z, v[8 * j + 3] * rs * ga.w);
        o.z = pk2(v[8 * j + 4] * rs * gb.x, v[8 * j + 5] * rs * gb.y); o.w = pk2(v[8 * j + 6] * rs * gb.z, v[8 * j + 7] * rs * gb.w);
        ((v4u*)orow)[c] = o; }
}

__device__ __forceinline__ void rms_raw16_to_bf16(const v4u (&a)[4], const float* __restrict__ g, bf16* __restrict__ orow, int lane) {
    float s = 0.f;
#pragma unroll
    for (int j = 0; j < 4; ++j) {
        const unsigned wv[4] = {a[j].x, a[j].y, a[j].z, a[j].w};
#pragma unroll
        for (int q = 0; q < 4; ++q) { const float lo = __builtin_bit_cast(float, wv[q] << 16), hi = __builtin_bit_cast(float, wv[q] & 0xffff0000u); s += lo * lo + hi * hi; } }
    const float rs = rsqrtf(wave_sum_x(s) * (1.0f / D) + 1e-6f);
#pragma unroll
    for (int j = 0; j < 4; ++j) { const int c = lane + 64 * j; const f32x4 ga = ((const f32x4*)g)[2 * c], gb = ((const f32x4*)g)[2 * c + 1];
        v4u o;
        o.x = pk2(__builtin_bit_cast(float, a[j].x << 16) * rs * ga.x, __builtin_bit_cast(float, a[j].x & 0xffff0000u) * rs * ga.y);
        o.y = pk2(__builtin_bit_cast(float, a[j].y << 16) * rs * ga.z, __builtin_bit_cast(float, a[j].y & 0xffff0000u) * rs * ga.w);
        o.z = pk2(__builtin_bit_cast(float, a[j].z << 16) * rs * gb.x, __builtin_bit_cast(float, a[j].z & 0xffff0000u) * rs * gb.y);
        o.w = pk2(__builtin_bit_cast(float, a[j].w << 16) * rs * gb.z, __builtin_bit_cast(float, a[j].w & 0xffff0000u) * rs * gb.w);
        ((v4u*)orow)[c] = o; }
}
constexpr int RT_PC = 0, RT_PG = RT_PC + 8 * 16 * 64 * 4, RT_PSS = RT_PG + 8 * 16 * 64 * 4, RT_LG = RT_PSS + 8 * 64 * 4, RT_SS = RT_LG + 32 * 40 * 4, RT_HIST = RT_SS + 128, RT_BASE = RT_HIST + 128, RT_END = RT_BASE + 128;
static_assert(RT_END <= LDSCTL_OFF, "router LDS");
__device__ __forceinline__ void router_block(Frame& F, int blk, const bf16* __restrict__ H, const bf16* __restrict__ RW, const float* __restrict__ nf, const float* __restrict__ rgb,
                                             const float* __restrict__ reb, bf16* __restrict__ VN, int* __restrict__ cnt, int* __restrict__ list,
                                             int* __restrict__ asg_e, int* __restrict__ asg_pos, float* __restrict__ gate) {
    LAS unsigned char* L = F.lds + RING_OFF;
    const int tid = F.tid, lane = F.lane, w = F.wave, r = lane & 31, hh = lane >> 5;
    const int m0 = blk * 32;
    LAS float* Pc = (LAS float*)(L + RT_PC); LAS float* Pg = (LAS float*)(L + RT_PG); LAS float* Pss = (LAS float*)(L + RT_PSS); LAS float* Lg = (LAS float*)(L + RT_LG); LAS float* Ssq = (LAS float*)(L + RT_SS);
    LAS int* hist = (LAS int*)(L + RT_HIST); LAS int* base = (LAS int*)(L + RT_BASE);
    if (tid < 32) hist[tid] = 0;
    f32x16 acce = zero16(), accg = zero16(); float ss = 0.f;
    const bf16* arow = H + (size_t)(m0 + r) * D + 256 * w + 8 * hh;
    const bf16* bhi = RW + (size_t)r * D + 256 * w + 8 * hh; const bf16* blo = bhi + 64 * D;
#pragma unroll 4
    for (int s2 = 0; s2 < 16; ++s2) {
        const bf16x8_t av = *(const bf16x8_t*)(arow + 16 * s2);
        const bf16x8_t b0 = *(const bf16x8_t*)(bhi + 16 * s2), b1 = *(const bf16x8_t*)(blo + 16 * s2), b2 = *(const bf16x8_t*)(bhi + 32 * D + 16 * s2), b3 = *(const bf16x8_t*)(blo + 32 * D + 16 * s2);
#pragma unroll
        for (int j = 0; j < 8; ++j) { const float x = __builtin_bit_cast(float, (unsigned)(unsigned short)av[j] << 16); ss += x * x; }
        acce = __builtin_amdgcn_mfma_f32_32x32x16_bf16(av, b0, acce, 0, 0, 0); acce = __builtin_amdgcn_mfma_f32_32x32x16_bf16(av, b1, acce, 0, 0, 0);
        accg = __builtin_amdgcn_mfma_f32_32x32x16_bf16(av, b2, accg, 0, 0, 0); accg = __builtin_amdgcn_mfma_f32_32x32x16_bf16(av, b3, accg, 0, 0, 0);
    }
#pragma unroll
    for (int reg = 0; reg < 16; ++reg) { Pc[(w * 16 + reg) * 64 + lane] = acce[reg]; Pg[(w * 16 + reg) * 64 + lane] = accg[reg]; }
    Pss[w * 64 + lane] = ss;
    v4u hr0[4], hr1[4], hr2[4], hr3[4];
#pragma unroll
    for (int j = 0; j < 4; ++j) { hr0[j] = ((const v4u*)(H + (size_t)(m0 + 4 * w + 0) * D))[lane + 64 * j]; hr1[j] = ((const v4u*)(H + (size_t)(m0 + 4 * w + 1) * D))[lane + 64 * j];
                                  hr2[j] = ((const v4u*)(H + (size_t)(m0 + 4 * w + 2) * D))[lane + 64 * j]; hr3[j] = ((const v4u*)(H + (size_t)(m0 + 4 * w + 3) * D))[lane + 64 * j]; }
    __syncthreads();
#pragma unroll
    for (int i = 0; i < 2; ++i) {
        const int slot = tid + 512 * i, reg = slot >> 6, ln = slot & 63;
        float sum = 0.f;
#pragma unroll
        for (int ww = 0; ww < 8; ++ww) sum += Pc[(ww * 16 + reg) * 64 + ln];
        Lg[CROW(reg, ln) * 40 + NG + (ln & 31)] = sum;
    }
    if (tid < 128) {
        const int t = tid & 31, c = tid >> 5, ln = c + 32 * ((t >> 2) & 1), reg = (t & 3) + 4 * (t >> 3); float sum = 0.f;
#pragma unroll
        for (int ww = 0; ww < 8; ++ww) sum += Pg[(ww * 16 + reg) * 64 + ln];
        Lg[t * 40 + c] = sum;
    } else if (tid < 160) {
        const int t = tid - 128; float sum = 0.f;
#pragma unroll
        for (int ww = 0; ww < 8; ++ww) sum += Pss[ww * 64 + t] + Pss[ww * 64 + 32 + t];
        Ssq[t] = sum;
    }
    __syncthreads();
    int ea = 0, eb = 0, pa = 0, pb = 0;
    if (tid < 32) {
        const int m = m0 + tid;
        const float rs = rsqrtf(Ssq[tid] * (1.0f / D) + 1e-6f);
        float lg[NG + NE];
#pragma unroll
        for (int i = 0; i < NG + NE; ++i) lg[i] = Lg[tid * 40 + i] * rs + (i < NG ? rgb[i] : reb[i - NG]);
        int grp = 0; float gm = lg[0];
#pragma unroll
        for (int j = 1; j < NG; ++j) if (lg[j] > gm) { gm = lg[j]; grp = j; }
        float den = 0.f;
#pragma unroll
        for (int j = 0; j < NG; ++j) den += expf(lg[j] - gm);
        const float pg = 1.0f / den;
        int i1 = 0, i2 = 0; float v1 = 0.f, v2 = 0.f;
#pragma unroll
        for (int g = 0; g < NG; ++g) {
            int a1 = 0; float w1 = lg[NG + g * EPG];
#pragma unroll
            for (int j = 1; j < EPG; ++j) if (lg[NG + g * EPG + j] > w1) { w1 = lg[NG + g * EPG + j]; a1 = j; }
            int a2 = 0; float w2 = -3.0e38f;
#pragma unroll
            for (int j = 0; j < EPG; ++j) if (j != a1 && lg[NG + g * EPG + j] > w2) { w2 = lg[NG + g * EPG + j]; a2 = j; }
            if (g == 0 || grp == g) { i1 = a1; i2 = a2; v1 = w1; v2 = w2; }
        }
        const float e2 = expf(v2 - v1);
        ea = grp * EPG + i1; eb = grp * EPG + i2;
        gate[2 * m] = pg / (1.0f + e2); gate[2 * m + 1] = pg * e2 / (1.0f + e2);
        pa = atomicAdd((int*)&hist[ea], 1); pb = atomicAdd((int*)&hist[eb], 1);
    }
    __syncthreads();
    if (tid < 32) { const int c = hist[tid]; base[tid] = c > 0 ? atomicAdd(&cnt[tid], c) : 0; }
    __syncthreads();
    if (tid < 32) {
        const int m = m0 + tid; pa += base[ea]; pb += base[eb];
        list[(size_t)ea * NT + pa] = m; asg_e[2 * m] = ea; asg_pos[2 * m] = pa;
        list[(size_t)eb * NT + pb] = m; asg_e[2 * m + 1] = eb; asg_pos[2 * m + 1] = pb;
    }
    rms_raw16_to_bf16(hr0, nf, VN + (size_t)(m0 + 4 * w + 0) * D, lane); rms_raw16_to_bf16(hr1, nf, VN + (size_t)(m0 + 4 * w + 1) * D, lane);
    rms_raw16_to_bf16(hr2, nf, VN + (size_t)(m0 + 4 * w + 2) * D, lane); rms_raw16_to_bf16(hr3, nf, VN + (size_t)(m0 + 4 * w + 3) * D, lane);
    __syncthreads();
}


struct Args { const float* in[28]; float* out; unsigned char* ws; int ph_lo, ph_hi; };

constexpr size_t FW_CTL = 0, CTL_ZERO_BYTES = 64 * 1024, FW_LIST = 1, FW_ASG = 2, FW_WOUT = 3;
constexpr size_t FW_WGU = 11, FW_WD = 139, FW_WINT = 364, FW_U16 = 386, FW_PROJ = 203, FW_SS = 203, FW_GLU = 259, FW_BONUS = 259, FW_LOUT = 275, FW_Y2 = 203;
constexpr size_t FW_LORAT = 323, FW_LIN = 326, FW_MIXED = 332, FW_QH = 364, FW_Y0 = 396, FW_H = 364, FW_MC = 428, FW_VN16 = 428, FW_NC = 460, FW_HID = 460, FW_G16 = 492, FW_END = 508;
static_assert(FW_WGU + 128 <= FW_WD && FW_WD + 64 <= FW_PROJ && FW_U16 + 32 <= FW_MC && FW_PROJ + 56 <= FW_GLU && FW_GLU + 16 <= FW_LOUT && FW_LOUT + 48 <= FW_LORAT && FW_Y2 + 96 <= FW_LORAT && FW_LIN + 6 <= FW_MIXED && FW_HID + 24 <= FW_G16, "d_ws map");
constexpr int CW_CNT = 8192, CW_CVQ = 8320, CW_CVQ2 = 8320 + 8 * 64;
constexpr int TP_OFF = MISC_OFF + 128;
constexpr int NPH = 12;
#ifndef DUPMASK
#define DUPMASK 0
#endif
#define NREP(k) (1 + ((DUPMASK >> (k)) & 1))

__global__ void __launch_bounds__(NTHR, 2) mk_fwd(Args args) {
    extern __shared__ __attribute__((aligned(16))) unsigned char lds_raw[];
    Frame F;
    F.lds = (LAS unsigned char*)lds_raw;
    F.MISC = (volatile LAS unsigned*)(F.lds + MISC_OFF);
    F.wave = __builtin_amdgcn_readfirstlane(threadIdx.x >> 6); F.lane = lane_id_fresh(); F.tid = F.wave * 64 + F.lane;
#define REFRESH() do { F.lane = lane_id_fresh(); F.tid = F.wave * 64 + F.lane; } while (0)
    F.G = gridDim.x; { const int bx = blockIdx.x; F.vcu = (F.G % 8 == 0) ? (bx % 8) * (F.G / 8) + bx / 8 : bx; }
    unsigned char* ws = args.ws;
    F.ctl = (unsigned*)(ws + FW_CTL * MiB);
    for (int u = F.tid; u < (LDS_BYTES - LDSCTL_OFF) / 4; u += NTHR) ((LAS unsigned*)(F.lds + LDSCTL_OFF))[u] = 0u;
    __syncthreads();
    XcdBarrier bar = xcd_barrier_post(F.ctl + CW_BAR, F.MISC + 8);
    const int lo = args.ph_lo, hi = args.ph_hi;
#define IN(k) (lo <= (k) && (k) < hi)
#define BOTH(k) (IN(k) && IN((k) + 1))
    const int gw = F.vcu * NWAVES + F.wave, NGW = F.G * NWAVES;
    bf16* P16 = (bf16*)(ws + FW_PROJ * MiB); bf16* GLUb = (bf16*)(ws + FW_GLU * MiB);
    bf16* WguT = (bf16*)(ws + FW_WGU * MiB); bf16* WdT = (bf16*)(ws + FW_WD * MiB); bf16* WoutT = (bf16*)(ws + FW_WOUT * MiB); bf16* LoraT = (bf16*)(ws + FW_LORAT * MiB);
    bf16* LIN = (bf16*)(ws + FW_LIN * MiB); bf16* WinT = (bf16*)(ws + FW_WINT * MiB); bf16* U16 = (bf16*)(ws + FW_U16 * MiB);
    bf16* BONUS = (bf16*)(ws + FW_BONUS * MiB); bf16* G16 = (bf16*)(ws + FW_G16 * MiB); bf16* Y2 = (bf16*)(ws + FW_Y2 * MiB);
    bf16* MIXED16 = (bf16*)(ws + FW_MIXED * MiB); bf16* LOUT = (bf16*)(ws + FW_LOUT * MiB); bf16* SSp = (bf16*)(ws + FW_SS * MiB);
    bf16* QHp = (bf16*)(ws + FW_QH * MiB); bf16* Y0p = (bf16*)(ws + FW_Y0 * MiB); bf16* Hh = (bf16*)(ws + FW_H * MiB);
    bf16* Mcp = (bf16*)(ws + FW_MC * MiB); bf16* VN16 = (bf16*)(ws + FW_VN16 * MiB); bf16* Ncp = (bf16*)(ws + FW_NC * MiB); bf16* HID = (bf16*)(ws + FW_HID * MiB);
    int* list = (int*)(ws + FW_LIST * MiB); int* asg_e = (int*)(ws + FW_ASG * MiB); int* asg_pos = asg_e + 2 * NT; float* gate = (float*)(asg_pos + 2 * NT);
    int* cnt = (int*)(F.ctl + CW_CNT);
    bf16* RWp = (bf16*)(ws + FW_ASG * MiB + 512 * 1024);
    LAS int* tp = (LAS int*)(F.lds + TP_OFF);
    LAS float* scr = (LAS float*)(F.lds + RING_OFF + F.wave * 16384);

    if (IN(0)) for (int rep = 0; rep < NREP(0); ++rep) {
        if (rep) xcd_barrier(bar);
        REFRESH();
        constexpr int I_IN = (D / 64) * (DIN / 32), I_O = (D / 64) * (D / 32);
        for (int it = gw; it < I_IN + I_O; it += NGW) {
            if (it < I_IN) transpose_item(args.in[2], D, DIN, WinT, D, RowVG{}, scr, it, F.lane);
            else transpose_item(args.in[18], D, D, WoutT, D, RowId{0}, scr, it - I_IN, F.lane);
        }
        { v4u z; z.x = 0u; z.y = 0u; z.z = 0u; z.w = 0u; v4u* p = (v4u*)(WinT + (size_t)DIN * D);
          const int nz = (DINP - DIN) * D / 8;
          for (int i = blockIdx.x * NTHR + F.tid; i < nz; i += F.G * NTHR) p[i] = z; }
        for (int i = blockIdx.x * NTHR + F.tid; i < 3072 * 48; i += F.G * NTHR) {
            const int n = i % 3072, j0 = (i / 3072) * 8;
            const int blk = n >> 10, nn = n & 1023;
            float v[8];
#pragma unroll
            for (int q = 0; q < 8; ++q) { const int j = j0 + q; float x = 0.f;
                if (blk == 0) { if (j < 64) x = args.in[9][(size_t)j * DR + nn]; }
                else if (blk == 1) { if (j >= 64 && j < 128) x = args.in[11][(size_t)(j - 64) * DR + nn]; }
                else { if (j >= 128 && j < 288) x = args.in[12][(size_t)(j - 128) * DR + nn]; }
                v[q] = x; }
            v4u o; o.x = pk2(v[0], v[1]); o.y = pk2(v[2], v[3]); o.z = pk2(v[4], v[5]); o.w = pk2(v[6], v[7]);
            *(v4u*)(LoraT + (size_t)n * 384 + j0) = o;
        }
        for (int i = blockIdx.x * NTHR + F.tid; i < 64 * (D / 8); i += F.G * NTHR) {
            const int row = i / (D / 8), k0 = (i % (D / 8)) * 8;
            unsigned hi[4], lo[4];
#pragma unroll
            for (int q = 0; q < 4; ++q) { float x[2];
#pragma unroll
                for (int e = 0; e < 2; ++e) { const int k = k0 + 2 * q + e; x[e] = (row < 32) ? args.in[19][k] * args.in[22][(size_t)k * NE + row] : (row < 36) ? args.in[19][k] * args.in[20][(size_t)k * NG + row - 32] : 0.f; }
                const unsigned h2 = pk2(x[0], x[1]); hi[q] = h2;
                lo[q] = pk2(x[0] - __builtin_bit_cast(float, h2 << 16), x[1] - __builtin_bit_cast(float, h2 & 0xffff0000u)); }
            *(v4u*)(RWp + (size_t)row * D + k0) = (v4u){hi[0], hi[1], hi[2], hi[3]}; *(v4u*)(RWp + (size_t)(64 + row) * D + k0) = (v4u){lo[0], lo[1], lo[2], lo[3]};
        }
        for (int m = gw; m < NT; m += NGW) rms_row_to_bf16(args.in[0] + (size_t)m * D, args.in[1], U16 + (size_t)m * D, F.lane);
    }
    if (BOTH(0)) xcd_barrier(bar);
    if (IN(1)) for (int rep = 0; rep < NREP(1); ++rep) {
        if (rep) xcd_barrier(bar);
        REFRESH();
        pg8::Gemm g{U16, WinT, NT, DINP, D}; pg8::StaticOrder S; S.init(NT, DINP, F.G, (int)blockIdx.x);
        pg8::EpiProj E{GLUb, P16};
        pg8::gemm_phase<pg8::EpiProj, pg8::StaticOrder>(F.lds + RING_OFF, g, S, E, nullptr, F.wave);
        { const int nwg = (NT / 256) * (DINP / 256), rounds = (nwg + (int)F.G - 1) / (int)F.G;
          if (rep == 0 && (int)blockIdx.x + (rounds - 1) * (int)F.G >= nwg) { const CvIn C{args.in, WguT, WdT}; cv_queue_run(C, F.ctl + CW_CVQ, 0, 2 * NE * 256, (LAS float*)(F.lds + RING_OFF + F.wave * CV_SCR), lane_id_fresh(), 6); } }
    }
    if (BOTH(1)) xcd_barrier(bar);
    if (IN(2)) for (int rep = 0; rep < NREP(2); ++rep) {
        if (rep) xcd_barrier(bar);
        REFRESH();
        for (int m = gw; m < NT; m += NGW) lora_in_token(P16, args.in[7], LIN, m, F.lane);
        for (int u = F.vcu; u < NT / CV_TT; u += F.G) conv_unit(F, u, GLUb, args.in[3], args.in[4], args.in[5], args.in[6], MIXED16);
    }
    if (BOTH(2)) xcd_barrier(bar);
    if (IN(3)) for (int rep = 0; rep < NREP(3); ++rep) {
        if (rep) xcd_barrier(bar);
        REFRESH();
        pg8::Gemm g{LIN, LoraT, NT, 3072, 384}; pg8::LoraOrder S; S.init(NT, 3072, F.G, (int)blockIdx.x);
        pg8::EpiBf16<0> E{LOUT, 3072, nullptr, 0, 0};
        pg8::gemm_phase<pg8::EpiBf16<0>, pg8::LoraOrder>(F.lds + RING_OFF, g, S, E, nullptr, F.wave);
        { const int nwg = (NT / 256) * (3072 / 256), rounds = (nwg + (int)F.G - 1) / (int)F.G;
          if (rep == 0 && (int)blockIdx.x + (rounds - 1) * (int)F.G >= nwg) { const CvIn C{args.in, WguT, WdT}; cv_queue_run(C, F.ctl + CW_CVQ, 0, 2 * NE * 256, (LAS float*)(F.lds + RING_OFF + F.wave * CV_SCR), lane_id_fresh(), 1); } }
    }
    if (BOTH(3)) xcd_barrier(bar);
    if (IN(4)) for (int rep = 0; rep < NREP(4); ++rep) {
        if (rep) xcd_barrier(bar);
        REFRESH();
        const PrepIn P{P16, LOUT, args.in[7], args.in[8], args.in[10], args.in[13], args.in[14], args.in[15], BONUS, G16};
        const int upw = (NUNITS + (int)F.G - 1) / (int)F.G + 1, nsx = (NUNITS + upw - 1) / upw;
        if ((int)blockIdx.x < nsx) scan_x_phase<0>(F, P, QHp, Y0p, Mcp, Ncp, nsx);
        else { const CvIn C{args.in, WguT, WdT}; cv_queue_run(C, F.ctl + CW_CVQ, 0, 2 * NE * 256, (LAS float*)(F.lds + RING_OFF + F.wave * CV_SCR), lane_id_fresh(), 16); }
#ifdef XMODE
        xcd_barrier(bar); scan_x_phase<XMODE>(F, P, QHp, Y0p, Mcp, Ncp, (int)F.G);
#endif
    }
    if (BOTH(4)) xcd_barrier(bar);
    if (IN(5)) {
        REFRESH();
        for (int rep = 0; rep < NREP(5); ++rep) { if (rep) xcd_barrier(bar);
        if (blockIdx.x < 4 * BATCH * NH) scan_y_chain4(F, (int)blockIdx.x, Mcp, Ncp, SSp); }
        { const CvIn C{args.in, WguT, WdT}; cv_queue_run(C, F.ctl + CW_CVQ, 0, 2 * NE * 256, (LAS float*)(F.lds + RING_OFF + F.wave * CV_SCR), F.lane); }
        if (BOTH(5)) xcd_barrier(bar);
    }
    if (IN(6)) for (int rep = 0; rep < NREP(6); ++rep) {
        if (rep) xcd_barrier(bar);
        REFRESH();
        const PostIn Z{args.in[16], args.in[17], BONUS, LOUT, MIXED16};
        scan_z_phase(F, QHp, Y0p, SSp, Z);
    }
    if (BOTH(6)) xcd_barrier(bar);
    if (IN(7)) for (int rep = 0; rep < NREP(7); ++rep) {
        if (rep) xcd_barrier(bar);
        REFRESH();
        pg8::Gemm g{MIXED16, WoutT, NT, D, D}; pg8::StaticOrder S; S.init(NT, D, F.G, (int)blockIdx.x);
        pg8::EpiResBf16 E{Hh, D, args.in[0]};
        pg8::gemm_phase<pg8::EpiResBf16, pg8::StaticOrder>(F.lds + RING_OFF, g, S, E, nullptr, F.wave);
    }
    if (BOTH(7)) xcd_barrier(bar);
    if (IN(8)) {
        REFRESH();
        for (int blk = blockIdx.x; blk < NT / 32; blk += F.G)
            router_block(F, blk, Hh, RWp, args.in[19], args.in[21], args.in[23], VN16, cnt, list, asg_e, asg_pos, gate);
        if (BOTH(8)) xcd_barrier(bar);
    }
    if (IN(9) || IN(10) || IN(11)) {
        REFRESH();
        __syncthreads();
        if (F.wave == 0) {
            const int e = F.lane & 31; int c = (cnt[e] + 255) >> 8, inc = c;
#pragma unroll
            for (int d = 1; d < 32; d <<= 1) { const int o = __shfl_up(inc, d, 32); if (e >= d) inc += o; }
            if (F.lane < 32) { tp[e] = inc - c; if (e == 31) tp[NE] = inc; for (int mt = inc - c; mt < inc; ++mt) tp[40 + mt] = e; }
        }
        __syncthreads();
    }
    if (IN(9)) for (int rep = 0; rep < NREP(9); ++rep) {
        if (rep) xcd_barrier(bar);
        REFRESH();
        MoeOrder S{tp, cnt, list, 4, (int)F.G, (int)blockIdx.x, nullptr, 0, (const char*)WguT, (size_t)1024 * D * 2, (size_t)256 * D * 2};
        pg8::EpiSwiGLU E{HID, DE};
        pg8::gemm_phase_g<true, pg8::EpiSwiGLU, MoeOrder>(F.lds + RING_OFF, (const char*)VN16, D, S, E, F.wave);
        if (rep == 0) { const CvIn C{args.in, WguT, WdT}; cv_queue_run(C, F.ctl + CW_CVQ2, 2 * NE * 256, CV_ITEMS, (LAS float*)(F.lds + RING_OFF + F.wave * CV_SCR), lane_id_fresh()); }
    }
    if (BOTH(9)) xcd_barrier(bar);
    if (IN(10)) for (int rep = 0; rep < NREP(10); ++rep) {
        if (rep) xcd_barrier(bar);
        REFRESH();
        MoeOrder S{tp, cnt, list, 8, (int)F.G, (int)blockIdx.x, (const char*)HID, (size_t)256 * DE * 2, (const char*)WdT, (size_t)D * DE * 2, (size_t)256 * DE * 2};
        pg8::EpiBf16<0> E{Y2, D, nullptr, 0, 0};
        pg8::gemm_phase_g<false, pg8::EpiBf16<0>, MoeOrder>(F.lds + RING_OFF, nullptr, DE, S, E, F.wave);
    }
    if (BOTH(10)) xcd_barrier(bar);
    if (IN(11)) for (int rep = 0; rep < NREP(11); ++rep) {
        if (rep) xcd_barrier(bar);
        REFRESH();
        for (int m = gw; m < NT; m += NGW) {
            const int s1 = 256 * tp[asg_e[2 * m]] + asg_pos[2 * m], s2 = 256 * tp[asg_e[2 * m + 1]] + asg_pos[2 * m + 1];
            final_token(Hh + (size_t)m * D, Y2 + (size_t)s1 * D, Y2 + (size_t)s2 * D, gate[2 * m], gate[2 * m + 1], args.in[27], args.out + (size_t)m * D, F.lane);
        }
    }
#undef IN
#undef BOTH
}

extern "C" void kernel_launch(void* const* d_in, const int* in_sizes, int n_in, void* d_out, int out_size, void* d_ws, size_t ws_size, hipStream_t stream) {
    static int grid = 0;
    if (grid == 0) {
        if (n_in != 28 || in_sizes[0] != NT * D || out_size != NT * D || ws_size < FW_END * MiB) {
            fprintf(stderr, "kernel_launch: unexpected shapes (n_in %d, in0 %d, out %d, ws %zu)\n", n_in, n_in > 0 ? in_sizes[0] : -1, out_size, ws_size); grid = -1; return; }
        int dev = 0, cus = 0, per_cu = 0;
        if (hipGetDevice(&dev) != hipSuccess || hipDeviceGetAttribute(&cus, hipDeviceAttributeMultiprocessorCount, dev) != hipSuccess) { grid = -1; return; }
        if (hipFuncSetAttribute((const void*)mk_fwd, hipFuncAttributeMaxDynamicSharedMemorySize, LDS_BYTES) != hipSuccess) { fprintf(stderr, "hipFuncSetAttribute failed\n"); grid = -1; return; }
        if (hipOccupancyMaxActiveBlocksPerMultiprocessor(&per_cu, (const void*)mk_fwd, NTHR, LDS_BYTES) != hipSuccess || per_cu < 1) { fprintf(stderr, "occupancy query: %d\n", per_cu); (void)hipGetLastError(); }
        grid = cus;
    }
    if (grid < 0) return;
    if (hipMemsetAsync((char*)d_ws + FW_CTL * MiB, 0, CTL_ZERO_BYTES, stream) != hipSuccess) return;
    Args a{};
    for (int i = 0; i < 28; ++i) a.in[i] = (const float*)d_in[i];
    a.out = (float*)d_out; a.ws = (unsigned char*)d_ws; a.ph_lo = 0; a.ph_hi = NPH;
#ifdef PROBE_PH
#ifndef PROBE_HI
#define PROBE_HI PROBE_PH
#endif
    a.ph_hi = PROBE_HI + 1;
    hipLaunchKernelGGL(mk_fwd, dim3(grid), dim3(NTHR), LDS_BYTES, stream, a);
    if (hipMemsetAsync((char*)d_ws + FW_CTL * MiB + CW_BAR * 4, 0, XCD_BAR_WORDS * 4, stream) != hipSuccess) return;
    if (hipMemsetAsync((char*)d_ws + FW_CTL * MiB + CW_CVQ * 4, 0, 512, stream) != hipSuccess) return;
    a.ph_lo = PROBE_PH; a.ph_hi = NPH;
#endif
    hipLaunchKernelGGL(mk_fwd, dim3(grid), dim3(NTHR), LDS_BYTES, stream, a);
}
```

```cpp
#include <hip/hip_runtime.h>
#include <cstdio>
#include <cstdint>

constexpr int BATCH = 2, T = 4096, NT = BATCH * T, D = 2048, DIN = 5408, DC = 1024, DR = 1024, NH = 16, HN = 64, CW = 31;
constexpr int DSH = 3360, LW = 64, LA = 64, LG = 160;
constexpr int NE = 32, NG = 4, EPG = 8, DE = 512;
constexpr size_t MiB = 1u << 20;
constexpr int LDP = 3584;

__device__ __forceinline__ float wave_sum(float v) {
#pragma unroll
    for (int o = 32; o > 0; o >>= 1) v += __shfl_xor(v, o);
    return v;
}
__device__ __forceinline__ float block_sum256(float v, float* red) {
    v = wave_sum(v);
    __syncthreads();
    if ((threadIdx.x & 63) == 0) red[threadIdx.x >> 6] = v;
    __syncthreads();
    return (red[0] + red[1]) + (red[2] + red[3]);
}
__device__ __forceinline__ float sigmoidf_(float x) { return 1.0f / (1.0f + expf(-x)); }
__device__ __forceinline__ unsigned f2bf_n(float f) { unsigned u = __builtin_bit_cast(unsigned, f); return (u + 0x7fffu + ((u >> 16) & 1u)) >> 16; }

__device__ __forceinline__ int lane_id_fresh() { int l; asm volatile("v_mbcnt_lo_u32_b32 %0, -1, 0\n\tv_mbcnt_hi_u32_b32 %0, -1, %0" : "=v"(l)); return l; }
namespace pg8 {
#define PG8_LAS __attribute__((address_space(3)))
typedef unsigned short bf16_t;
typedef short bf16x8 __attribute__((ext_vector_type(8)));
typedef float f32x4 __attribute__((ext_vector_type(4)));
typedef unsigned u32x4 __attribute__((ext_vector_type(4)));
constexpr int BM = 256, BK = 64, HALF = 128, HTB = HALF * BK * 2  , STAGE_BYTES = 8 * HTB, NXCD = 8, WGM = 8;

__host__ __device__ __forceinline__ int lds_byte(int r, int c) { const int st = (r >> 4) * 2 + (c >> 5), rr = r & 15, cc = c & 31, ob = rr * 64 + cc * 2; return st * 1024 + (ob ^ (((ob >> 9) & 1) << 5)); }
__host__ __device__ __forceinline__ void stage_rc(int b, int& R, int& C) { const int st = b / 1024, sb = b % 1024, swz = sb ^ (((sb >> 9) & 1) << 5); R = (st >> 1) * 16 + swz / 64; C = (st & 1) * 32 + (swz % 64) / 2; }
__host__ __device__ __forceinline__ int perm32(int rho) { const int n = rho >> 4, i = rho & 15; return 8 * (i >> 2) + 4 * n + (i & 3); }

struct Unit { int pm, pn; };
struct Gemm { const bf16_t* A; const bf16_t* Bt; int M, N, K; };

struct StaticOrder {
    int nM, nN, nwg, G, c;
    __host__ __device__ void init(int M, int N, int G_, int c_) { nM = M / BM; nN = N / BM; nwg = nM * nN; G = G_; c = c_; }
    __host__ __device__ bool next(int i, Unit& u) const {
        const long L = (long)i * G + c; if (L >= nwg) return false;
        int wgid = (int)L; { const int q = nwg / NXCD, r = nwg % NXCD, xcd = wgid % NXCD, off = wgid / NXCD; wgid = (xcd < r ? xcd * (q + 1) : r * (q + 1) + (xcd - r) * q) + off; }
        const int nig = WGM * nN, gid = wgid / nig, fm = gid * WGM, gsz = (nM - fm) < WGM ? (nM - fm) : WGM;
        u.pm = fm + ((wgid % nig) % gsz); u.pn = (wgid % nig) / gsz; return true;
    }
    __device__ __forceinline__ void a_ready(const Unit&) const {}
    __device__ __forceinline__ void done(const Unit&) const {}
    __device__ __forceinline__ size_t kofs(const Unit&) const { return 0; }
    __device__ __forceinline__ int ntiles(const Unit&, int nt) const { return nt; }
};
struct LoraOrder : StaticOrder {
    __device__ __forceinline__ size_t kofs(const Unit& u) const { return u.pn < 8 ? 0 : 256; }
    __device__ __forceinline__ int ntiles(const Unit& u, int) const { return u.pn < 8 ? 2 : 4; }
};
__device__ __forceinline__ unsigned cvt_pk_bf16(float lo, float hi) { unsigned r; asm volatile("v_cvt_pk_bf16_f32 %0, %1, %2" : "=v"(r) : "v"(lo), "v"(hi)); return r; }
typedef float f32x2 __attribute__((ext_vector_type(2)));
__device__ __forceinline__ f32x2 gelu_pk(f32x2 v) {
    const f32x2 av = __builtin_elementwise_abs(v), d = av * 0.2316418882f + 1.0f;
    f32x2 t; t.x = __builtin_amdgcn_rcpf(d.x); t.y = __builtin_amdgcn_rcpf(d.y);
    f32x2 q = t * 0.5307027145f + (-0.7265760135f); q = q * t + 0.7107068705f; q = q * t + (-0.142248368f); q = q * t + 0.127414796f; q = q * t;
    const f32x2 s = (v * v) * (-0.72134752044f);
    f32x2 e; e.x = __builtin_amdgcn_exp2f(s.x); e.y = __builtin_amdgcn_exp2f(s.y);
    const f32x2 m = v * (q * e), r = v - m;
    f32x2 o; o.x = v.x < 0.f ? m.x : r.x; o.y = v.y < 0.f ? m.y : r.y; return o;
}

struct EpiF32 {
    static constexpr bool PERM = false, AFTER_DRAIN = false;
    float* C; int ldc; const float* bias;
    template <class U> __device__ __forceinline__ void operator()(const f32x4 (&acc)[2][2][4][2], const U& u, int wr, int wc, int fr, int fq) const {
        const int row0 = u.pm * BM + wr * 64 + fr, col0 = u.pn * BM + wc * 32 + 4 * fq;
        f32x4 bv[2][2];
#pragma unroll
        for (int bj = 0; bj < 2; ++bj)
#pragma unroll
            for (int n = 0; n < 2; ++n) bv[bj][n] = bias ? *(const f32x4*)(bias + col0 + bj * HALF + n * 16) : (f32x4){0.f, 0.f, 0.f, 0.f};
#pragma unroll
        for (int ai = 0; ai < 2; ++ai)
#pragma unroll
            for (int m = 0; m < 4; ++m) { float* rowp = C + (size_t)(row0 + ai * HALF + m * 16) * ldc + col0;
#pragma unroll
                for (int bj = 0; bj < 2; ++bj)
#pragma unroll
                    for (int n = 0; n < 2; ++n) *(f32x4*)(rowp + bj * HALF + n * 16) = acc[ai][bj][m][n] + bv[bj][n]; }
    }
};
struct EpiResF32 {
    static constexpr bool PERM = false, AFTER_DRAIN = false;
    float* C; int ldc; const float* res;
    template <class U> __device__ __forceinline__ void operator()(const f32x4 (&acc)[2][2][4][2], const U& u, int wr, int wc, int fr, int fq) const {
        const int row0 = u.pm * BM + wr * 64 + fr, col0 = u.pn * BM + wc * 32 + 4 * fq;
#pragma unroll
        for (int ai = 0; ai < 2; ++ai)
#pragma unroll
            for (int m = 0; m < 4; ++m) { const size_t off = (size_t)(row0 + ai * HALF + m * 16) * ldc + col0;
#pragma unroll
                for (int bj = 0; bj < 2; ++bj)
#pragma unroll
                    for (int n = 0; n < 2; ++n) *(f32x4*)(C + off + bj * HALF + n * 16) = acc[ai][bj][m][n] + *(const f32x4*)(res + off + bj * HALF + n * 16); }
    }
};
struct EpiResBf16 {
    static constexpr bool PERM = true, AFTER_DRAIN = false;
    bf16_t* O; int ldc; const float* res;
    template <class U> __device__ __forceinline__ void operator()(const f32x4 (&acc)[2][2][4][2], const U& u, int wr, int wc, int fr, int fq) const {
        const int row0 = u.pm * BM + wr * 64 + fr, col0 = u.pn * BM + wc * 32 + 8 * fq;
#pragma unroll
        for (int ai = 0; ai < 2; ++ai)
#pragma unroll
            for (int m = 0; m < 4; ++m) { const size_t off = (size_t)(row0 + ai * HALF + m * 16) * ldc + col0;
#pragma unroll
                for (int bj = 0; bj < 2; ++bj) { const f32x4 v0 = acc[ai][bj][m][0] + __builtin_nontemporal_load((const f32x4*)(res + off + bj * HALF)), v1 = acc[ai][bj][m][1] + __builtin_nontemporal_load((const f32x4*)(res + off + bj * HALF + 4));
                    u32x4 w; w.x = cvt_pk_bf16(v0[0], v0[1]); w.y = cvt_pk_bf16(v0[2], v0[3]); w.z = cvt_pk_bf16(v1[0], v1[1]); w.w = cvt_pk_bf16(v1[2], v1[3]);
                    *(u32x4*)(O + off + bj * HALF) = w; } }
    }
};
template <int ACT  > struct EpiBf16 {
    static constexpr bool PERM = true, AFTER_DRAIN = false;
    bf16_t* O; int ldc; const float* bias; int split_cols; size_t split_stride;
    template <class U> __device__ __forceinline__ void operator()(const f32x4 (&acc)[2][2][4][2], const U& u, int wr, int wc, int fr, int fq) const {
        const int row0 = u.pm * BM + wr * 64 + fr; int colt = u.pn * BM; bf16_t* base = O;
        if (split_cols) { const int t = colt / split_cols; base += (size_t)t * split_stride; colt -= t * split_cols; }
        const int col0 = colt + wc * 32 + 8 * fq, bcol0 = u.pn * BM + wc * 32 + 8 * fq;
        f32x4 bv[2][2];
#pragma unroll
        for (int bj = 0; bj < 2; ++bj)
#pragma unroll
            for (int n = 0; n < 2; ++n) bv[bj][n] = bias ? *(const f32x4*)(bias + bcol0 + bj * HALF + 4 * n) : (f32x4){0.f, 0.f, 0.f, 0.f};
#pragma unroll
        for (int ai = 0; ai < 2; ++ai)
#pragma unroll
            for (int m = 0; m < 4; ++m) { bf16_t* rowp = base + (size_t)(row0 + ai * HALF + m * 16) * ldc + col0;
#pragma unroll
                for (int bj = 0; bj < 2; ++bj) { f32x4 v0 = acc[ai][bj][m][0] + bv[bj][0], v1 = acc[ai][bj][m][1] + bv[bj][1];
                    if (ACT == 1) { f32x2 a = gelu_pk((f32x2){v0[0], v0[1]}), b = gelu_pk((f32x2){v0[2], v0[3]}), c = gelu_pk((f32x2){v1[0], v1[1]}), d = gelu_pk((f32x2){v1[2], v1[3]});
                        v0 = (f32x4){a.x, a.y, b.x, b.y}; v1 = (f32x4){c.x, c.y, d.x, d.y}; }
                    if (ACT == 2) {
#pragma unroll
                        for (int j = 0; j < 4; ++j) { v0[j] = 0.5f * v0[j] * (1.0f + erff(v0[j] * 0.70710678f)); v1[j] = 0.5f * v1[j] * (1.0f + erff(v1[j] * 0.70710678f)); } }
                    u32x4 w; w.x = cvt_pk_bf16(v0[0], v0[1]); w.y = cvt_pk_bf16(v0[2], v0[3]); w.z = cvt_pk_bf16(v1[0], v1[1]); w.w = cvt_pk_bf16(v1[2], v1[3]);
                    *(u32x4*)(rowp + bj * HALF) = w; } }
    }
};

template <class Epi, class Sched, bool STAMP = false>
__device__ __forceinline__ void gemm_phase(PG8_LAS unsigned char* lds, const Gemm g, const Sched& S, const Epi& E, unsigned long long* stamps, int wid) {
    const int lane = lane_id_fresh(), tid = wid * 64 + lane, wr = wid >> 2, wc = wid & 3, fr = lane & 15, fq = lane >> 4;
    const int K = g.K, nt = K / BK;
    int ts_lo = 0, ts_hi = 0, nts = 0; const unsigned long long rt_entry = STAMP ? (unsigned long long)wall_clock64() : 0ull;
#define PG8_STAMP() do { if (STAMP && wid == 0 && nts < 64) { const unsigned long long _c = (unsigned long long)clock64(); \
        ts_lo = (lane == nts) ? (int)(unsigned)_c : ts_lo; ts_hi = (lane == nts) ? (int)(unsigned)(_c >> 32) : ts_hi; ++nts; } } while (0)
    PG8_STAMP();
    unsigned voffA[2], voffB[2];
#pragma unroll
    for (int i = 0; i < 2; ++i) { int R, C; stage_rc(tid * 16 + i * 8192, R, C); const int Rb = Epi::PERM ? ((R & ~31) + perm32(R & 31)) : R;
        voffA[i] = (unsigned)(R * K + C) * 2u; voffB[i] = (unsigned)(Rb * K + C) * 2u; }
    const size_t kstep = (size_t)(BK * 2);
    const size_t hstep = (size_t)HALF * K * 2;
    const size_t tstep = 2 * hstep;
    const unsigned ldsw = (unsigned)wid * 1024u;
    const int aoff = lds_byte(wr * 64 + fr, fq * 8), boff = lds_byte(wc * 32 + fr, fq * 8);
#define PG8_SA(b, h) (((b) * 2 + (h)) * HTB)
#define PG8_SB(b, h) ((4 + (b) * 2 + (h)) * HTB)
#define PG8_STAGE(bufoff, gbase, voff) do { _Pragma("unroll") for (int _i = 0; _i < 2; ++_i) \
        __builtin_amdgcn_global_load_lds((const unsigned*)((const char*)(gbase) + (voff)[_i]), (PG8_LAS unsigned*)(lds + (bufoff) + ldsw + _i * 8192), 16, 0, 0); } while (0)
#define PG8_LDA(dst, b, h) do { _Pragma("unroll") for (int m = 0; m < 4; ++m) _Pragma("unroll") for (int k = 0; k < 2; ++k) dst[m][k] = *(const PG8_LAS bf16x8*)(lds + PG8_SA(b, h) + aoff + m * 2048 + k * 1024); } while (0)
#define PG8_LDB(dst, b, h) do { _Pragma("unroll") for (int n = 0; n < 2; ++n) _Pragma("unroll") for (int k = 0; k < 2; ++k) dst[n][k] = *(const PG8_LAS bf16x8*)(lds + PG8_SB(b, h) + boff + n * 2048 + k * 1024); } while (0)
#define PG8_MMA(ai, bj, At, Bt) do { __builtin_amdgcn_s_setprio(1); _Pragma("unroll") for (int m = 0; m < 4; ++m) _Pragma("unroll") for (int n = 0; n < 2; ++n) _Pragma("unroll") for (int k = 0; k < 2; ++k) \
        acc[ai][bj][m][n] = __builtin_amdgcn_mfma_f32_16x16x32_bf16(Bt[n][k], At[m][k], acc[ai][bj][m][n], 0, 0, 0); __builtin_amdgcn_s_setprio(0); } while (0)
#define PG8_WAIT_V(n) asm volatile("s_waitcnt vmcnt(" #n ")" ::: "memory")
#define PG8_WAIT_L(n) asm volatile("s_waitcnt lgkmcnt(" #n ")" ::: "memory")
#define PG8_BAR __builtin_amdgcn_s_barrier()
#define PG8_SCHED __builtin_amdgcn_sched_barrier(0)
    Unit cur, nxt; int ui = 0;
    if (!S.next(0, cur)) return;
    f32x4 acc[2][2][4][2];
    bf16x8 At[4][2], B0[2][2], B1[2][2];
    const char* cA = (const char*)g.A + (size_t)cur.pm * tstep + S.kofs(cur); const char* cB = (const char*)g.Bt + (size_t)cur.pn * tstep + S.kofs(cur);
    S.a_ready(cur);
    { const char* p0 = cB; const char* p1 = cB + hstep; const char* p2 = cA; const char* p3 = cA + hstep; const char* p4 = cB + kstep; const char* p5 = cA + kstep; const char* p6 = cB + hstep + kstep;
      asm volatile("" : "+s"(p0), "+s"(p1), "+s"(p2), "+s"(p3), "+s"(p4), "+s"(p5), "+s"(p6));
      PG8_STAGE(PG8_SB(0, 0), p0, voffB); PG8_STAGE(PG8_SB(0, 1), p1, voffB); PG8_STAGE(PG8_SA(0, 0), p2, voffA); PG8_STAGE(PG8_SA(0, 1), p3, voffA);
      if (wr == 1) PG8_BAR;
      PG8_WAIT_V(2); PG8_BAR;
      PG8_STAGE(PG8_SB(1, 0), p4, voffB); PG8_STAGE(PG8_SA(1, 0), p5, voffA); PG8_STAGE(PG8_SB(1, 1), p6, voffB);
      PG8_WAIT_V(6); PG8_BAR; }
#pragma unroll
    for (int a = 0; a < 2; ++a)
#pragma unroll
        for (int b = 0; b < 2; ++b)
#pragma unroll
            for (int m = 0; m < 4; ++m)
#pragma unroll
                for (int n = 0; n < 2; ++n) acc[a][b][m][n] = (f32x4){0.f, 0.f, 0.f, 0.f};
    PG8_STAMP();
    for (;;) {
        const bool has_next = S.next(ui + 1, nxt);
        const char* nA = has_next ? (const char*)g.A + (size_t)nxt.pm * tstep + S.kofs(nxt) : cA; const char* nB = has_next ? (const char*)g.Bt + (size_t)nxt.pn * tstep + S.kofs(nxt) : cB;
        const int ntc = S.ntiles(cur, nt);
#pragma unroll 1
        for (int t = 0; t < ntc; t += 2) {
            const bool last = (t == ntc - 2);
            const char* a1 = cA + (size_t)(t + 1) * kstep;
            const char* a2 = last ? nA : cA + (size_t)(t + 2) * kstep; const char* b2 = last ? nB : cB + (size_t)(t + 2) * kstep;
            const char* a3 = a2 + kstep; const char* b3 = b2 + kstep;
            if (last && has_next) S.a_ready(nxt);
            PG8_LDB(B0, 0, 0); PG8_LDB(B1, 0, 1); PG8_SCHED; PG8_LDA(At, 0, 0); PG8_STAGE(PG8_SA(1, 1), a1 + hstep, voffA);
            PG8_WAIT_V(8); PG8_WAIT_L(0); PG8_BAR; PG8_MMA(0, 0, At, B0); PG8_MMA(0, 1, At, B1); PG8_BAR; PG8_SCHED;
            PG8_LDA(At, 0, 1); PG8_STAGE(PG8_SB(0, 0), b2, voffB); PG8_STAGE(PG8_SB(0, 1), b2 + hstep, voffB); PG8_STAGE(PG8_SA(0, 0), a2, voffA);
            PG8_WAIT_V(8); PG8_WAIT_L(0); PG8_BAR; PG8_MMA(1, 0, At, B0); PG8_MMA(1, 1, At, B1); PG8_BAR; PG8_SCHED;
            PG8_LDB(B0, 1, 0); PG8_LDB(B1, 1, 1); PG8_SCHED; PG8_LDA(At, 1, 0); PG8_STAGE(PG8_SA(0, 1), a2 + hstep, voffA);
            PG8_WAIT_V(8); PG8_WAIT_L(0); PG8_BAR; PG8_MMA(0, 0, At, B0); PG8_MMA(0, 1, At, B1); PG8_BAR; PG8_SCHED;
            PG8_LDA(At, 1, 1); PG8_STAGE(PG8_SB(1, 0), b3, voffB); PG8_STAGE(PG8_SB(1, 1), b3 + hstep, voffB); PG8_STAGE(PG8_SA(1, 0), a3, voffA);
            PG8_WAIT_V(8); PG8_WAIT_L(0); PG8_BAR; PG8_MMA(1, 0, At, B0); PG8_MMA(1, 1, At, B1); PG8_BAR; PG8_SCHED;
        }
        PG8_STAMP();
        if (wr == 0) PG8_BAR;
        if constexpr (!Epi::AFTER_DRAIN) { const int l2 = lane_id_fresh(); E(acc, cur, wr, wc, l2 & 15, l2 >> 4); S.done(cur); }
        PG8_STAMP();
        if (!has_next) break;
#pragma unroll
        for (int a = 0; a < 2; ++a)
#pragma unroll
            for (int b = 0; b < 2; ++b)
#pragma unroll
                for (int m = 0; m < 4; ++m)
#pragma unroll
                    for (int n = 0; n < 2; ++n) acc[a][b][m][n] = (f32x4){0.f, 0.f, 0.f, 0.f};
        cur = nxt; cA = nA; cB = nB; ++ui;
        if (wr == 1) PG8_BAR;
    }
    PG8_WAIT_V(0);
    PG8_BAR;
    if constexpr (Epi::AFTER_DRAIN) { E.fused(acc, cur, wr, wc, fr, fq, lds, wid, lane); S.done(cur); }
    PG8_STAMP();
    if (STAMP && wid == 0) { stamps[lane] = lane < nts ? (((unsigned long long)(unsigned)ts_hi << 32) | (unsigned)ts_lo) : 0ull;
        if (lane == 62) stamps[62] = rt_entry; if (lane == 63) stamps[63] = (unsigned long long)wall_clock64(); }
#undef PG8_STAMP
#undef PG8_SA
#undef PG8_SB
#undef PG8_STAGE
#undef PG8_LDA
#undef PG8_LDB
#undef PG8_MMA
#undef PG8_WAIT_V
#undef PG8_WAIT_L
#undef PG8_BAR
#undef PG8_SCHED
}
struct GUnit { int pm, pn; const char* aBase; const char* bBase; const int* rows; int nvalid; };
struct EpiSwiGLU {
    static constexpr bool PERM = false, AFTER_DRAIN = false;
    bf16_t* O; int ldh;
    template <class U> __device__ __forceinline__ void operator()(const f32x4 (&acc)[2][2][4][2], const U& u, int wr, int wc, int fr, int fq) const {
        const int row0 = u.pm * BM + wr * 64 + fr, col0 = u.pn * (BM / 2) + wc * 16 + 4 * fq;
#pragma unroll
        for (int ai = 0; ai < 2; ++ai)
#pragma unroll
            for (int m = 0; m < 4; ++m) { bf16_t* rowp = O + (size_t)(row0 + ai * HALF + m * 16) * ldh + col0;
#pragma unroll
                for (int bj = 0; bj < 2; ++bj) { const f32x4 g = acc[ai][bj][m][0], up = acc[ai][bj][m][1]; f32x4 h;
#pragma unroll
                    for (int j = 0; j < 4; ++j) h[j] = g[j] * __builtin_amdgcn_rcpf(1.0f + __expf(-g[j])) * up[j];
                    typedef unsigned u32x2 __attribute__((ext_vector_type(2))); u32x2 w; w.x = cvt_pk_bf16(h[0], h[1]); w.y = cvt_pk_bf16(h[2], h[3]);
                    *(u32x2*)(rowp + bj * (HALF / 2)) = w; } }
    }
};
struct EpiProj {
    static constexpr bool PERM = false, AFTER_DRAIN = false;
    bf16_t* GLU; bf16_t* P16;
    template <class U> __device__ __forceinline__ void operator()(const f32x4 (&acc)[2][2][4][2], const U& u, int wr, int wc, int fr, int fq) const {
        typedef unsigned u32x2 __attribute__((ext_vector_type(2)));
        const int row0 = u.pm * BM + wr * 64 + fr;
        if (u.pn < 8) {
            const int col0 = u.pn * (BM / 2) + wc * 16 + 4 * fq;
#pragma unroll
            for (int ai = 0; ai < 2; ++ai)
#pragma unroll
                for (int m = 0; m < 4; ++m) { bf16_t* rowp = GLU + (size_t)(row0 + ai * HALF + m * 16) * 1024 + col0;
#pragma unroll
                    for (int bj = 0; bj < 2; ++bj) { const f32x4 v = acc[ai][bj][m][0], g = acc[ai][bj][m][1]; f32x4 h;
#pragma unroll
                        for (int j = 0; j < 4; ++j) h[j] = v[j] * __builtin_amdgcn_rcpf(1.0f + __expf(-g[j]));
                        u32x2 w; w.x = cvt_pk_bf16(h[0], h[1]); w.y = cvt_pk_bf16(h[2], h[3]); *(u32x2*)(rowp + bj * (HALF / 2)) = w; } }
        } else {
            const int col0 = (u.pn - 8) * BM + wc * 32 + 4 * fq;
#pragma unroll
            for (int ai = 0; ai < 2; ++ai)
#pragma unroll
                for (int m = 0; m < 4; ++m) { bf16_t* rowp = P16 + (size_t)(row0 + ai * HALF + m * 16) * 3584 + col0;
#pragma unroll
                    for (int bj = 0; bj < 2; ++bj)
#pragma unroll
                        for (int n = 0; n < 2; ++n) { const f32x4 v = acc[ai][bj][m][n]; u32x2 w; w.x = cvt_pk_bf16(v[0], v[1]); w.y = cvt_pk_bf16(v[2], v[3]); *(u32x2*)(rowp + bj * HALF + n * 16) = w; } }
        }
    }
};
template <bool GATHER, class Epi, class Sched>
__device__ __forceinline__ void gemm_phase_g(PG8_LAS unsigned char* lds, const char* Agather, int K, const Sched& S, const Epi& E, int wid) {
    const int lane = lane_id_fresh(), tid = wid * 64 + lane, wr = wid >> 2, wc = wid & 3, fr = lane & 15, fq = lane >> 4;
    const int nt = K / BK;
    unsigned voffA[2], voffB[2]; int RA[2], CA[2];
#pragma unroll
    for (int i = 0; i < 2; ++i) { int R, C; stage_rc(tid * 16 + i * 8192, R, C); const int Rb = Epi::PERM ? ((R & ~31) + perm32(R & 31)) : R;
        voffA[i] = (unsigned)(R * K + C) * 2u; voffB[i] = (unsigned)(Rb * K + C) * 2u; RA[i] = R; CA[i] = C; }
    const size_t kstep = (size_t)(BK * 2);
    const size_t hstep = (size_t)HALF * K * 2;
    const unsigned ldsw = (unsigned)wid * 1024u;
    const int aoff = lds_byte(wr * 64 + fr, fq * 8), boff = lds_byte(wc * 32 + fr, fq * 8);
#define PG8_SA(b, h) (((b) * 2 + (h)) * HTB)
#define PG8_SB(b, h) ((4 + (b) * 2 + (h)) * HTB)
#define PG8_STAGE(bufoff, gbase, voff) do { _Pragma("unroll") for (int _i = 0; _i < 2; ++_i) \
        __builtin_amdgcn_global_load_lds((const unsigned*)((const char*)(gbase) + (voff)[_i]), (PG8_LAS unsigned*)(lds + (bufoff) + ldsw + _i * 8192), 16, 0, 0); } while (0)
#define PG8_STAGE_A(bufoff, ub, h, OFFS) do { if (GATHER) PG8_STAGE(bufoff, ub, OFFS[h]); else PG8_STAGE(bufoff, (ub) + (h) * hstep, voffA); } while (0)
#define PG8_GOFF(dst, un) do { _Pragma("unroll") for (int _h = 0; _h < 2; ++_h) _Pragma("unroll") for (int _i = 0; _i < 2; ++_i) { const int _r = _h * HALF + RA[_i]; \
        const int _tok = (un).rows[_r < (un).nvalid ? _r : 0]; dst[_h][_i] = (unsigned)(_tok * K + CA[_i]) * 2u; } asm volatile("s_waitcnt vmcnt(0)" ::: "memory"); } while (0)
#define PG8_LDA(dst, b, h) do { _Pragma("unroll") for (int m = 0; m < 4; ++m) _Pragma("unroll") for (int k = 0; k < 2; ++k) dst[m][k] = *(const PG8_LAS bf16x8*)(lds + PG8_SA(b, h) + aoff + m * 2048 + k * 1024); } while (0)
#define PG8_LDB(dst, b, h) do { _Pragma("unroll") for (int n = 0; n < 2; ++n) _Pragma("unroll") for (int k = 0; k < 2; ++k) dst[n][k] = *(const PG8_LAS bf16x8*)(lds + PG8_SB(b, h) + boff + n * 2048 + k * 1024); } while (0)
#define PG8_MMA(ai, bj, At, Bt) do { __builtin_amdgcn_s_setprio(1); _Pragma("unroll") for (int m = 0; m < 4; ++m) _Pragma("unroll") for (int n = 0; n < 2; ++n) _Pragma("unroll") for (int k = 0; k < 2; ++k) \
        acc[ai][bj][m][n] = __builtin_amdgcn_mfma_f32_16x16x32_bf16(Bt[n][k], At[m][k], acc[ai][bj][m][n], 0, 0, 0); __builtin_amdgcn_s_setprio(0); } while (0)
#define PG8_WAIT_V(n) asm volatile("s_waitcnt vmcnt(" #n ")" ::: "memory")
#define PG8_WAIT_L(n) asm volatile("s_waitcnt lgkmcnt(" #n ")" ::: "memory")
#define PG8_BAR __builtin_amdgcn_s_barrier()
#define PG8_SCHED __builtin_amdgcn_sched_barrier(0)
    GUnit cur, nxt; int ui = 0;
    if (!S.next(0, cur)) return;
    f32x4 acc[2][2][4][2];
    bf16x8 At[4][2], B0[2][2], B1[2][2];
    unsigned ga[2][2] = {{0u, 0u}, {0u, 0u}}, nga[2][2] = {{0u, 0u}, {0u, 0u}};
    const char* cA = GATHER ? Agather : cur.aBase; const char* cB = cur.bBase;
    if (GATHER) PG8_GOFF(ga, cur);
    PG8_STAGE(PG8_SB(0, 0), cB, voffB); PG8_STAGE(PG8_SB(0, 1), cB + hstep, voffB); PG8_STAGE_A(PG8_SA(0, 0), cA, 0, ga); PG8_STAGE_A(PG8_SA(0, 1), cA, 1, ga);
    if (wr == 1) PG8_BAR;
    PG8_WAIT_V(2); PG8_BAR;
    PG8_STAGE(PG8_SB(1, 0), cB + kstep, voffB); PG8_STAGE_A(PG8_SA(1, 0), cA + kstep, 0, ga); PG8_STAGE(PG8_SB(1, 1), cB + hstep + kstep, voffB);
    PG8_WAIT_V(6); PG8_BAR;
#pragma unroll
    for (int a = 0; a < 2; ++a)
#pragma unroll
        for (int b = 0; b < 2; ++b)
#pragma unroll
            for (int m = 0; m < 4; ++m)
#pragma unroll
                for (int n = 0; n < 2; ++n) acc[a][b][m][n] = (f32x4){0.f, 0.f, 0.f, 0.f};
    for (;;) {
        const bool has_next = S.next(ui + 1, nxt);
        if (GATHER) { if (has_next) PG8_GOFF(nga, nxt); else {
#pragma unroll
            for (int h = 0; h < 2; ++h)
#pragma unroll
                for (int i = 0; i < 2; ++i) nga[h][i] = ga[h][i]; } }
        const char* nA = GATHER ? Agather : (has_next ? nxt.aBase : cA); const char* nB = has_next ? nxt.bBase : cB;
#pragma unroll 1
        for (int t = 0; t < nt; t += 2) {
            const bool last = (t == nt - 2);
            const char* a1 = cA + (size_t)(t + 1) * kstep;
            const char* a2 = last ? nA : cA + (size_t)(t + 2) * kstep; const char* b2 = last ? nB : cB + (size_t)(t + 2) * kstep;
            const char* a3 = a2 + kstep; const char* b3 = b2 + kstep;
            unsigned o2[2][2];
#pragma unroll
            for (int h = 0; h < 2; ++h)
#pragma unroll
                for (int i = 0; i < 2; ++i) o2[h][i] = last ? nga[h][i] : ga[h][i];
            PG8_LDB(B0, 0, 0); PG8_LDB(B1, 0, 1); PG8_SCHED; PG8_LDA(At, 0, 0); PG8_STAGE_A(PG8_SA(1, 1), a1, 1, ga);
            PG8_WAIT_V(8); PG8_WAIT_L(0); PG8_BAR; PG8_MMA(0, 0, At, B0); PG8_MMA(0, 1, At, B1); PG8_BAR; PG8_SCHED;
            PG8_LDA(At, 0, 1); PG8_STAGE(PG8_SB(0, 0), b2, voffB); PG8_STAGE(PG8_SB(0, 1), b2 + hstep, voffB); PG8_STAGE_A(PG8_SA(0, 0), a2, 0, o2);
            PG8_WAIT_V(8); PG8_WAIT_L(0); PG8_BAR; PG8_MMA(1, 0, At, B0); PG8_MMA(1, 1, At, B1); PG8_BAR; PG8_SCHED;
            PG8_LDB(B0, 1, 0); PG8_LDB(B1, 1, 1); PG8_SCHED; PG8_LDA(At, 1, 0); PG8_STAGE_A(PG8_SA(0, 1), a2, 1, o2);
            PG8_WAIT_V(8); PG8_WAIT_L(0); PG8_BAR; PG8_MMA(0, 0, At, B0); PG8_MMA(0, 1, At, B1); PG8_BAR; PG8_SCHED;
            PG8_LDA(At, 1, 1); PG8_STAGE(PG8_SB(1, 0), b3, voffB); PG8_STAGE(PG8_SB(1, 1), b3 + hstep, voffB); PG8_STAGE_A(PG8_SA(1, 0), a3, 0, o2);
            PG8_WAIT_V(8); PG8_WAIT_L(0); PG8_BAR; PG8_MMA(1, 0, At, B0); PG8_MMA(1, 1, At, B1); PG8_BAR; PG8_SCHED;
        }
        if (wr == 0) PG8_BAR;
        { const int l2 = lane_id_fresh(); E(acc, cur, wr, wc, l2 & 15, l2 >> 4); }
        if (!has_next) break;
#pragma unroll
        for (int a = 0; a < 2; ++a)
#pragma unroll
            for (int b = 0; b < 2; ++b)
#pragma unroll
                for (int m = 0; m < 4; ++m)
#pragma unroll
                    for (int n = 0; n < 2; ++n) acc[a][b][m][n] = (f32x4){0.f, 0.f, 0.f, 0.f};
        cur = nxt; cA = nA; cB = nB; ++ui;
#pragma unroll
        for (int h = 0; h < 2; ++h)
#pragma unroll
            for (int i = 0; i < 2; ++i) ga[h][i] = nga[h][i];
        if (wr == 1) PG8_BAR;
    }
    PG8_WAIT_V(0);
    PG8_BAR;
#undef PG8_SA
#undef PG8_SB
#undef PG8_STAGE
#undef PG8_STAGE_A
#undef PG8_GOFF
#undef PG8_LDA
#undef PG8_LDB
#undef PG8_MMA
#undef PG8_WAIT_V
#undef PG8_WAIT_L
#undef PG8_BAR
#undef PG8_SCHED
}
}


#define XB_TMO      128
#define XB_XCNT(j)  (256  + 64 * (j))
#define XB_XSUB(j)  (1280 + 64 * (j))
#define XB_XGEN(j)  (2304 + 64 * (j))
#define XB_TOP      3328
#define XB_TOPGEN   3392
#define XCD_BAR_WORDS 3456
#define XB_SPIN_CAP (1u << 18)
#define LAS __attribute__((address_space(3)))

__device__ __forceinline__ unsigned xb_ld(unsigned* p)              { return __hip_atomic_load(p, __ATOMIC_RELAXED, __HIP_MEMORY_SCOPE_AGENT); }
__device__ __forceinline__ unsigned xb_add(unsigned* p, unsigned v) { return __hip_atomic_fetch_add(p, v, __ATOMIC_RELAXED, __HIP_MEMORY_SCOPE_AGENT); }
__device__ __forceinline__ unsigned xb_xcc_id() { return (unsigned)__builtin_amdgcn_s_getreg((3 << 11) | 20) & 0xFu; }
#define XB_SPIN(cond, bar) do { unsigned _sp = 0; while (cond) { __builtin_amdgcn_s_sleep(1); \
    if ((++_sp & 255u) == 0u) { if (xb_ld(&(bar)[XB_TMO])) break; if (_sp > XB_SPIN_CAP) { atomicAdd(&(bar)[XB_TMO], 1u); break; } } } } while (0)

struct XcdBarrier {
    unsigned* bar; unsigned x; unsigned w0;
    volatile LAS unsigned* st;
};

__device__ __forceinline__ XcdBarrier xcd_barrier_post(unsigned* bar, volatile LAS unsigned* st) {
    XcdBarrier b; b.bar = bar; b.x = xb_xcc_id(); b.st = st; b.w0 = (__builtin_amdgcn_readfirstlane(threadIdx.x >> 6) == 0) ? 1u : 0u;
    if (threadIdx.x == 0) (void)xb_add(&bar[XB_XCNT(b.x)], 1u);
    return b;
}
__device__ __forceinline__ void xcd_barrier_complete(unsigned* bar, unsigned x, unsigned& nloc, unsigned& nx) {
    const unsigned G = gridDim.x * gridDim.y * gridDim.z;
    unsigned sum, cnt, mine, sp = 0u;
    for (;;) {
        sum = 0u; cnt = 0u; mine = 0u;
#pragma unroll
        for (unsigned j = 0; j < 16; ++j) { const unsigned c = xb_ld(&bar[XB_XCNT(j)]); sum += c; cnt += (c > 0u) ? 1u : 0u; mine = (j == x) ? c : mine; }
        if (sum == G) break;
        __builtin_amdgcn_s_sleep(1);
        if ((++sp & 255u) == 0u) { if (xb_ld(&bar[XB_TMO])) break; if (sp > XB_SPIN_CAP) { atomicAdd(&bar[XB_TMO], 1u); break; } }
    }
    nloc = mine > 0u ? mine : 1u; nx = cnt > 0u ? cnt : 1u;
}

__device__ __forceinline__ void xcd_barrier(const XcdBarrier& b) {
    asm volatile("s_waitcnt vmcnt(0)" ::: "memory");
    __syncthreads();
    if (b.w0 != 0u && lane_id_fresh() == 0) {
        unsigned* bar = b.bar;
        __builtin_amdgcn_s_waitcnt(0);
        unsigned nloc = b.st[0], nx = b.st[1];
        if (nloc == 0u) { xcd_barrier_complete(bar, b.x, nloc, nx); b.st[0] = nloc; b.st[1] = nx; }
        const unsigned old = xb_add(&bar[XB_XSUB(b.x)], 1u);
        const unsigned gen = old / nloc;
        if (old + 1u == (gen + 1u) * nloc) {
            __builtin_amdgcn_fence(__ATOMIC_RELEASE, "agent");
            asm volatile("s_waitcnt vmcnt(0)" ::: "memory");
            const unsigned og = xb_add(&bar[XB_TOP], 1u);
            const unsigned tg = og / nx;
            if (og + 1u == (tg + 1u) * nx) xb_add(&bar[XB_TOPGEN], 1u);
            else XB_SPIN(xb_ld(&bar[XB_TOPGEN]) == tg, bar);
            __builtin_amdgcn_fence(__ATOMIC_ACQUIRE, "agent");
            xb_add(&bar[XB_XGEN(b.x)], 1u);
            asm volatile("s_waitcnt vmcnt(0)" ::: "memory");
        } else {
            XB_SPIN(xb_ld(&bar[XB_XGEN(b.x)]) == gen, bar);
            __builtin_amdgcn_fence(__ATOMIC_ACQUIRE, "agent");
            asm volatile("s_waitcnt vmcnt(0)" ::: "memory");
        }
    }
    __syncthreads();
}


#define GAS __attribute__((address_space(1)))
typedef unsigned short bf16;
typedef unsigned v4u __attribute__((ext_vector_type(4)));
typedef float f32x4 __attribute__((ext_vector_type(4)));
#define LDS_WAIT() asm volatile("s_waitcnt lgkmcnt(0)" ::: "memory")
#define VM_WAIT() asm volatile("s_waitcnt vmcnt(0)" ::: "memory")
__device__ __forceinline__ unsigned f2bf(float f) { unsigned u = __builtin_bit_cast(unsigned, f); return (u + 0x7fffu + ((u >> 16) & 1u)) >> 16; }
__device__ __forceinline__ unsigned pk2(float lo, float hi) { return f2bf(lo) | (f2bf(hi) << 16); }
__device__ __forceinline__ float bf2f(unsigned short b) { return __builtin_bit_cast(float, (unsigned)b << 16); }

constexpr int NWAVES = 8, NTHR = NWAVES * 64;
constexpr int RING_OFF = 0, RING_BYTES = 131072;
constexpr int LDSCTL_OFF = 148480, MISC_OFF = LDSCTL_OFF + 320;
constexpr int LDS_BYTES = LDSCTL_OFF + 1024;
constexpr int DINP = 5632;
constexpr int CW_BAR = 4096;

struct Frame {
    LAS unsigned char* lds;
    volatile LAS unsigned* MISC;
    unsigned* ctl;
    int tid, lane, wave, vcu, G;
};

template <class RowMap>
__device__ __forceinline__ void transpose_item(const float* __restrict__ W, int K, int N, bf16* __restrict__ WT, int ldt, const RowMap& rm, LAS float* scr, int item, int lane) {
    const int nblk = N / 32, kb = item / nblk, nb = item % nblk, k0 = 64 * kb, n0 = 32 * nb;
#pragma unroll 8
    for (int i = 0; i < 32; ++i) { const int kk = 2 * i + (lane >> 5); scr[kk * 33 + (lane & 31)] = __builtin_nontemporal_load(W + (size_t)(k0 + kk) * N + n0 + (lane & 31)); }
    LDS_WAIT(); asm volatile("" ::: "memory");
    const int c = lane & 7;
#pragma unroll
    for (int j = 0; j < 4; ++j) { const int n = (lane >> 3) + 8 * j; const LAS float* s = scr + (8 * c) * 33 + n;
        v4u o; o.x = pk2(s[0 * 33], s[1 * 33]); o.y = pk2(s[2 * 33], s[3 * 33]); o.z = pk2(s[4 * 33], s[5 * 33]); o.w = pk2(s[6 * 33], s[7 * 33]);
        *(v4u*)(WT + (size_t)rm(n0 + n) * ldt + k0 + 8 * c) = o; }
    LDS_WAIT(); asm volatile("" ::: "memory");
}
struct RowId { int off; __device__ __forceinline__ int operator()(int n) const { return off + n; } };

__device__ __forceinline__ float wave_sum_x(float v) {
#pragma unroll
    for (int o = 1; o < 64; o <<= 1) v += __shfl_xor(v, o);
    return v;
}
__device__ __forceinline__ void rms_row_to_bf16(const float* __restrict__ xrow, const float* __restrict__ g, bf16* __restrict__ orow, int lane) {
    const f32x4* xr = (const f32x4*)xrow + lane;
    f32x4 v[8]; float s = 0.f;
#pragma unroll
    for (int j = 0; j < 8; ++j) { v[j] = __builtin_nontemporal_load(xr + 64 * j); s += (v[j].x * v[j].x + v[j].y * v[j].y) + (v[j].z * v[j].z + v[j].w * v[j].w); }
    const float rs = rsqrtf(wave_sum_x(s) * (1.0f / D) + 1e-6f);
    const f32x4* g4 = (const f32x4*)g + lane;
    unsigned long long* o8 = (unsigned long long*)orow + lane;
#pragma unroll
    for (int j = 0; j < 8; ++j) { const f32x4 gg = g4[64 * j];
        o8[64 * j] = (unsigned long long)pk2(v[j].x * rs * gg.x, v[j].y * rs * gg.y) | ((unsigned long long)pk2(v[j].z * rs * gg.z, v[j].w * rs * gg.w) << 32); }
}

struct MoeOrder {
    const LAS int* tp; const int* cnt; const int* list;
    int nN, G, c;
    const char* Abase; size_t a_tile_bytes;
    const char* Bbase; size_t b_exp_bytes, b_tile_bytes;
    __device__ __forceinline__ bool next(int i, pg8::GUnit& u) const {
        const int L0 = i * G + c, total = tp[NE] * nN; if (L0 >= total) return false;
        const int q = total >> 3, r = total & 7, xcd = L0 & 7, off = L0 >> 3;
        const int L = (xcd < r ? xcd * (q + 1) : r * (q + 1) + (xcd - r) * q) + off;
        const int mt = L / nN, pn = L - mt * nN;
        const int e = tp[40 + mt];
        const int lt = mt - tp[e];
        u.pm = mt; u.pn = pn;
        u.aBase = Abase + (size_t)mt * a_tile_bytes;
        u.bBase = Bbase + (size_t)e * b_exp_bytes + (size_t)pn * b_tile_bytes;
        u.rows = list + (size_t)e * NT + lt * 256;
        const int rem = cnt[e] - lt * 256; u.nvalid = rem < 256 ? rem : 256;
        return true;
    }
};
struct RowVG { __device__ __forceinline__ int operator()(int n) const { return n >= 2048 ? n : (n < 1024 ? 32 * (n >> 4) + (n & 15) : 32 * ((n - 1024) >> 4) + 16 + (n & 15)); } };
struct RowGU { int up; __device__ __forceinline__ int operator()(int j) const { return 32 * (j >> 4) + (j & 15) + up; } };

__device__ __forceinline__ void router_token(const float* __restrict__ hrow, const float* __restrict__ nf, const float* __restrict__ rgw, const float* __restrict__ rgb,
                                             const float* __restrict__ rew, const float* __restrict__ reb, bf16* __restrict__ vrow, int m, int lane,
                                             int* __restrict__ cnt, int* __restrict__ list, int* __restrict__ asg_e, int* __restrict__ asg_pos, float* __restrict__ gate) {
    const f32x4* xr = (const f32x4*)hrow + lane;
    float s = 0.f;
#pragma unroll
    for (int j = 0; j < 8; ++j) { const f32x4 t = xr[64 * j]; s += (t.x * t.x + t.y * t.y) + (t.z * t.z + t.w * t.w); }
    const float rs = rsqrtf(wave_sum_x(s) * (1.0f / D) + 1e-6f);
    const f32x4* g4 = (const f32x4*)nf + lane;
    unsigned long long* o8 = (unsigned long long*)vrow + lane;
    float lg[NG + NE];
#pragma unroll
    for (int i = 0; i < NG + NE; ++i) lg[i] = 0.f;
#pragma unroll 1
    for (int j = 0; j < 8; ++j) {
        const f32x4 gg = g4[64 * j], hv = xr[64 * j];
        f32x4 vv; vv.x = hv.x * rs * gg.x; vv.y = hv.y * rs * gg.y; vv.z = hv.z * rs * gg.z; vv.w = hv.w * rs * gg.w;
        o8[64 * j] = (unsigned long long)pk2(vv.x, vv.y) | ((unsigned long long)pk2(vv.z, vv.w) << 32);
        const int d0 = 4 * (lane + 64 * j);
#pragma unroll
        for (int q = 0; q < 4; ++q) {
            const float x = vv[q];
            const f32x4 rg = *(const f32x4*)(rgw + (size_t)(d0 + q) * NG);
            lg[0] += x * rg.x; lg[1] += x * rg.y; lg[2] += x * rg.z; lg[3] += x * rg.w;
            const f32x4* re = (const f32x4*)(rew + (size_t)(d0 + q) * NE);
#pragma unroll
            for (int e4 = 0; e4 < 8; ++e4) { const f32x4 w = re[e4]; lg[4 + 4 * e4] += x * w.x; lg[5 + 4 * e4] += x * w.y; lg[6 + 4 * e4] += x * w.z; lg[7 + 4 * e4] += x * w.w; }
        }
    }
    const float* rgb_o = rgb; const float* reb_o = reb;
    asm volatile("" : "+s"(rgb_o), "+s"(reb_o));
#pragma unroll
    for (int i = 0; i < NG + NE; ++i) lg[i] = wave_sum_x(lg[i]) + (i < NG ? rgb_o[i] : reb_o[i - NG]);
    int grp = 0; float gm = lg[0];
#pragma unroll
    for (int j = 1; j < NG; ++j) if (lg[j] > gm) { gm = lg[j]; grp = j; }
    float den = 0.f;
#pragma unroll
    for (int j = 0; j < NG; ++j) den += expf(lg[j] - gm);
    const float pg = 1.0f / den;
    int i1 = 0, i2 = 0; float v1 = 0.f, v2 = 0.f;
#pragma unroll
    for (int g = 0; g < NG; ++g) {
        int a1 = 0; float w1 = lg[NG + g * EPG];
#pragma unroll
        for (int j = 1; j < EPG; ++j) if (lg[NG + g * EPG + j] > w1) { w1 = lg[NG + g * EPG + j]; a1 = j; }
        int a2 = 0; float w2 = -3.0e38f;
#pragma unroll
        for (int j = 0; j < EPG; ++j) if (j != a1 && lg[NG + g * EPG + j] > w2) { w2 = lg[NG + g * EPG + j]; a2 = j; }
        if (g == 0 || grp == g) { i1 = a1; i2 = a2; v1 = w1; v2 = w2; }
    }
    const float e2 = expf(v2 - v1);
    if (lane == 0) {
        const int ea = grp * EPG + i1, eb = grp * EPG + i2;
        gate[2 * m] = pg / (1.0f + e2); gate[2 * m + 1] = pg * e2 / (1.0f + e2);
        const int pa = atomicAdd(&cnt[ea], 1); list[(size_t)ea * NT + pa] = m; asg_e[2 * m] = ea; asg_pos[2 * m] = pa;
        const int pb = atomicAdd(&cnt[eb], 1); list[(size_t)eb * NT + pb] = m; asg_e[2 * m + 1] = eb; asg_pos[2 * m + 1] = pb;
    }
}
__device__ __forceinline__ void final_token(const bf16* __restrict__ hrow, const bf16* __restrict__ y1, const bf16* __restrict__ y2, float g1, float g2,
                                            const float* __restrict__ nf, float* __restrict__ orow, int lane) {
    f32x4 v[8]; float s = 0.f;
#pragma unroll
    for (int j = 0; j < 4; ++j) {
        const int c = lane + 64 * j;
        const v4u hq = __builtin_nontemporal_load((const v4u*)hrow + c); f32x4 ha, hb;
        ha.x = __builtin_bit_cast(float, hq.x << 16); ha.y = __builtin_bit_cast(float, hq.x & 0xffff0000u); ha.z = __builtin_bit_cast(float, hq.y << 16); ha.w = __builtin_bit_cast(float, hq.y & 0xffff0000u);
        hb.x = __builtin_bit_cast(float, hq.z << 16); hb.y = __builtin_bit_cast(float, hq.z & 0xffff0000u); hb.z = __builtin_bit_cast(float, hq.w << 16); hb.w = __builtin_bit_cast(float, hq.w & 0xffff0000u);
        const v4u a = __builtin_nontemporal_load((const v4u*)y1 + c), b = __builtin_nontemporal_load((const v4u*)y2 + c);
        f32x4 ya, yb, za, zb;
        ya.x = __builtin_bit_cast(float, a.x << 16); ya.y = __builtin_bit_cast(float, a.x & 0xffff0000u); ya.z = __builtin_bit_cast(float, a.y << 16); ya.w = __builtin_bit_cast(float, a.y & 0xffff0000u);
        yb.x = __builtin_bit_cast(float, a.z << 16); yb.y = __builtin_bit_cast(float, a.z & 0xffff0000u); yb.z = __builtin_bit_cast(float, a.w << 16); yb.w = __builtin_bit_cast(float, a.w & 0xffff0000u);
        za.x = __builtin_bit_cast(float, b.x << 16); za.y = __builtin_bit_cast(float, b.x & 0xffff0000u); za.z = __builtin_bit_cast(float, b.y << 16); za.w = __builtin_bit_cast(float, b.y & 0xffff0000u);
        zb.x = __builtin_bit_cast(float, b.z << 16); zb.y = __builtin_bit_cast(float, b.z & 0xffff0000u); zb.z = __builtin_bit_cast(float, b.w << 16); zb.w = __builtin_bit_cast(float, b.w & 0xffff0000u);
        v[2 * j] = ha + g1 * ya + g2 * za; v[2 * j + 1] = hb + g1 * yb + g2 * zb;
        s += (v[2 * j].x * v[2 * j].x + v[2 * j].y * v[2 * j].y) + (v[2 * j].z * v[2 * j].z + v[2 * j].w * v[2 * j].w);
        s += (v[2 * j + 1].x * v[2 * j + 1].x + v[2 * j + 1].y * v[2 * j + 1].y) + (v[2 * j + 1].z * v[2 * j + 1].z + v[2 * j + 1].w * v[2 * j + 1].w);
    }
    const float rs = rsqrtf(wave_sum_x(s) * (1.0f / D) + 1e-6f);
#pragma unroll
    for (int j = 0; j < 4; ++j) {
        const int c = lane + 64 * j;
        const f32x4 ga = ((const f32x4*)nf)[2 * c], gb = ((const f32x4*)nf)[2 * c + 1];
        __builtin_nontemporal_store(v[2 * j] * rs * ga, (f32x4*)orow + 2 * c); __builtin_nontemporal_store(v[2 * j + 1] * rs * gb, (f32x4*)orow + 2 * c + 1);
    }
}
typedef short bf16x8_t __attribute__((ext_vector_type(8)));
typedef float f32x16 __attribute__((ext_vector_type(16)));
constexpr int TS = 144;
constexpr int FS = 68;
constexpr int SX_AT = 0, SX_RT = 9216, SX_BT = 18432, SX_KT = 27648, SX_VT = 36864, SX_BHT = 46080, SX_KHT = 55296,
              SX_AAK = 64512, SX_ARB = 73728, SX_ARK = 82944, SX_WT = 92160, SX_U0T = 101376, SX_AABT = 110592, SX_XU = SX_BT,
              SX_XW = 128000, SX_TOT = 145408, SX_PC = 147456;
static_assert(SX_AABT + 64 * FS * 4 <= SX_XW && SX_XW + 64 * FS * 4 <= SX_TOT && SX_TOT + 2048 <= SX_PC && SX_PC + 256 <= LDSCTL_OFF && 64 * FS * 4 <= 2 * 9216, "scan X LDS map");
constexpr int NUNITS = BATCH * NH * (T / 64);

__device__ __forceinline__ f32x16 mma_nt(const LAS unsigned char* X, int rx, const LAS unsigned char* Y, int ry, f32x16 acc, int lane) {
    const int r = lane & 31, h = lane >> 5;
#pragma unroll
    for (int s = 0; s < 4; ++s) {
        const bf16x8_t a = *(const LAS bf16x8_t*)(X + (rx + r) * TS + (16 * s + 8 * h) * 2);
        const bf16x8_t b = *(const LAS bf16x8_t*)(Y + (ry + r) * TS + (16 * s + 8 * h) * 2);
        acc = __builtin_amdgcn_mfma_f32_32x32x16_bf16(a, b, acc, 0, 0, 0);
    }
    return acc;
}
#define CROW(reg, lane) (((reg) & 3) + 8 * ((reg) >> 2) + 4 * ((lane) >> 5))
__device__ __forceinline__ f32x16 zero16() { f32x16 z;
#pragma unroll
    for (int i = 0; i < 16; ++i) z[i] = 0.f; return z; }

struct PrepIn { const bf16* proj; const bf16* lora; const float* mu; const float* w0; const float* a0; const float* k_k; const float* k_a; const float* r_k; bf16* bonus; bf16* g16; };
__device__ __forceinline__ float wave_sum_dpp(float v) {
    v += __builtin_bit_cast(float, __builtin_amdgcn_update_dpp(0, __builtin_bit_cast(int, v), 0xB1, 0xF, 0xF, true));
    v += __builtin_bit_cast(float, __builtin_amdgcn_update_dpp(0, __builtin_bit_cast(int, v), 0x4E, 0xF, 0xF, true));
    v += __builtin_bit_cast(float, __builtin_amdgcn_update_dpp(0, __builtin_bit_cast(int, v), 0x141, 0xF, 0xF, true));
    v += __builtin_bit_cast(float, __builtin_amdgcn_update_dpp(0, __builtin_bit_cast(int, v), 0x140, 0xF, 0xF, true));
    const int iv = __builtin_bit_cast(int, v);
    const float s0 = __builtin_bit_cast(float, __builtin_amdgcn_readlane(iv, 0)), s1 = __builtin_bit_cast(float, __builtin_amdgcn_readlane(iv, 16));
    const float s2 = __builtin_bit_cast(float, __builtin_amdgcn_readlane(iv, 32)), s3 = __builtin_bit_cast(float, __builtin_amdgcn_readlane(iv, 48));
    return (s0 + s1) + (s2 + s3);
}
__device__ __forceinline__ unsigned cvt_pk(float lo, float hi) { unsigned r; asm volatile("v_cvt_pk_bf16_f32 %0, %1, %2" : "=v"(r) : "v"(lo), "v"(hi)); return r; }
#define LDS_BARRIER() do { asm volatile("s_waitcnt lgkmcnt(0)" ::: "memory"); __builtin_amdgcn_s_barrier(); asm volatile("" ::: "memory"); } while (0)
struct XRaw { unsigned r[9], k[9], v[9], wl[8], al[8]; float par[8]; };
__device__ __forceinline__ void scan_x_load(const PrepIn& P, int u, int w, int lane, XRaw& X) {
    const int bh = u >> 6, c = u & 63, b = bh >> 4, h = bh & 15, tq = w, col = h * HN + lane;
    const size_t mrow0 = (size_t)b * T + (size_t)c * 64 + tq * 8;
    const bf16* pr = P.proj + mrow0 * LDP;
    const bf16* lo = P.lora + mrow0 * 3072;
    const bool hasprev = (c * 64 + tq * 8) > 0;
    const bf16* pp = pr - (hasprev ? LDP : 0);
    X.par[0] = P.mu[col]; X.par[1] = P.mu[DR + col]; X.par[2] = P.mu[2 * DR + col]; X.par[3] = P.w0[col]; X.par[4] = P.a0[col]; X.par[5] = P.k_k[col]; X.par[6] = P.k_a[col]; X.par[7] = P.r_k[col];
    X.r[0] = pp[col]; X.k[0] = pp[DR + col]; X.v[0] = pp[2 * DR + col];
#pragma unroll
    for (int i = 0; i < 8; ++i) {
        const bf16* ri = pr + (size_t)i * LDP; const bf16* li = lo + (size_t)i * 3072;
        X.r[i + 1] = ri[col]; X.k[i + 1] = ri[DR + col]; X.v[i + 1] = ri[2 * DR + col];
        X.wl[i] = li[col]; X.al[i] = li[1024 + col];
    }
}

constexpr int CV_ITEMS = 3 * NE * 256, CV_SCR = 64 * 65 * 4;
static_assert(8 * CV_SCR <= LDSCTL_OFF, "conversion LDS");
struct CvIn { const float* const* in; bf16* WguT; bf16* WdT; };
struct CvRegs { f32x4 v[16]; };
__device__ __forceinline__ void cv_load64(const CvIn& C, int item, int lane, CvRegs& R) {
    const int m = item / (NE * 256), r = item - m * (NE * 256), e = r >> 8, blk = r & 255;
    const int N = (m == 2) ? D : DE, nb = (m == 2) ? 32 : 8, kb = blk / nb, n0 = (blk - kb * nb) * 64;
    const float* W = C.in[24 + m] + (size_t)e * D * DE + (size_t)(64 * kb) * N + n0;
#pragma unroll
    for (int i = 0; i < 16; ++i) R.v[i] = __builtin_nontemporal_load((const f32x4*)(W + (size_t)(4 * i + (lane >> 4)) * N + 4 * (lane & 15)));
}
__device__ __forceinline__ void cv_finish64(const CvIn& C, int item, LAS float* scr, int lane, const CvRegs& R) {
    const int m = item / (NE * 256), r = item - m * (NE * 256), e = r >> 8, blk = r & 255;
    const int K = (m == 2) ? DE : D, nb = (m == 2) ? 32 : 8, kb = blk / nb, n0 = (blk - kb * nb) * 64;
#pragma unroll
    for (int i = 0; i < 16; ++i) { LAS float* d = scr + (4 * i + (lane >> 4)) * 65 + 4 * (lane & 15); d[0] = R.v[i].x; d[1] = R.v[i].y; d[2] = R.v[i].z; d[3] = R.v[i].w; }
    asm volatile("s_waitcnt lgkmcnt(0)" ::: "memory");
    const int c = lane & 7, nl = lane >> 3;
    bf16* WT = (m == 2) ? C.WdT + (size_t)e * D * DE : C.WguT + (size_t)e * 1024 * D;
#pragma unroll
    for (int i = 0; i < 8; ++i) {
        const int n = n0 + 8 * i + nl, row = (m == 2) ? n : 32 * (n >> 4) + (n & 15) + 16 * m;
        const LAS float* sp = scr + (8 * c) * 65 + 8 * i + nl;
        v4u o; o.x = cvt_pk(sp[0], sp[65]); o.y = cvt_pk(sp[2 * 65], sp[3 * 65]); o.z = cvt_pk(sp[4 * 65], sp[5 * 65]); o.w = cvt_pk(sp[6 * 65], sp[7 * 65]);
        __builtin_nontemporal_store(o, (v4u*)(WT + (size_t)row * K + 64 * kb + 8 * c));
    }
    asm volatile("s_waitcnt lgkmcnt(0)" ::: "memory");
}
constexpr int CV_CHUNK = 8;
__device__ __forceinline__ void cv_queue_run(const CvIn& C, unsigned* qword, int lo, int hi, LAS float* scr, int lane, int max_items = 1 << 30) {
    const int per = (hi - lo) >> 3, x0 = (int)(xb_xcc_id() & 7u);
    int done = 0;
    for (int att = 0; att < 8 && done < max_items; ++att) {
        const int sh = (x0 + att) & 7, slo = lo + sh * per, shi = slo + per;
        while (done < max_items) {
            const int want = (max_items - done) < CV_CHUNK ? (max_items - done) : CV_CHUNK;
            unsigned first = 0u;
            if (lane == 0) first = __hip_atomic_fetch_add(qword + 64 * sh, (unsigned)want, __ATOMIC_RELAXED, __HIP_MEMORY_SCOPE_AGENT);
            const int it0 = slo + (int)__builtin_amdgcn_readfirstlane(first);
            if (it0 >= shi) break;
            {
                const int nit = (shi - it0) < want ? (shi - it0) : want;
                CvRegs A, B;
                cv_load64(C, it0, lane, A);
#pragma unroll 1
                for (int i = 0; i < nit; i += 2) {
                    if (i + 1 < nit) cv_load64(C, it0 + i + 1, lane, B);
                    cv_finish64(C, it0 + i, scr, lane, A);
                    if (i + 2 < nit) cv_load64(C, it0 + i + 2, lane, A);
                    if (i + 1 < nit) cv_finish64(C, it0 + i + 1, scr, lane, B);
                }
            }
            done += want;
        }
    }
}
template <int MODE>
__device__ __forceinline__ void scan_x_phase(Frame& F, const PrepIn& P, bf16* __restrict__ QH, bf16* __restrict__ Y0, float* __restrict__ Mc, float* __restrict__ Nc, int nsx) {
    LAS unsigned char* L = F.lds + RING_OFF;
    const int w = F.wave;
    int u = blockIdx.x;
    if (u >= NUNITS) return;
    XRaw X; scan_x_load(P, u, w, lane_id_fresh(), X);
#pragma unroll 1
    for (; u < NUNITS; u += nsx) {
    const int lane = lane_id_fresh(), tid = w * 64 + lane;
    const int bh = u >> 6, c = u & 63, b = bh >> 4, h = bh & 15;
    const size_t m0 = (size_t)b * T + (size_t)c * 64;
    {
        const int ch = lane, tq = w, col = h * HN + ch;
        const size_t mrow0 = m0 + tq * 8;
        const float mur = X.par[0], muk = X.par[1], muv = X.par[2], w0c = X.par[3], a0c = X.par[4], kkc_ = X.par[5], kac = X.par[6], rkc = X.par[7];
        float cum[8], rr_[8], kk2[8], vv_[8], al_[8], be_[8]; float run = 1.f;
#pragma unroll
        for (int i = 0; i < 8; ++i) {
#define XF(x) __builtin_bit_cast(float, (x) << 16)
            const float cr = XF(X.r[i + 1]), ck = XF(X.k[i + 1]), cv = XF(X.v[i + 1]);
            const bool zp = (i == 0) && (c * 64 + tq * 8 == 0);
            const float pr_ = zp ? 0.f : XF(X.r[i]), pk_ = zp ? 0.f : XF(X.k[i]), pv_ = zp ? 0.f : XF(X.v[i]);
            const float r = cr + (pr_ - cr) * mur, k = ck + (pk_ - ck) * muk, v = cv + (pv_ - cv) * muv;
            const float wl = w0c + XF(X.wl[i]), al = a0c + XF(X.al[i]);
            const float dec = __expf(-0.60653066f * __builtin_amdgcn_rcpf(1.0f + __expf(-wl)));
            const float a = __builtin_amdgcn_rcpf(1.0f + __expf(-al));
            const float kkc = k * kkc_;
            const float kk = kkc * __builtin_amdgcn_rsqf(fmaxf(wave_sum_dpp(kkc * kkc), 1e-24f));
            const float k2 = k * (1.0f + (a - 1.0f) * kac);
            const float bs = wave_sum_dpp(r * k2 * rkc);
            *(LAS unsigned short*)(L + SX_WT + tq * 1024 + i * 128 + ch * 2) = (unsigned short)(cvt_pk(bs * v, 0.f) & 0xffffu);
            rr_[i] = r; kk2[i] = k2; vv_[i] = v; al_[i] = -kk; be_[i] = kk * a;
            run *= dec; cum[i] = run;
        }
        if (MODE == 0) { asm volatile("s_waitcnt lgkmcnt(0)" ::: "memory");
            const v4u bo = *(const LAS v4u*)(L + SX_WT + tq * 1024 + lane * 16);
            *(v4u*)(P.bonus + (size_t)u * 4096 + (tq * 8 + (lane >> 3)) * 64 + 8 * (lane & 7)) = bo; }
        { const int un = u + nsx; if (un < NUNITS) scan_x_load(P, un, w, lane, X); }
        LAS float* tot = (LAS float*)(L + SX_TOT);
        tot[tq * 64 + ch] = run;
        LDS_BARRIER();
        float off = 1.f, pc = 1.f;
#pragma unroll
        for (int q = 0; q < 8; ++q) { const float x = tot[q * 64 + ch]; off *= (q < tq) ? x : 1.f; pc *= x; }
        if (tq == 0) ((LAS float*)(L + SX_PC))[ch] = pc;
        unsigned vt[4], bht[4], kht[4]; float atf[8]; float Pc_last = 0.f;
#pragma unroll
        for (int i = 0; i < 8; ++i) {
            const float Pp = off * cum[i], Pex = (i == 0) ? off : off * cum[i > 0 ? i - 1 : 0], Pi = __builtin_amdgcn_rcpf(Pp), Pc = pc * Pi;
            const float r = rr_[i], k = kk2[i], v = vv_[i], al = al_[i], be = be_[i];
            const int t = tq * 8 + i;
            atf[i] = al * Pex;
            const unsigned ar = cvt_pk(atf[i], r * Pp), bk = cvt_pk(be * Pi, k * Pi);
            *(LAS unsigned short*)(L + SX_AT + t * TS + ch * 2) = (unsigned short)(ar & 0xffffu);
            *(LAS unsigned short*)(L + SX_RT + t * TS + ch * 2) = (unsigned short)(ar >> 16);
            *(LAS unsigned short*)(L + SX_BT + t * TS + ch * 2) = (unsigned short)(bk & 0xffffu);
            *(LAS unsigned short*)(L + SX_KT + t * TS + ch * 2) = (unsigned short)(bk >> 16);
            if (i & 1) { vt[i >> 1] = cvt_pk(vv_[i - 1], v); bht[i >> 1] = cvt_pk(be_[i - 1] * Pc_last, be * Pc); kht[i >> 1] = cvt_pk(kk2[i - 1] * Pc_last, k * Pc); }
            Pc_last = Pc;
        }
        { LAS float* xw = (LAS float*)(L + SX_XW) + ch * FS + tq * 8; *(LAS f32x4*)xw = (f32x4){atf[0], atf[1], atf[2], atf[3]}; *(LAS f32x4*)(xw + 4) = (f32x4){atf[4], atf[5], atf[6], atf[7]}; }
        v4u o; o.x = vt[0]; o.y = vt[1]; o.z = vt[2]; o.w = vt[3]; *(LAS v4u*)(L + SX_VT + ch * TS + tq * 16) = o;
        o.x = bht[0]; o.y = bht[1]; o.z = bht[2]; o.w = bht[3]; *(LAS v4u*)(L + SX_BHT + ch * TS + tq * 16) = o;
        o.x = kht[0]; o.y = kht[1]; o.z = kht[2]; o.w = kht[3]; *(LAS v4u*)(L + SX_KHT + ch * TS + tq * 16) = o;
    }
    LDS_BARRIER();
    if (MODE == 1) continue;
    {
        const int mat = w >> 1, ib = w & 1, r = lane & 31;
        const LAS unsigned char* Xp = L + ((mat < 2) ? SX_AT : SX_RT);
        const LAS unsigned char* Yp = L + ((mat & 1) ? SX_KT : SX_BT);
        const int incl = (mat >= 2) ? 1 : 0;
#pragma unroll
        for (int jb = 0; jb < 2; ++jb) {
            f32x16 acc = zero16();
            if (jb <= ib) acc = mma_nt(Xp, 32 * ib, Yp, 32 * jb, acc, lane);
#pragma unroll
            for (int reg = 0; reg < 16; ++reg) {
                const int t = 32 * ib + CROW(reg, lane), j = 32 * jb + r;
                acc[reg] = (j < t + incl) ? acc[reg] : 0.f;
            }
            if (mat == 0) {
#pragma unroll
                for (int rg = 0; rg < 4; ++rg)
                    *(LAS f32x4*)((LAS float*)(L + SX_AABT) + (32 * jb + r) * FS + 32 * ib + 8 * rg + 4 * (lane >> 5)) = (f32x4){acc[4 * rg], acc[4 * rg + 1], acc[4 * rg + 2], acc[4 * rg + 3]};
            } else {
                LAS unsigned char* dstm = L + (mat == 1 ? SX_AAK : mat == 2 ? SX_ARB : SX_ARK);
#pragma unroll
                for (int reg = 0; reg < 16; reg += 2) { const unsigned pkv = cvt_pk(acc[reg], acc[reg + 1]); const int t = 32 * ib + CROW(reg, lane), j = 32 * jb + r;
                    *(LAS unsigned short*)(dstm + t * TS + j * 2) = (unsigned short)(pkv & 0xffffu); *(LAS unsigned short*)(dstm + (t + 1) * TS + j * 2) = (unsigned short)(pkv >> 16); }
            }
        }
    }
    LDS_BARRIER();
    if (w < 4) {
        const int ib = w >> 1, vb = w & 1, r = lane & 31;
        f32x16 acc = mma_nt(L + SX_AAK, 32 * ib, L + SX_VT, 32 * vb, zero16(), lane);
#pragma unroll
        for (int rg = 0; rg < 4; ++rg)
            *(LAS f32x4*)((LAS float*)(L + SX_XU) + (32 * vb + r) * FS + 32 * ib + 8 * rg + 4 * (lane >> 5)) = (f32x4){acc[4 * rg], acc[4 * rg + 1], acc[4 * rg + 2], acc[4 * rg + 3]};
    } else if (w == 4) {
        const LAS float* ATm = (const LAS float*)(L + SX_AABT);
        const int bb = lane >> 4, j = lane & 15;
        float t[16];
#pragma unroll
        for (int i = 0; i < 16; ++i) t[i] = (i == j) ? 1.f : 0.f;
#pragma unroll
        for (int m = 0; m < 15; ++m) {
            const LAS float* cp = ATm + (16 * bb + m) * FS + 16 * bb;
#pragma unroll
            for (int i4 = (m + 1) / 4; i4 < 4; ++i4) {
                const f32x4 l = *(const LAS f32x4*)(cp + 4 * i4);
                if (4 * i4 + 0 > m) t[4 * i4 + 0] += l.x * t[m];
                if (4 * i4 + 1 > m) t[4 * i4 + 1] += l.y * t[m];
                if (4 * i4 + 2 > m) t[4 * i4 + 2] += l.z * t[m];
                if (4 * i4 + 3 > m) t[4 * i4 + 3] += l.w * t[m];
            }
        }
        LAS float* TBw = (LAS float*)(L + SX_AT) + bb * 320 + j;
#pragma unroll
        for (int i = 0; i < 16; ++i) TBw[i * 20] = t[i];
    }
    LDS_BARRIER();
    {
        const LAS float* AT = (const LAS float*)(L + SX_AABT);
        const LAS float* TB = (const LAS float*)(L + SX_AT);
        LAS float* xb = (LAS float*)(L + (w < 4 ? SX_XW : SX_XU)) + (16 * (w & 3)) * FS;
        const int n = lane & 15, q = lane >> 4;
        LAS float* xcol = xb + n * FS;
#pragma unroll
        for (int b = 0; b < 4; ++b) {
            f32x4 acc0 = (f32x4){0.f, 0.f, 0.f, 0.f}, acc1 = acc0, acc2 = acc0, acc3 = acc0;
#pragma unroll
            for (int k0 = 0; k0 < 16 * b; k0 += 16) {
                const int k = k0 + q;
                const float a0 = AT[k * FS + 16 * b + n], a1 = AT[(k + 4) * FS + 16 * b + n], a2 = AT[(k + 8) * FS + 16 * b + n], a3 = AT[(k + 12) * FS + 16 * b + n];
                const float x0 = xcol[k], x1 = xcol[k + 4], x2 = xcol[k + 8], x3 = xcol[k + 12];
                acc0 = __builtin_amdgcn_mfma_f32_16x16x4f32(a0, x0, acc0, 0, 0, 0); acc1 = __builtin_amdgcn_mfma_f32_16x16x4f32(a1, x1, acc1, 0, 0, 0);
                acc2 = __builtin_amdgcn_mfma_f32_16x16x4f32(a2, x2, acc2, 0, 0, 0); acc3 = __builtin_amdgcn_mfma_f32_16x16x4f32(a3, x3, acc3, 0, 0, 0);
            }
            const f32x4 rhs = *(const LAS f32x4*)(xcol + 16 * b + 4 * q);
            const f32x4 z = (rhs + acc0) + (acc1 + acc2) + acc3;
            const f32x4 tb = *(const LAS f32x4*)(TB + b * 320 + n * 20 + 4 * q);
            f32x4 c = (f32x4){0.f, 0.f, 0.f, 0.f};
            c = __builtin_amdgcn_mfma_f32_16x16x4f32(z.x, tb.x, c, 0, 0, 0); c = __builtin_amdgcn_mfma_f32_16x16x4f32(z.y, tb.y, c, 0, 0, 0);
            c = __builtin_amdgcn_mfma_f32_16x16x4f32(z.z, tb.z, c, 0, 0, 0); c = __builtin_amdgcn_mfma_f32_16x16x4f32(z.w, tb.w, c, 0, 0, 0);
            LAS float* xo = xb + (4 * q) * FS + 16 * b + n;
            xo[0] = c.x; xo[FS] = c.y; xo[2 * FS] = c.z; xo[3 * FS] = c.w;
        }
        LAS unsigned char* dst = L + (w < 4 ? SX_WT : SX_U0T) + (16 * (w & 3) + n) * TS + q * 32;
        const f32x4 p0 = *(const LAS f32x4*)(xcol + 16 * q), p1 = *(const LAS f32x4*)(xcol + 16 * q + 4), p2 = *(const LAS f32x4*)(xcol + 16 * q + 8), p3 = *(const LAS f32x4*)(xcol + 16 * q + 12);
        v4u o; o.x = cvt_pk(p0.x, p0.y); o.y = cvt_pk(p0.z, p0.w); o.z = cvt_pk(p1.x, p1.y); o.w = cvt_pk(p1.z, p1.w); *(LAS v4u*)dst = o;
        o.x = cvt_pk(p2.x, p2.y); o.y = cvt_pk(p2.z, p2.w); o.z = cvt_pk(p3.x, p3.y); o.w = cvt_pk(p3.z, p3.w); *(LAS v4u*)(dst + 16) = o;
    }
    LDS_BARRIER();
    if (MODE == 2) continue;
    asm volatile("" :: "v"(X.r[0]), "v"(X.r[1]), "v"(X.r[2]), "v"(X.r[3]), "v"(X.r[4]), "v"(X.r[5]), "v"(X.r[6]), "v"(X.r[7]), "v"(X.r[8]), "v"(X.k[0]), "v"(X.k[1]), "v"(X.k[2]), "v"(X.k[3]), "v"(X.k[4]), "v"(X.k[5]), "v"(X.k[6]), "v"(X.k[7]), "v"(X.k[8]));
    asm volatile("" :: "v"(X.v[0]), "v"(X.v[1]), "v"(X.v[2]), "v"(X.v[3]), "v"(X.v[4]), "v"(X.v[5]), "v"(X.v[6]), "v"(X.v[7]), "v"(X.v[8]), "v"(X.wl[0]), "v"(X.wl[1]), "v"(X.wl[2]), "v"(X.wl[3]), "v"(X.wl[4]), "v"(X.wl[5]), "v"(X.wl[6]), "v"(X.wl[7]));
    asm volatile("" :: "v"(X.al[0]), "v"(X.al[1]), "v"(X.al[2]), "v"(X.al[3]), "v"(X.al[4]), "v"(X.al[5]), "v"(X.al[6]), "v"(X.al[7]));
    {
        const int mat = w >> 1, ib = w & 1, r = lane & 31;
        LAS float* stg = (LAS float*)(L + (w == 0 ? SX_AT : w == 1 ? SX_AAK : w == 2 ? SX_BT : w == 3 ? SX_KT : SX_AABT + (w - 4) * 8704));
        const LAS unsigned char* XA = L + (mat < 2 ? SX_ARB : SX_BHT);
        const LAS unsigned char* YA = L + ((mat & 1) ? SX_U0T : SX_WT);
        const LAS unsigned char* XB = L + (mat < 2 ? SX_ARK : SX_KHT);
#pragma unroll
        for (int jb = 0; jb < 2; ++jb) {
            f32x16 acc = mma_nt(XA, 32 * ib, YA, 32 * jb, zero16(), lane);
            if (mat & 1) acc = mma_nt(XB, 32 * ib, L + SX_VT, 32 * jb, acc, lane);
#pragma unroll
            for (int reg = 0; reg < 16; ++reg) stg[CROW(reg, lane) * FS + 32 * jb + r] = acc[reg];
        }
        asm volatile("s_waitcnt lgkmcnt(0)" ::: "memory");
        if (MODE != 0) { if (stg[lane] == 123.456f) ((LAS float*)(L + SX_TOT))[lane] = 1.f; }
        else if (mat < 2) {
            bf16* O = (mat == 0 ? QH : Y0) + (size_t)u * 4096 + (32 * ib) * 64 + 8 * (lane & 7);
            f32x4 a[4], b[4]; v4u rt[4];
#pragma unroll
            for (int it = 0; it < 4; ++it) { const int rl = 8 * it + (lane >> 3);
                a[it] = *(const LAS f32x4*)(stg + rl * FS + 8 * (lane & 7)); b[it] = *(const LAS f32x4*)(stg + rl * FS + 8 * (lane & 7) + 4);
                rt[it] = *(const LAS v4u*)(L + SX_RT + (32 * ib + rl) * TS + 16 * (lane & 7)); }
#pragma unroll
            for (int it = 0; it < 4; ++it) { const int rl = 8 * it + (lane >> 3);
                f32x4 x = a[it], y = b[it];
                if (mat == 0) { x.x += __builtin_bit_cast(float, rt[it].x << 16); x.y += __builtin_bit_cast(float, rt[it].x & 0xffff0000u); x.z += __builtin_bit_cast(float, rt[it].y << 16); x.w += __builtin_bit_cast(float, rt[it].y & 0xffff0000u);
                                y.x += __builtin_bit_cast(float, rt[it].z << 16); y.y += __builtin_bit_cast(float, rt[it].z & 0xffff0000u); y.z += __builtin_bit_cast(float, rt[it].w << 16); y.w += __builtin_bit_cast(float, rt[it].w & 0xffff0000u); }
                v4u o; o.x = cvt_pk(x.x, x.y); o.y = cvt_pk(x.z, x.w); o.z = cvt_pk(y.x, y.y); o.w = cvt_pk(y.z, y.w);
                *(v4u*)(O + rl * 64) = o; }
        } else {
            float* O = (mat == 2 ? Mc : Nc) + (size_t)u * 4096 + (32 * ib) * 64 + 4 * (lane & 15);
            f32x4 v[8]; float pcv[8];
#pragma unroll
            for (int it = 0; it < 8; ++it) { const int rl = 4 * it + (lane >> 4);
                v[it] = *(const LAS f32x4*)(stg + rl * FS + 4 * (lane & 15)); pcv[it] = ((const LAS float*)(L + SX_PC))[32 * ib + rl]; }
#pragma unroll
            for (int it = 0; it < 8; ++it) { const int rl = 4 * it + (lane >> 4), d = 32 * ib + rl - 4 * (lane & 15);
                f32x4 x = v[it]; const float p = (mat == 2) ? pcv[it] : 0.f;
                x.x += (d == 0) ? p : 0.f; x.y += (d == 1) ? p : 0.f; x.z += (d == 2) ? p : 0.f; x.w += (d == 3) ? p : 0.f;
                *(f32x4*)(O + rl * 64) = x; }
        }
    }
    LDS_BARRIER();
    }
}

constexpr int SY_M = 0, SY_S = 64 * 65 * 4, SY_P = SY_S + 64 * FS * 4;
__device__ __forceinline__ void scan_y_chain(Frame& F, int bh, const float* __restrict__ Mc, const float* __restrict__ Nc, float* __restrict__ SS) {
    LAS unsigned char* L = F.lds + RING_OFF;
    LAS float* Ms = (LAS float*)(L + SY_M); LAS float* Ss = (LAS float*)(L + SY_S); LAS float* Ps = (LAS float*)(L + SY_P);
    const int tid = F.tid, lane = F.lane, w = F.wave, r = lane & 31, hh = lane >> 5;
    const int tile = w & 3, ti = tile >> 1, tj = tile & 1, kh = w >> 2;
    f32x16 S = zero16();
    for (int i = tid; i < 64 * FS; i += NTHR) Ss[i] = 0.f;
    f32x4 mA, mB; f32x16 nn = zero16();
    { const float* Mg = Mc + (size_t)(bh * 64) * 4096; mA = *(const f32x4*)(Mg + tid * 8); mB = *(const f32x4*)(Mg + tid * 8 + 4);
      if (kh == 0) { const float* Ng = Nc + (size_t)(bh * 64) * 4096;
#pragma unroll
          for (int reg = 0; reg < 16; ++reg) nn[reg] = Ng[(32 * ti + CROW(reg, lane)) * 64 + 32 * tj + r]; } }
    for (int c = 0; c < 64; ++c) {
        const size_t u = (size_t)bh * 64 + c;
        { const int e0 = tid * 8, row = e0 >> 6, col = e0 & 63; LAS float* d = Ms + row * 65 + col;
          d[0] = mA.x; d[1] = mA.y; d[2] = mA.z; d[3] = mA.w; d[4] = mB.x; d[5] = mB.y; d[6] = mB.z; d[7] = mB.w; }
        const f32x16 ncur = nn;
        if (kh == 0) {
#pragma unroll
            for (int reg = 0; reg < 16; ++reg) SS[u * 4096 + (32 * ti + CROW(reg, lane)) * 64 + 32 * tj + r] = S[reg];
        }
        if (c + 1 < 64) {
            const float* Mg = Mc + (u + 1) * 4096; mA = *(const f32x4*)(Mg + tid * 8); mB = *(const f32x4*)(Mg + tid * 8 + 4);
            if (kh == 0) { const float* Ng = Nc + (u + 1) * 4096;
#pragma unroll
                for (int reg = 0; reg < 16; ++reg) nn[reg] = Ng[(32 * ti + CROW(reg, lane)) * 64 + 32 * tj + r]; }
        }
        __syncthreads();
        f32x16 acc = zero16();
#pragma unroll
        for (int s = 0; s < 16; ++s) {
            const int k = 32 * kh + 2 * s + hh;
            acc = __builtin_amdgcn_mfma_f32_32x32x2f32(Ms[(32 * ti + r) * 65 + k], Ss[k * FS + 32 * tj + r], acc, 0, 0, 0);
        }
        if (kh == 1) {
#pragma unroll
            for (int reg = 0; reg < 16; ++reg) Ps[(tile * 16 + reg) * 64 + lane] = acc[reg];
        }
        __syncthreads();
        if (kh == 0) {
#pragma unroll
            for (int reg = 0; reg < 16; ++reg) { S[reg] = acc[reg] + Ps[(tile * 16 + reg) * 64 + lane] + ncur[reg]; Ss[(32 * ti + CROW(reg, lane)) * FS + 32 * tj + r] = S[reg]; }
        }
    }
    __syncthreads();
}

constexpr int SY4_MB = 64 * 65 * 4, SY4_SB = 64 * 17 * 4, SY4_M = 0, SY4_S = 2 * SY4_MB;
__device__ __forceinline__ void scan_y_chain4(Frame& F, int job, const float* __restrict__ Mc, const float* __restrict__ Nc, bf16* __restrict__ SS) {
    LAS unsigned char* L = F.lds + RING_OFF;
    const int tid = F.tid, lane = F.lane, w = F.wave, bh = job >> 2, cq = job & 3;
    const int li = lane & 15, lq = lane >> 4;
    const size_t u0 = (size_t)bh * 64;
    for (int i = tid; i < 64 * 17; i += NTHR) ((LAS float*)(L + SY4_S))[i] = 0.f;
    if (w >= 4) {
        const int lt = tid - 256, row = (16 * lt) >> 6, col = (16 * lt) & 63;
        f32x4 a[4], b[4];
#pragma unroll
        for (int q = 0; q < 4; ++q) { a[q] = *(const f32x4*)(Mc + u0 * 4096 + 16 * lt + 4 * q); b[q] = *(const f32x4*)(Mc + (u0 + 1) * 4096 + 16 * lt + 4 * q); }
        { LAS float* d = (LAS float*)(L + SY4_M) + row * 65 + col;
#pragma unroll
          for (int q = 0; q < 4; ++q) { d[4 * q] = a[q].x; d[4 * q + 1] = a[q].y; d[4 * q + 2] = a[q].z; d[4 * q + 3] = a[q].w; } }
        LDS_BARRIER();
#pragma unroll 1
        for (int c = 0; c < 64; ++c) {
            LAS float* d = (LAS float*)(L + SY4_M + ((c + 1) & 1) * SY4_MB) + row * 65 + col;
#pragma unroll
            for (int q = 0; q < 4; ++q) { d[4 * q] = b[q].x; d[4 * q + 1] = b[q].y; d[4 * q + 2] = b[q].z; d[4 * q + 3] = b[q].w; }
            if (c + 2 < 64) {
#pragma unroll
                for (int q = 0; q < 4; ++q) b[q] = *(const f32x4*)(Mc + (u0 + c + 2) * 4096 + 16 * lt + 4 * q);
            }
            LDS_BARRIER();
        }
    } else {
        const int rb = w;
        f32x4 S = (f32x4){0.f, 0.f, 0.f, 0.f}, n0, n1;
        { const float* Ng = Nc + u0 * 4096 + 16 * cq + li;
#pragma unroll
          for (int reg = 0; reg < 4; ++reg) { n0[reg] = Ng[(16 * rb + 4 * lq + reg) * 64]; n1[reg] = Ng[4096 + (16 * rb + 4 * lq + reg) * 64]; } }
        LDS_BARRIER();
#pragma unroll 1
        for (int c = 0; c < 64; ++c) {
            const size_t u = u0 + c;
            const LAS float* Ms = (const LAS float*)(L + SY4_M + (c & 1) * SY4_MB); const LAS float* Ss = (const LAS float*)(L + SY4_S + (c & 1) * SY4_SB);
            LAS float* Sn = (LAS float*)(L + SY4_S + ((c + 1) & 1) * SY4_SB);
            { typedef unsigned u32x2 __attribute__((ext_vector_type(2)));
              *(u32x2*)(SS + u * 4096 + (size_t)(16 * cq + li) * 64 + 16 * rb + 4 * lq) = (u32x2){cvt_pk(S[0], S[1]), cvt_pk(S[2], S[3])}; }
            f32x4 acc0 = n0, acc1 = (f32x4){0.f, 0.f, 0.f, 0.f};
            n0 = n1;
            if (c + 2 < 64) { const float* Ng = Nc + (u + 2) * 4096 + 16 * cq + li;
#pragma unroll
                for (int reg = 0; reg < 4; ++reg) n1[reg] = Ng[(16 * rb + 4 * lq + reg) * 64]; }
#pragma unroll
            for (int s = 0; s < 16; s += 2) {
                const int k = 4 * s + lq;
                acc0 = __builtin_amdgcn_mfma_f32_16x16x4f32(Ms[(16 * rb + li) * 65 + k], Ss[k * 17 + li], acc0, 0, 0, 0);
                acc1 = __builtin_amdgcn_mfma_f32_16x16x4f32(Ms[(16 * rb + li) * 65 + k + 4], Ss[(k + 4) * 17 + li], acc1, 0, 0, 0);
            }
#pragma unroll
            for (int reg = 0; reg < 4; ++reg) { S[reg] = acc0[reg] + acc1[reg]; Sn[(16 * rb + 4 * lq + reg) * 17 + li] = S[reg]; }
            LDS_BARRIER();
        }
    }
    LDS_BARRIER();
}

constexpr int SZ_Q = 0, SZ_S = 64 * TS, SZ_Y = 2 * 64 * TS, SZ_UNIT = SZ_Y + 64 * 65 * 4;
struct PostIn { const float* gn_g; const float* gn_b; const bf16* bonus; const bf16* lout; bf16* mixed; };
struct ZRaw { v4u q[2], s[2]; unsigned y0[16]; };
__device__ __forceinline__ void scan_z_load(int u, int w, int lane, const bf16* __restrict__ QH, const bf16* __restrict__ Y0, const bf16* __restrict__ SS, ZRaw& R) {
    const int bh = u >> 6, c = u & 63, b = bh >> 4, h = bh & 15, lt = (w & 3) * 64 + lane, r = lane & 31;
    const size_t m0 = (size_t)b * T + (size_t)c * 64;
#pragma unroll
    for (int i = 0; i < 2; ++i) { const int ck = lt + 256 * i, row = ck >> 3, c8 = (ck & 7) * 8;
        R.q[i] = *(const v4u*)(QH + (size_t)u * 4096 + row * 64 + c8);
        R.s[i] = *(const v4u*)(SS + (size_t)u * 4096 + row * 64 + c8); }
    const int tile = w & 3, ti = tile >> 1, tj = tile & 1;
#pragma unroll
    for (int reg = 0; reg < 16; ++reg) R.y0[reg] = Y0[(size_t)u * 4096 + (32 * ti + CROW(reg, lane)) * 64 + 32 * tj + r];
}
__device__ __forceinline__ void scan_z_phase(Frame& F, const bf16* __restrict__ QH, const bf16* __restrict__ Y0, const bf16* __restrict__ SS, const PostIn& Z) {
    typedef unsigned u32x2 __attribute__((ext_vector_type(2)));
    const int w = F.wave, half = w >> 2;
    LAS unsigned char* L = F.lds + RING_OFF + half * SZ_UNIT;
    LAS float* Qs = (LAS float*)(L + SZ_Y);
    int u = half * (int)F.G + (int)blockIdx.x;
    ZRaw R;
    if (u < NUNITS) scan_z_load(u, w, lane_id_fresh(), QH, Y0, SS, R);
#pragma unroll 1
    for (int base = 0; base < NUNITS; base += 2 * (int)F.G, u += 2 * (int)F.G) {
        const bool valid = u < NUNITS;
        const int lane = lane_id_fresh(), lt = (w & 3) * 64 + lane, r = lane & 31, hh = lane >> 5;
        const int uu = valid ? u : 0, bh = uu >> 6, c = uu & 63, b = bh >> 4, h = bh & 15;
        const size_t m0 = (size_t)b * T + (size_t)c * 64;
        const int tile = w & 3, ti = tile >> 1, tj = tile & 1;
        f32x16 acc = zero16();
        if (valid) {
#pragma unroll
            for (int i = 0; i < 2; ++i) { const int ck = lt + 256 * i, row = ck >> 3, c8 = (ck & 7) * 8;
                *(LAS v4u*)(L + SZ_Q + row * TS + c8 * 2) = R.q[i]; *(LAS v4u*)(L + SZ_S + row * TS + c8 * 2) = R.s[i]; }
#pragma unroll
            for (int reg = 0; reg < 16; ++reg) acc[reg] = __builtin_bit_cast(float, R.y0[reg] << 16);
        }
        if (u + 2 * (int)F.G < NUNITS) scan_z_load(u + 2 * (int)F.G, w, lane, QH, Y0, SS, R);
        const int t = lt >> 2, q = lt & 3, col = h * HN + 16 * q;
        const size_t o = (m0 + t) * DR + col;
        v4u bo0 = (v4u){0u, 0u, 0u, 0u}, bo1 = bo0, gt0 = bo0, gt1 = bo0;
        if (valid) { const bf16* bp = Z.bonus + (size_t)uu * 4096 + t * 64 + 16 * q; bo0 = *(const v4u*)bp; bo1 = *(const v4u*)(bp + 8); const bf16* gp = Z.lout + (m0 + t) * 3072 + 2048 + col; gt0 = *(const v4u*)gp; gt1 = *(const v4u*)(gp + 8); }
        LDS_BARRIER();
        if (valid) {
            acc = mma_nt(L + SZ_Q, 32 * ti, L + SZ_S, 32 * tj, acc, lane);
        }
        if (valid) {
#pragma unroll
            for (int reg = 0; reg < 16; ++reg) Qs[(32 * ti + CROW(reg, lane)) * 65 + 32 * tj + r] = acc[reg];
        }
        LDS_BARRIER();
        if (valid) {
            float y[16]; float sm = 0.f;
#pragma unroll
            for (int i = 0; i < 16; ++i) { y[i] = Qs[t * 65 + 16 * q + i]; sm += y[i]; }
            sm += __builtin_bit_cast(float, __builtin_amdgcn_update_dpp(0, __builtin_bit_cast(int, sm), 0xB1, 0xF, 0xF, true));
            sm += __builtin_bit_cast(float, __builtin_amdgcn_update_dpp(0, __builtin_bit_cast(int, sm), 0x4E, 0xF, 0xF, true));
            const float mean = sm * (1.0f / 64.0f); float qv = 0.f;
#pragma unroll
            for (int i = 0; i < 16; ++i) { y[i] -= mean; qv += y[i] * y[i]; }
            qv += __builtin_bit_cast(float, __builtin_amdgcn_update_dpp(0, __builtin_bit_cast(int, qv), 0xB1, 0xF, 0xF, true));
            qv += __builtin_bit_cast(float, __builtin_amdgcn_update_dpp(0, __builtin_bit_cast(int, qv), 0x4E, 0xF, 0xF, true));
            const float rs = rsqrtf(qv * (1.0f / 64.0f) + 64e-5f);
            const unsigned bw[8] = {bo0.x, bo0.y, bo0.z, bo0.w, bo1.x, bo1.y, bo1.z, bo1.w}, gw8[8] = {gt0.x, gt0.y, gt0.z, gt0.w, gt1.x, gt1.y, gt1.z, gt1.w};
            unsigned pk[8];
#pragma unroll
            for (int i4 = 0; i4 < 4; ++i4) {
                const f32x4 gg = *(const f32x4*)(Z.gn_g + col + 4 * i4), gb = *(const f32x4*)(Z.gn_b + col + 4 * i4);
                const unsigned bA = bw[2 * i4], bB = bw[2 * i4 + 1], gA = gw8[2 * i4], gB = gw8[2 * i4 + 1];
                pk[2 * i4] = cvt_pk((y[4 * i4] * rs * gg.x + gb.x + __builtin_bit_cast(float, bA << 16)) * __builtin_bit_cast(float, gA << 16),
                                    (y[4 * i4 + 1] * rs * gg.y + gb.y + __builtin_bit_cast(float, bA & 0xffff0000u)) * __builtin_bit_cast(float, gA & 0xffff0000u));
                pk[2 * i4 + 1] = cvt_pk((y[4 * i4 + 2] * rs * gg.z + gb.z + __builtin_bit_cast(float, bB << 16)) * __builtin_bit_cast(float, gB << 16),
                                        (y[4 * i4 + 3] * rs * gg.w + gb.w + __builtin_bit_cast(float, bB & 0xffff0000u)) * __builtin_bit_cast(float, gB & 0xffff0000u));
            }
            bf16* dst = Z.mixed + (m0 + t) * D + DC + col;
            *(v4u*)dst = (v4u){pk[0], pk[1], pk[2], pk[3]}; *(v4u*)(dst + 8) = (v4u){pk[4], pk[5], pk[6], pk[7]};
        }
        LDS_BARRIER();
    }
}
__device__ __forceinline__ void lora_in_token(const bf16* __restrict__ proj, const float* __restrict__ mu, bf16* __restrict__ lin, int m, int lane) {
    const bf16* p = proj + (size_t)m * LDP + 3 * DR;
    const bool hasprev = (m % T) > 0;
#pragma unroll
    for (int i = 0; i < 6; ++i) {
        const int j = lane + 64 * i;
        float o = 0.f;
        if (j < LW + LA + LG) {
            const float cur = bf2f(p[j]), prv = hasprev ? bf2f(p[j - LDP]) : 0.f;
            const float x = cur + (prv - cur) * mu[3 * DR + j];
            o = (j < LW) ? (1.0f - 2.0f * __builtin_amdgcn_rcpf(1.0f + __expf(2.0f * x))) : (j < LW + LA) ? x : __builtin_amdgcn_rcpf(1.0f + __expf(-x));
        }
        lin[(size_t)m * 384 + j] = (bf16)f2bf(o);
    }
}
constexpr int CV_TT = 32, CV_ROWS = CV_TT + CW - 1, CV_RH = CV_ROWS / 2;
constexpr int CV_RED = CV_ROWS * DC * 2;
static_assert(CV_ROWS % 2 == 0 && CV_RED + 8 * 2 * CV_TT * 4 + 2 * CV_TT * 4 <= LDSCTL_OFF, "conv LDS");
__device__ __forceinline__ void conv_unit(Frame& F, int unit, const bf16* __restrict__ glu, const float* __restrict__ dw, const float* __restrict__ cb,
                                          const float* __restrict__ lng, const float* __restrict__ lnb, bf16* __restrict__ mixed) {
    LAS unsigned char* L = F.lds + RING_OFF;
    const int w = F.wave, lane = lane_id_fresh(), tid = w * 64 + lane;
    const int m0 = unit * CV_TT, tseq0 = m0 % T;
    {
        const int cq = tid & 255, rh = tid >> 8;
        typedef unsigned u32x2 __attribute__((ext_vector_type(2)));
        u32x2 gq[CV_RH];
#pragma unroll
        for (int q = 0; q < CV_RH; ++q) {
            const int rr = rh * CV_RH + q, ts = tseq0 - (CW - 1) + rr;
            gq[q] = (u32x2){0u, 0u};
            if (ts >= 0) gq[q] = *(const u32x2*)(glu + (size_t)(m0 - (CW - 1) + rr) * DC + 4 * cq);
        }
#pragma unroll
        for (int q = 0; q < CV_RH; ++q) *(LAS u32x2*)(L + (rh * CV_RH + q) * (DC * 2) + cq * 8) = gq[q];
    }
    __syncthreads();
    const int c0 = 2 * tid;
    float g0[CV_ROWS], g1[CV_ROWS];
#pragma unroll
    for (int rr = 0; rr < CV_ROWS; ++rr) { const unsigned x = *(const LAS unsigned*)(L + rr * (DC * 2) + c0 * 2); g0[rr] = __builtin_bit_cast(float, x << 16); g1[rr] = __builtin_bit_cast(float, x & 0xffff0000u); }
    float a0[CV_TT], a1[CV_TT];
    { const float b0 = cb[c0], b1 = cb[c0 + 1];
#pragma unroll
      for (int t = 0; t < CV_TT; ++t) { a0[t] = b0; a1[t] = b1; } }
#pragma unroll
    for (int j = 0; j < CW; ++j) {
        const float w0 = dw[j * DC + c0], w1 = dw[j * DC + c0 + 1];
#pragma unroll
        for (int t = 0; t < CV_TT; ++t) { a0[t] += w0 * g0[t + j]; a1[t] += w1 * g1[t + j]; }
        if ((j & 7) == 7) asm volatile("" ::: "memory");
    }
    LAS float* red = (LAS float*)(L + CV_RED);
#pragma unroll
    for (int t = 0; t < CV_TT; ++t) {
        float s = a0[t] + a1[t], q = a0[t] * a0[t] + a1[t] * a1[t];
        s = wave_sum_dpp(s); q = wave_sum_dpp(q);
        if (lane == 0) { red[w * 2 * CV_TT + t] = s; red[w * 2 * CV_TT + CV_TT + t] = q; }
    }
    __syncthreads();
    if (tid < 2 * CV_TT) { float s = 0.f;
#pragma unroll
        for (int k = 0; k < 8; ++k) s += red[k * 2 * CV_TT + tid];
        red[8 * 2 * CV_TT + tid] = s; }
    __syncthreads();
    const float lg0 = lng[c0], lg1 = lng[c0 + 1], lb0 = lnb[c0], lb1 = lnb[c0 + 1];
#pragma unroll
    for (int t = 0; t < CV_TT; ++t) {
        const float mu = red[8 * 2 * CV_TT + t] * (1.0f / DC), var = red[8 * 2 * CV_TT + CV_TT + t] * (1.0f / DC) - mu * mu;
        const float rs = rsqrtf(fmaxf(var, 0.f) + 1e-5f);
        const float z0 = (a0[t] - mu) * rs * lg0 + lb0, z1 = (a1[t] - mu) * rs * lg1 + lb1;
        *(unsigned*)(mixed + (size_t)(m0 + t) * D + c0) = cvt_pk(z0 * __builtin_amdgcn_rcpf(1.0f + __expf(-z0)), z1 * __builtin_amdgcn_rcpf(1.0f + __expf(-z1)));
    }
    __syncthreads();
}

__device__ __forceinline__ void rms_row16_to_bf16(const bf16* __restrict__ hrow, const float* __restrict__ g, bf16* __restrict__ orow, int lane) {
    float v[32]; float s = 0.f;
#pragma unroll
    for (int j = 0; j < 4; ++j) { const v4u a = ((const v4u*)hrow)[lane + 64 * j];
        v[8 * j] = __builtin_bit_cast(float, a.x << 16); v[8 * j + 1] = __builtin_bit_cast(float, a.x & 0xffff0000u); v[8 * j + 2] = __builtin_bit_cast(float, a.y << 16); v[8 * j + 3] = __builtin_bit_cast(float, a.y & 0xffff0000u);
        v[8 * j + 4] = __builtin_bit_cast(float, a.z << 16); v[8 * j + 5] = __builtin_bit_cast(float, a.z & 0xffff0000u); v[8 * j + 6] = __builtin_bit_cast(float, a.w << 16); v[8 * j + 7] = __builtin_bit_cast(float, a.w & 0xffff0000u);
#pragma unroll
        for (int q = 0; q < 8; ++q) s += v[8 * j + q] * v[8 * j + q]; }
    const float rs = rsqrtf(wave_sum_x(s) * (1.0f / D) + 1e-6f);
#pragma unroll
    for (int j = 0; j < 4; ++j) { const int c = lane + 64 * j; const f32x4 ga = ((const f32x4*)g)[2 * c], gb = ((const f32x4*)g)[2 * c + 1];
        v4u o; o.x = pk2(v[8 * j] * rs * ga.x, v[8 * j + 1] * rs * ga.y); o.y = pk2(v[8 * j + 2] * rs * ga.z, v[8 * j + 3] * rs * ga.w);
        o.z = pk2(v[8 * j + 4] * rs * gb.x, v[8 * j + 5] * rs * gb.y); o.w = pk2(v[8 * j + 6] * rs * gb.z, v[8 * j + 7] * rs * gb.w);
        ((v4u*)orow)[c] = o; }
}

__device__ __forceinline__ void rms_raw16_to_bf16(const v4u (&a)[4], const float* __restrict__ g, bf16* __restrict__ orow, int lane) {
    float s = 0.f;
#pragma unroll
    for (int j = 0; j < 4; ++j) {
        const unsigned wv[4] = {a[j].x, a[j].y, a[j].z, a[j].w};
#pragma unroll
        for (int q = 0; q < 4; ++q) { const float lo = __builtin_bit_cast(float, wv[q] << 16), hi = __builtin_bit_cast(float, wv[q] & 0xffff0000u); s += lo * lo + hi * hi; } }
    const float rs = rsqrtf(wave_sum_x(s) * (1.0f / D) + 1e-6f);
#pragma unroll
    for (int j = 0; j < 4; ++j) { const int c = lane + 64 * j; const f32x4 ga = ((const f32x4*)g)[2 * c], gb = ((const f32x4*)g)[2 * c + 1];
        v4u o;
        o.x = pk2(__builtin_bit_cast(float, a[j].x << 16) * rs * ga.x, __builtin_bit_cast(float, a[j].x & 0xffff0000u) * rs * ga.y);
        o.y = pk2(__builtin_bit_cast(float, a[j].y << 16) * rs * ga.z, __builtin_bit_cast(float, a[j].y & 0xffff0000u) * rs * ga.w);
        o.z = pk2(__builtin_bit_cast(float, a[j].z << 16) * rs * gb.x, __builtin_bit_cast(float, a[j].z & 0xffff0000u) * rs * gb.y);
        o.w = pk2(__builtin_bit_cast(float, a[j].w << 16) * rs * gb.z, __builtin_bit_cast(float, a[j].w & 0xffff0000u) * rs * gb.w);
        ((v4u*)orow)[c] = o; }
}
constexpr int RT_PC = 0, RT_PG = RT_PC + 8 * 16 * 64 * 4, RT_PSS = RT_PG + 8 * 16 * 64 * 4, RT_LG = RT_PSS + 8 * 64 * 4, RT_SS = RT_LG + 32 * 40 * 4, RT_HIST = RT_SS + 128, RT_BASE = RT_HIST + 128, RT_END = RT_BASE + 128;
static_assert(RT_END <= LDSCTL_OFF, "router LDS");
__device__ __forceinline__ void router_block(Frame& F, int blk, const bf16* __restrict__ H, const bf16* __restrict__ RW, const float* __restrict__ nf, const float* __restrict__ rgb,
                                             const float* __restrict__ reb, bf16* __restrict__ VN, int* __restrict__ cnt, int* __restrict__ list,
                                             int* __restrict__ asg_e, int* __restrict__ asg_pos, float* __restrict__ gate) {
    LAS unsigned char* L = F.lds + RING_OFF;
    const int tid = F.tid, lane = F.lane, w = F.wave, r = lane & 31, hh = lane >> 5;
    const int m0 = blk * 32;
    LAS float* Pc = (LAS float*)(L + RT_PC); LAS float* Pg = (LAS float*)(L + RT_PG); LAS float* Pss = (LAS float*)(L + RT_PSS); LAS float* Lg = (LAS float*)(L + RT_LG); LAS float* Ssq = (LAS float*)(L + RT_SS);
    LAS int* hist = (LAS int*)(L + RT_HIST); LAS int* base = (LAS int*)(L + RT_BASE);
    if (tid < 32) hist[tid] = 0;
    f32x16 acce = zero16(), accg = zero16(); float ss = 0.f;
    const bf16* arow = H + (size_t)(m0 + r) * D + 256 * w + 8 * hh;
    const bf16* bhi = RW + (size_t)r * D + 256 * w + 8 * hh; const bf16* blo = bhi + 64 * D;
#pragma unroll 4
    for (int s2 = 0; s2 < 16; ++s2) {
        const bf16x8_t av = *(const bf16x8_t*)(arow + 16 * s2);
        const bf16x8_t b0 = *(const bf16x8_t*)(bhi + 16 * s2), b1 = *(const bf16x8_t*)(blo + 16 * s2), b2 = *(const bf16x8_t*)(bhi + 32 * D + 16 * s2), b3 = *(const bf16x8_t*)(blo + 32 * D + 16 * s2);
#pragma unroll
        for (int j = 0; j < 8; ++j) { const float x = __builtin_bit_cast(float, (unsigned)(unsigned short)av[j] << 16); ss += x * x; }
        acce = __builtin_amdgcn_mfma_f32_32x32x16_bf16(av, b0, acce, 0, 0, 0); acce = __builtin_amdgcn_mfma_f32_32x32x16_bf16(av, b1, acce, 0, 0, 0);
        accg = __builtin_amdgcn_mfma_f32_32x32x16_bf16(av, b2, accg, 0, 0, 0); accg = __builtin_amdgcn_mfma_f32_32x32x16_bf16(av, b3, accg, 0, 0, 0);
    }
#pragma unroll
    for (int reg = 0; reg < 16; ++reg) { Pc[(w * 16 + reg) * 64 + lane] = acce[reg]; Pg[(w * 16 + reg) * 64 + lane] = accg[reg]; }
    Pss[w * 64 + lane] = ss;
    v4u hr0[4], hr1[4], hr2[4], hr3[4];
#pragma unroll
    for (int j = 0; j < 4; ++j) { hr0[j] = ((const v4u*)(H + (size_t)(m0 + 4 * w + 0) * D))[lane + 64 * j]; hr1[j] = ((const v4u*)(H + (size_t)(m0 + 4 * w + 1) * D))[lane + 64 * j];
                                  hr2[j] = ((const v4u*)(H + (size_t)(m0 + 4 * w + 2) * D))[lane + 64 * j]; hr3[j] = ((const v4u*)(H + (size_t)(m0 + 4 * w + 3) * D))[lane + 64 * j]; }
    __syncthreads();
#pragma unroll
    for (int i = 0; i < 2; ++i) {
        const int slot = tid + 512 * i, reg = slot >> 6, ln = slot & 63;
        float sum = 0.f;
#pragma unroll
        for (int ww = 0; ww < 8; ++ww) sum += Pc[(ww * 16 + reg) * 64 + ln];
        Lg[CROW(reg, ln) * 40 + NG + (ln & 31)] = sum;
    }
    if (tid < 128) {
        const int t = tid & 31, c = tid >> 5, ln = c + 32 * ((t >> 2) & 1), reg = (t & 3) + 4 * (t >> 3); float sum = 0.f;
#pragma unroll
        for (int ww = 0; ww < 8; ++ww) sum += Pg[(ww * 16 + reg) * 64 + ln];
        Lg[t * 40 + c] = sum;
    } else if (tid < 160) {
        const int t = tid - 128; float sum = 0.f;
#pragma unroll
        for (int ww = 0; ww < 8; ++ww) sum += Pss[ww * 64 + t] + Pss[ww * 64 + 32 + t];
        Ssq[t] = sum;
    }
    __syncthreads();
    int ea = 0, eb = 0, pa = 0, pb = 0;
    if (tid < 32) {
        const int m = m0 + tid;
        const float rs = rsqrtf(Ssq[tid] * (1.0f / D) + 1e-6f);
        float lg[NG + NE];
#pragma unroll
        for (int i = 0; i < NG + NE; ++i) lg[i] = Lg[tid * 40 + i] * rs + (i < NG ? rgb[i] : reb[i - NG]);
        int grp = 0; float gm = lg[0];
#pragma unroll
        for (int j = 1; j < NG; ++j) if (lg[j] > gm) { gm = lg[j]; grp = j; }
        float den = 0.f;
#pragma unroll
        for (int j = 0; j < NG; ++j) den += expf(lg[j] - gm);
        const float pg = 1.0f / den;
        int i1 = 0, i2 = 0; float v1 = 0.f, v2 = 0.f;
#pragma unroll
        for (int g = 0; g < NG; ++g) {
            int a1 = 0; float w1 = lg[NG + g * EPG];
#pragma unroll
            for (int j = 1; j < EPG; ++j) if (lg[NG + g * EPG + j] > w1) { w1 = lg[NG + g * EPG + j]; a1 = j; }
            int a2 = 0; float w2 = -3.0e38f;
#pragma unroll
            for (int j = 0; j < EPG; ++j) if (j != a1 && lg[NG + g * EPG + j] > w2) { w2 = lg[NG + g * EPG + j]; a2 = j; }
            if (g == 0 || grp == g) { i1 = a1; i2 = a2; v1 = w1; v2 = w2; }
        }
        const float e2 = expf(v2 - v1);
        ea = grp * EPG + i1; eb = grp * EPG + i2;
        gate[2 * m] = pg / (1.0f + e2); gate[2 * m + 1] = pg * e2 / (1.0f + e2);
        pa = atomicAdd((int*)&hist[ea], 1); pb = atomicAdd((int*)&hist[eb], 1);
    }
    __syncthreads();
    if (tid < 32) { const int c = hist[tid]; base[tid] = c > 0 ? atomicAdd(&cnt[tid], c) : 0; }
    __syncthreads();
    if (tid < 32) {
        const int m = m0 + tid; pa += base[ea]; pb += base[eb];
        list[(size_t)ea * NT + pa] = m; asg_e[2 * m] = ea; asg_pos[2 * m] = pa;
        list[(size_t)eb * NT + pb] = m; asg_e[2 * m + 1] = eb; asg_pos[2 * m + 1] = pb;
    }
    rms_raw16_to_bf16(hr0, nf, VN + (size_t)(m0 + 4 * w + 0) * D, lane); rms_raw16_to_bf16(hr1, nf, VN + (size_t)(m0 + 4 * w + 1) * D, lane);
    rms_raw16_to_bf16(hr2, nf, VN + (size_t)(m0 + 4 * w + 2) * D, lane); rms_raw16_to_bf16(hr3, nf, VN + (size_t)(m0 + 4 * w + 3) * D, lane);
    __syncthreads();
}


struct Args { const float* in[28]; float* out; unsigned char* ws; int ph_lo, ph_hi; };

constexpr size_t FW_CTL = 0, CTL_ZERO_BYTES = 64 * 1024, FW_LIST = 1, FW_ASG = 2, FW_WOUT = 3;
constexpr size_t FW_WGU = 11, FW_WD = 139, FW_WINT = 364, FW_U16 = 386, FW_PROJ = 203, FW_SS = 203, FW_GLU = 259, FW_BONUS = 259, FW_LOUT = 275, FW_Y2 = 203;
constexpr size_t FW_LORAT = 323, FW_LIN = 326, FW_MIXED = 332, FW_QH = 364, FW_Y0 = 396, FW_H = 364, FW_MC = 428, FW_VN16 = 428, FW_NC = 460, FW_HID = 460, FW_G16 = 492, FW_END = 508;
static_assert(FW_WGU + 128 <= FW_WD && FW_WD + 64 <= FW_PROJ && FW_U16 + 32 <= FW_MC && FW_PROJ + 56 <= FW_GLU && FW_GLU + 16 <= FW_LOUT && FW_LOUT + 48 <= FW_LORAT && FW_Y2 + 96 <= FW_LORAT && FW_LIN + 6 <= FW_MIXED && FW_HID + 24 <= FW_G16, "d_ws map");
constexpr int CW_CNT = 8192, CW_CVQ = 8320, CW_CVQ2 = 8320 + 8 * 64;
constexpr int TP_OFF = MISC_OFF + 128;
constexpr int NPH = 12;
#ifndef DUPMASK
#define DUPMASK 0
#endif
#define NREP(k) (1 + ((DUPMASK >> (k)) & 1))

__global__ void __launch_bounds__(NTHR, 2) mk_fwd(Args args) {
    extern __shared__ __attribute__((aligned(16))) unsigned char lds_raw[];
    Frame F;
    F.lds = (LAS unsigned char*)lds_raw;
    F.MISC = (volatile LAS unsigned*)(F.lds + MISC_OFF);
    F.wave = __builtin_amdgcn_readfirstlane(threadIdx.x >> 6); F.lane = lane_id_fresh(); F.tid = F.wave * 64 + F.lane;
#define REFRESH() do { F.lane = lane_id_fresh(); F.tid = F.wave * 64 + F.lane; } while (0)
    F.G = gridDim.x; { const int bx = blockIdx.x; F.vcu = (F.G % 8 == 0) ? (bx % 8) * (F.G / 8) + bx / 8 : bx; }
    unsigned char* ws = args.ws;
    F.ctl = (unsigned*)(ws + FW_CTL * MiB);
    for (int u = F.tid; u < (LDS_BYTES - LDSCTL_OFF) / 4; u += NTHR) ((LAS unsigned*)(F.lds + LDSCTL_OFF))[u] = 0u;
    __syncthreads();
    XcdBarrier bar = xcd_barrier_post(F.ctl + CW_BAR, F.MISC + 8);
    const int lo = args.ph_lo, hi = args.ph_hi;
#define IN(k) (lo <= (k) && (k) < hi)
#define BOTH(k) (IN(k) && IN((k) + 1))
    const int gw = F.vcu * NWAVES + F.wave, NGW = F.G * NWAVES;
    bf16* P16 = (bf16*)(ws + FW_PROJ * MiB); bf16* GLUb = (bf16*)(ws + FW_GLU * MiB);
    bf16* WguT = (bf16*)(ws + FW_WGU * MiB); bf16* WdT = (bf16*)(ws + FW_WD * MiB); bf16* WoutT = (bf16*)(ws + FW_WOUT * MiB); bf16* LoraT = (bf16*)(ws + FW_LORAT * MiB);
    bf16* LIN = (bf16*)(ws + FW_LIN * MiB); bf16* WinT = (bf16*)(ws + FW_WINT * MiB); bf16* U16 = (bf16*)(ws + FW_U16 * MiB);
    bf16* BONUS = (bf16*)(ws + FW_BONUS * MiB); bf16* G16 = (bf16*)(ws + FW_G16 * MiB); bf16* Y2 = (bf16*)(ws + FW_Y2 * MiB);
    bf16* MIXED16 = (bf16*)(ws + FW_MIXED * MiB); bf16* LOUT = (bf16*)(ws + FW_LOUT * MiB); bf16* SSp = (bf16*)(ws + FW_SS * MiB);
    bf16* QHp = (bf16*)(ws + FW_QH * MiB); bf16* Y0p = (bf16*)(ws + FW_Y0 * MiB); bf16* Hh = (bf16*)(ws + FW_H * MiB);
    float* Mcp = (float*)(ws + FW_MC * MiB); bf16* VN16 = (bf16*)(ws + FW_VN16 * MiB); float* Ncp = (float*)(ws + FW_NC * MiB); bf16* HID = (bf16*)(ws + FW_HID * MiB);
    int* list = (int*)(ws + FW_LIST * MiB); int* asg_e = (int*)(ws + FW_ASG * MiB); int* asg_pos = asg_e + 2 * NT; float* gate = (float*)(asg_pos + 2 * NT);
    int* cnt = (int*)(F.ctl + CW_CNT);
    bf16* RWp = (bf16*)(ws + FW_ASG * MiB + 512 * 1024);
    LAS int* tp = (LAS int*)(F.lds + TP_OFF);
    LAS float* scr = (LAS float*)(F.lds + RING_OFF + F.wave * 16384);

    if (IN(0)) for (int rep = 0; rep < NREP(0); ++rep) {
        if (rep) xcd_barrier(bar);
        REFRESH();
        constexpr int I_IN = (D / 64) * (DIN / 32), I_O = (D / 64) * (D / 32);
        for (int it = gw; it < I_IN + I_O; it += NGW) {
            if (it < I_IN) transpose_item(args.in[2], D, DIN, WinT, D, RowVG{}, scr, it, F.lane);
            else transpose_item(args.in[18], D, D, WoutT, D, RowId{0}, scr, it - I_IN, F.lane);
        }
        { v4u z; z.x = 0u; z.y = 0u; z.z = 0u; z.w = 0u; v4u* p = (v4u*)(WinT + (size_t)DIN * D);
          const int nz = (DINP - DIN) * D / 8;
          for (int i = blockIdx.x * NTHR + F.tid; i < nz; i += F.G * NTHR) p[i] = z; }
        for (int i = blockIdx.x * NTHR + F.tid; i < 3072 * 48; i += F.G * NTHR) {
            const int n = i % 3072, j0 = (i / 3072) * 8;
            const int blk = n >> 10, nn = n & 1023;
            float v[8];
#pragma unroll
            for (int q = 0; q < 8; ++q) { const int j = j0 + q; float x = 0.f;
                if (blk == 0) { if (j < 64) x = args.in[9][(size_t)j * DR + nn]; }
                else if (blk == 1) { if (j >= 64 && j < 128) x = args.in[11][(size_t)(j - 64) * DR + nn]; }
                else { if (j >= 128 && j < 288) x = args.in[12][(size_t)(j - 128) * DR + nn]; }
                v[q] = x; }
            v4u o; o.x = pk2(v[0], v[1]); o.y = pk2(v[2], v[3]); o.z = pk2(v[4], v[5]); o.w = pk2(v[6], v[7]);
            *(v4u*)(LoraT + (size_t)n * 384 + j0) = o;
        }
        for (int i = blockIdx.x * NTHR + F.tid; i < 64 * (D / 8); i += F.G * NTHR) {
            const int row = i / (D / 8), k0 = (i % (D / 8)) * 8;
            unsigned hi[4], lo[4];
#pragma unroll
            for (int q = 0; q < 4; ++q) { float x[2];
#pragma unroll
                for (int e = 0; e < 2; ++e) { const int k = k0 + 2 * q + e; x[e] = (row < 32) ? args.in[19][k] * args.in[22][(size_t)k * NE + row] : (row < 36) ? args.in[19][k] * args.in[20][(size_t)k * NG + row - 32] : 0.f; }
                const unsigned h2 = pk2(x[0], x[1]); hi[q] = h2;
                lo[q] = pk2(x[0] - __builtin_bit_cast(float, h2 << 16), x[1] - __builtin_bit_cast(float, h2 & 0xffff0000u)); }
            *(v4u*)(RWp + (size_t)row * D + k0) = (v4u){hi[0], hi[1], hi[2], hi[3]}; *(v4u*)(RWp + (size_t)(64 + row) * D + k0) = (v4u){lo[0], lo[1], lo[2], lo[3]};
        }
        for (int m = gw; m < NT; m += NGW) rms_row_to_bf16(args.in[0] + (size_t)m * D, args.in[1], U16 + (size_t)m * D, F.lane);
    }
    if (BOTH(0)) xcd_barrier(bar);
    if (IN(1)) for (int rep = 0; rep < NREP(1); ++rep) {
        if (rep) xcd_barrier(bar);
        REFRESH();
        pg8::Gemm g{U16, WinT, NT, DINP, D}; pg8::StaticOrder S; S.init(NT, DINP, F.G, (int)blockIdx.x);
        pg8::EpiProj E{GLUb, P16};
        pg8::gemm_phase<pg8::EpiProj, pg8::StaticOrder>(F.lds + RING_OFF, g, S, E, nullptr, F.wave);
        { const int nwg = (NT / 256) * (DINP / 256), rounds = (nwg + (int)F.G - 1) / (int)F.G;
          if (rep == 0 && (int)blockIdx.x + (rounds - 1) * (int)F.G >= nwg) { const CvIn C{args.in, WguT, WdT}; cv_queue_run(C, F.ctl + CW_CVQ, 0, 2 * NE * 256, (LAS float*)(F.lds + RING_OFF + F.wave * CV_SCR), lane_id_fresh(), 6); } }
    }
    if (BOTH(1)) xcd_barrier(bar);
    if (IN(2)) for (int rep = 0; rep < NREP(2); ++rep) {
        if (rep) xcd_barrier(bar);
        REFRESH();
        for (int m = gw; m < NT; m += NGW) lora_in_token(P16, args.in[7], LIN, m, F.lane);
        for (int u = F.vcu; u < NT / CV_TT; u += F.G) conv_unit(F, u, GLUb, args.in[3], args.in[4], args.in[5], args.in[6], MIXED16);
    }
    if (BOTH(2)) xcd_barrier(bar);
    if (IN(3)) for (int rep = 0; rep < NREP(3); ++rep) {
        if (rep) xcd_barrier(bar);
        REFRESH();
        pg8::Gemm g{LIN, LoraT, NT, 3072, 384}; pg8::LoraOrder S; S.init(NT, 3072, F.G, (int)blockIdx.x);
        pg8::EpiBf16<0> E{LOUT, 3072, nullptr, 0, 0};
        pg8::gemm_phase<pg8::EpiBf16<0>, pg8::LoraOrder>(F.lds + RING_OFF, g, S, E, nullptr, F.wave);
        { const int nwg = (NT / 256) * (3072 / 256), rounds = (nwg + (int)F.G - 1) / (int)F.G;
          if (rep == 0 && (int)blockIdx.x + (rounds - 1) * (int)F.G >= nwg) { const CvIn C{args.in, WguT, WdT}; cv_queue_run(C, F.ctl + CW_CVQ, 0, 2 * NE * 256, (LAS float*)(F.lds + RING_OFF + F.wave * CV_SCR), lane_id_fresh(), 1); } }
    }
    if (BOTH(3)) xcd_barrier(bar);
    if (IN(4)) for (int rep = 0; rep < NREP(4); ++rep) {
        if (rep) xcd_barrier(bar);
        REFRESH();
        const PrepIn P{P16, LOUT, args.in[7], args.in[8], args.in[10], args.in[13], args.in[14], args.in[15], BONUS, G16};
        const int upw = (NUNITS + (int)F.G - 1) / (int)F.G + 1, nsx = (NUNITS + upw - 1) / upw;
        if ((int)blockIdx.x < nsx) scan_x_phase<0>(F, P, QHp, Y0p, Mcp, Ncp, nsx);
        else { const CvIn C{args.in, WguT, WdT}; cv_queue_run(C, F.ctl + CW_CVQ, 0, 2 * NE * 256, (LAS float*)(F.lds + RING_OFF + F.wave * CV_SCR), lane_id_fresh(), 16); }
#ifdef XMODE
        xcd_barrier(bar); scan_x_phase<XMODE>(F, P, QHp, Y0p, Mcp, Ncp, (int)F.G);
#endif
    }
    if (BOTH(4)) xcd_barrier(bar);
    if (IN(5)) {
        REFRESH();
        for (int rep = 0; rep < NREP(5); ++rep) { if (rep) xcd_barrier(bar);
        if (blockIdx.x < 4 * BATCH * NH) scan_y_chain4(F, (int)blockIdx.x, Mcp, Ncp, SSp); }
        { const CvIn C{args.in, WguT, WdT}; cv_queue_run(C, F.ctl + CW_CVQ, 0, 2 * NE * 256, (LAS float*)(F.lds + RING_OFF + F.wave * CV_SCR), F.lane); }
        if (BOTH(5)) xcd_barrier(bar);
    }
    if (IN(6)) for (int rep = 0; rep < NREP(6); ++rep) {
        if (rep) xcd_barrier(bar);
        REFRESH();
        const PostIn Z{args.in[16], args.in[17], BONUS, LOUT, MIXED16};
        scan_z_phase(F, QHp, Y0p, SSp, Z);
    }
    if (BOTH(6)) xcd_barrier(bar);
    if (IN(7)) for (int rep = 0; rep < NREP(7); ++rep) {
        if (rep) xcd_barrier(bar);
        REFRESH();
        pg8::Gemm g{MIXED16, WoutT, NT, D, D}; pg8::StaticOrder S; S.init(NT, D, F.G, (int)blockIdx.x);
        pg8::EpiResBf16 E{Hh, D, args.in[0]};
        pg8::gemm_phase<pg8::EpiResBf16, pg8::StaticOrder>(F.lds + RING_OFF, g, S, E, nullptr, F.wave);
    }
    if (BOTH(7)) xcd_barrier(bar);
    if (IN(8)) {
        REFRESH();
        for (int blk = blockIdx.x; blk < NT / 32; blk += F.G)
            router_block(F, blk, Hh, RWp, args.in[19], args.in[21], args.in[23], VN16, cnt, list, asg_e, asg_pos, gate);
        if (BOTH(8)) xcd_barrier(bar);
    }
    if (IN(9) || IN(10) || IN(11)) {
        REFRESH();
        __syncthreads();
        if (F.wave == 0) {
            const int e = F.lane & 31; int c = (cnt[e] + 255) >> 8, inc = c;
#pragma unroll
            for (int d = 1; d < 32; d <<= 1) { const int o = __shfl_up(inc, d, 32); if (e >= d) inc += o; }
            if (F.lane < 32) { tp[e] = inc - c; if (e == 31) tp[NE] = inc; for (int mt = inc - c; mt < inc; ++mt) tp[40 + mt] = e; }
        }
        __syncthreads();
    }
    if (IN(9)) for (int rep = 0; rep < NREP(9); ++rep) {
        if (rep) xcd_barrier(bar);
        REFRESH();
        MoeOrder S{tp, cnt, list, 4, (int)F.G, (int)blockIdx.x, nullptr, 0, (const char*)WguT, (size_t)1024 * D * 2, (size_t)256 * D * 2};
        pg8::EpiSwiGLU E{HID, DE};
        pg8::gemm_phase_g<true, pg8::EpiSwiGLU, MoeOrder>(F.lds + RING_OFF, (const char*)VN16, D, S, E, F.wave);
        if (rep == 0) { const CvIn C{args.in, WguT, WdT}; cv_queue_run(C, F.ctl + CW_CVQ2, 2 * NE * 256, CV_ITEMS, (LAS float*)(F.lds + RING_OFF + F.wave * CV_SCR), lane_id_fresh()); }
    }
    if (BOTH(9)) xcd_barrier(bar);
    if (IN(10)) for (int rep = 0; rep < NREP(10); ++rep) {
        if (rep) xcd_barrier(bar);
        REFRESH();
        MoeOrder S{tp, cnt, list, 8, (int)F.G, (int)blockIdx.x, (const char*)HID, (size_t)256 * DE * 2, (const char*)WdT, (size_t)D * DE * 2, (size_t)256 * DE * 2};
        pg8::EpiBf16<0> E{Y2, D, nullptr, 0, 0};
        pg8::gemm_phase_g<false, pg8::EpiBf16<0>, MoeOrder>(F.lds + RING_OFF, nullptr, DE, S, E, F.wave);
    }
    if (BOTH(10)) xcd_barrier(bar);
    if (IN(11)) for (int rep = 0; rep < NREP(11); ++rep) {
        if (rep) xcd_barrier(bar);
        REFRESH();
        for (int m = gw; m < NT; m += NGW) {
            const int s1 = 256 * tp[asg_e[2 * m]] + asg_pos[2 * m], s2 = 256 * tp[asg_e[2 * m + 1]] + asg_pos[2 * m + 1];
            final_token(Hh + (size_t)m * D, Y2 + (size_t)s1 * D, Y2 + (size_t)s2 * D, gate[2 * m], gate[2 * m + 1], args.in[27], args.out + (size_t)m * D, F.lane);
        }
    }
#undef IN
#undef BOTH
}

extern "C" void kernel_launch(void* const* d_in, const int* in_sizes, int n_in, void* d_out, int out_size, void* d_ws, size_t ws_size, hipStream_t stream) {
    static int grid = 0;
    if (grid == 0) {
        if (n_in != 28 || in_sizes[0] != NT * D || out_size != NT * D || ws_size < FW_END * MiB) {
            fprintf(stderr, "kernel_launch: unexpected shapes (n_in %d, in0 %d, out %d, ws %zu)\n", n_in, n_in > 0 ? in_sizes[0] : -1, out_size, ws_size); grid = -1; return; }
        int dev = 0, cus = 0, per_cu = 0;
        if (hipGetDevice(&dev) != hipSuccess || hipDeviceGetAttribute(&cus, hipDeviceAttributeMultiprocessorCount, dev) != hipSuccess) { grid = -1; return; }
        if (hipFuncSetAttribute((const void*)mk_fwd, hipFuncAttributeMaxDynamicSharedMemorySize, LDS_BYTES) != hipSuccess) { fprintf(stderr, "hipFuncSetAttribute failed\n"); grid = -1; return; }
        if (hipOccupancyMaxActiveBlocksPerMultiprocessor(&per_cu, (const void*)mk_fwd, NTHR, LDS_BYTES) != hipSuccess || per_cu < 1) { fprintf(stderr, "occupancy query: %d\n", per_cu); (void)hipGetLastError(); }
        grid = cus;
    }
    if (grid < 0) return;
    if (hipMemsetAsync((char*)d_ws + FW_CTL * MiB, 0, CTL_ZERO_BYTES, stream) != hipSuccess) return;
    Args a{};
    for (int i = 0; i < 28; ++i) a.in[i] = (const float*)d_in[i];
    a.out = (float*)d_out; a.ws = (unsigned char*)d_ws; a.ph_lo = 0; a.ph_hi = NPH;
#ifdef PROBE_PH
#ifndef PROBE_HI
#define PROBE_HI PROBE_PH
#endif
    a.ph_hi = PROBE_HI + 1;
    hipLaunchKernelGGL(mk_fwd, dim3(grid), dim3(NTHR), LDS_BYTES, stream, a);
    if (hipMemsetAsync((char*)d_ws + FW_CTL * MiB + CW_BAR * 4, 0, XCD_BAR_WORDS * 4, stream) != hipSuccess) return;
    if (hipMemsetAsync((char*)d_ws + FW_CTL * MiB + CW_CVQ * 4, 0, 512, stream) != hipSuccess) return;
    a.ph_lo = PROBE_PH; a.ph_hi = NPH;
#endif
    hipLaunchKernelGGL(mk_fwd, dim3(grid), dim3(NTHR), LDS_BYTES, stream, a);
}
```

```cpp
#include <hip/hip_runtime.h>
#include <cstdio>
#include <cstdint>

constexpr int BATCH = 2, T = 4096, NT = BATCH * T, D = 2048, DIN = 5408, DC = 1024, DR = 1024, NH = 16, HN = 64, CW = 31;
constexpr int DSH = 3360, LW = 64, LA = 64, LG = 160;
constexpr int NE = 32, NG = 4, EPG = 8, DE = 512;
constexpr size_t MiB = 1u << 20;
constexpr int LDP = 3584;

__device__ __forceinline__ float wave_sum(float v) {
#pragma unroll
    for (int o = 32; o > 0; o >>= 1) v += __shfl_xor(v, o);
    return v;
}
__device__ __forceinline__ float block_sum256(float v, float* red) {
    v = wave_sum(v);
    __syncthreads();
    if ((threadIdx.x & 63) == 0) red[threadIdx.x >> 6] = v;
    __syncthreads();
    return (red[0] + red[1]) + (red[2] + red[3]);
}
__device__ __forceinline__ float sigmoidf_(float x) { return 1.0f / (1.0f + expf(-x)); }
__device__ __forceinline__ unsigned f2bf_n(float f) { unsigned u = __builtin_bit_cast(unsigned, f); return (u + 0x7fffu + ((u >> 16) & 1u)) >> 16; }

__device__ __forceinline__ int lane_id_fresh() { int l; asm volatile("v_mbcnt_lo_u32_b32 %0, -1, 0\n\tv_mbcnt_hi_u32_b32 %0, -1, %0" : "=v"(l)); return l; }
namespace pg8 {
#define PG8_LAS __attribute__((address_space(3)))
typedef unsigned short bf16_t;
typedef short bf16x8 __attribute__((ext_vector_type(8)));
typedef float f32x4 __attribute__((ext_vector_type(4)));
typedef unsigned u32x4 __attribute__((ext_vector_type(4)));
constexpr int BM = 256, BK = 64, HALF = 128, HTB = HALF * BK * 2  , STAGE_BYTES = 8 * HTB, NXCD = 8, WGM = 8;

__host__ __device__ __forceinline__ int lds_byte(int r, int c) { const int st = (r >> 4) * 2 + (c >> 5), rr = r & 15, cc = c & 31, ob = rr * 64 + cc * 2; return st * 1024 + (ob ^ (((ob >> 9) & 1) << 5)); }
__host__ __device__ __forceinline__ void stage_rc(int b, int& R, int& C) { const int st = b / 1024, sb = b % 1024, swz = sb ^ (((sb >> 9) & 1) << 5); R = (st >> 1) * 16 + swz / 64; C = (st & 1) * 32 + (swz % 64) / 2; }
__host__ __device__ __forceinline__ int perm32(int rho) { const int n = rho >> 4, i = rho & 15; return 8 * (i >> 2) + 4 * n + (i & 3); }

struct Unit { int pm, pn; };
struct Gemm { const bf16_t* A; const bf16_t* Bt; int M, N, K; };

struct StaticOrder {
    int nM, nN, nwg, G, c;
    __host__ __device__ void init(int M, int N, int G_, int c_) { nM = M / BM; nN = N / BM; nwg = nM * nN; G = G_; c = c_; }
    __host__ __device__ bool next(int i, Unit& u) const {
        const long L = (long)i * G + c; if (L >= nwg) return false;
        int wgid = (int)L; { const int q = nwg / NXCD, r = nwg % NXCD, xcd = wgid % NXCD, off = wgid / NXCD; wgid = (xcd < r ? xcd * (q + 1) : r * (q + 1) + (xcd - r) * q) + off; }
        const int nig = WGM * nN, gid = wgid / nig, fm = gid * WGM, gsz = (nM - fm) < WGM ? (nM - fm) : WGM;
        u.pm = fm + ((wgid % nig) % gsz); u.pn = (wgid % nig) / gsz; return true;
    }
    __device__ __forceinline__ void a_ready(const Unit&) const {}
    __device__ __forceinline__ void done(const Unit&) const {}
    __device__ __forceinline__ size_t kofs(const Unit&) const { return 0; }
    __device__ __forceinline__ int ntiles(const Unit&, int nt) const { return nt; }
};
struct LoraOrder : StaticOrder {
    __device__ __forceinline__ size_t kofs(const Unit&) const { return 256; }
    __device__ __forceinline__ int ntiles(const Unit&, int) const { return 4; }
};
__device__ __forceinline__ unsigned cvt_pk_bf16(float lo, float hi) { unsigned r; asm volatile("v_cvt_pk_bf16_f32 %0, %1, %2" : "=v"(r) : "v"(lo), "v"(hi)); return r; }
typedef float f32x2 __attribute__((ext_vector_type(2)));
__device__ __forceinline__ f32x2 gelu_pk(f32x2 v) {
    const f32x2 av = __builtin_elementwise_abs(v), d = av * 0.2316418882f + 1.0f;
    f32x2 t; t.x = __builtin_amdgcn_rcpf(d.x); t.y = __builtin_amdgcn_rcpf(d.y);
    f32x2 q = t * 0.5307027145f + (-0.7265760135f); q = q * t + 0.7107068705f; q = q * t + (-0.142248368f); q = q * t + 0.127414796f; q = q * t;
    const f32x2 s = (v * v) * (-0.72134752044f);
    f32x2 e; e.x = __builtin_amdgcn_exp2f(s.x); e.y = __builtin_amdgcn_exp2f(s.y);
    const f32x2 m = v * (q * e), r = v - m;
    f32x2 o; o.x = v.x < 0.f ? m.x : r.x; o.y = v.y < 0.f ? m.y : r.y; return o;
}

struct EpiF32 {
    static constexpr bool PERM = false, AFTER_DRAIN = false;
    float* C; int ldc; const float* bias;
    template <class U> __device__ __forceinline__ void operator()(const f32x4 (&acc)[2][2][4][2], const U& u, int wr, int wc, int fr, int fq) const {
        const int row0 = u.pm * BM + wr * 64 + fr, col0 = u.pn * BM + wc * 32 + 4 * fq;
        f32x4 bv[2][2];
#pragma unroll
        for (int bj = 0; bj < 2; ++bj)
#pragma unroll
            for (int n = 0; n < 2; ++n) bv[bj][n] = bias ? *(const f32x4*)(bias + col0 + bj * HALF + n * 16) : (f32x4){0.f, 0.f, 0.f, 0.f};
#pragma unroll
        for (int ai = 0; ai < 2; ++ai)
#pragma unroll
            for (int m = 0; m < 4; ++m) { float* rowp = C + (size_t)(row0 + ai * HALF + m * 16) * ldc + col0;
#pragma unroll
                for (int bj = 0; bj < 2; ++bj)
#pragma unroll
                    for (int n = 0; n < 2; ++n) *(f32x4*)(rowp + bj * HALF + n * 16) = acc[ai][bj][m][n] + bv[bj][n]; }
    }
};
struct EpiResF32 {
    static constexpr bool PERM = false, AFTER_DRAIN = false;
    float* C; int ldc; const float* res;
    template <class U> __device__ __forceinline__ void operator()(const f32x4 (&acc)[2][2][4][2], const U& u, int wr, int wc, int fr, int fq) const {
        const int row0 = u.pm * BM + wr * 64 + fr, col0 = u.pn * BM + wc * 32 + 4 * fq;
#pragma unroll
        for (int ai = 0; ai < 2; ++ai)
#pragma unroll
            for (int m = 0; m < 4; ++m) { const size_t off = (size_t)(row0 + ai * HALF + m * 16) * ldc + col0;
#pragma unroll
                for (int bj = 0; bj < 2; ++bj)
#pragma unroll
                    for (int n = 0; n < 2; ++n) *(f32x4*)(C + off + bj * HALF + n * 16) = acc[ai][bj][m][n] + *(const f32x4*)(res + off + bj * HALF + n * 16); }
    }
};
struct EpiResBf16 {
    static constexpr bool PERM = true, AFTER_DRAIN = false;
    bf16_t* O; int ldc; const float* res;
    template <class U> __device__ __forceinline__ void operator()(const f32x4 (&acc)[2][2][4][2], const U& u, int wr, int wc, int fr, int fq) const {
        const int row0 = u.pm * BM + wr * 64 + fr, col0 = u.pn * BM + wc * 32 + 8 * fq;
#pragma unroll
        for (int ai = 0; ai < 2; ++ai)
#pragma unroll
            for (int m = 0; m < 4; ++m) { const size_t off = (size_t)(row0 + ai * HALF + m * 16) * ldc + col0;
#pragma unroll
                for (int bj = 0; bj < 2; ++bj) { const f32x4 v0 = acc[ai][bj][m][0] + __builtin_nontemporal_load((const f32x4*)(res + off + bj * HALF)), v1 = acc[ai][bj][m][1] + __builtin_nontemporal_load((const f32x4*)(res + off + bj * HALF + 4));
                    u32x4 w; w.x = cvt_pk_bf16(v0[0], v0[1]); w.y = cvt_pk_bf16(v0[2], v0[3]); w.z = cvt_pk_bf16(v1[0], v1[1]); w.w = cvt_pk_bf16(v1[2], v1[3]);
                    *(u32x4*)(O + off + bj * HALF) = w; } }
    }
};
template <int ACT  > struct EpiBf16 {
    static constexpr bool PERM = true, AFTER_DRAIN = false;
    bf16_t* O; int ldc; const float* bias; int split_cols; size_t split_stride;
    template <class U> __device__ __forceinline__ void operator()(const f32x4 (&acc)[2][2][4][2], const U& u, int wr, int wc, int fr, int fq) const {
        const int row0 = u.pm * BM + wr * 64 + fr; int colt = u.pn * BM; bf16_t* base = O;
        if (split_cols) { const int t = colt / split_cols; base += (size_t)t * split_stride; colt -= t * split_cols; }
        const int col0 = colt + wc * 32 + 8 * fq, bcol0 = u.pn * BM + wc * 32 + 8 * fq;
        f32x4 bv[2][2];
#pragma unroll
        for (int bj = 0; bj < 2; ++bj)
#pragma unroll
            for (int n = 0; n < 2; ++n) bv[bj][n] = bias ? *(const f32x4*)(bias + bcol0 + bj * HALF + 4 * n) : (f32x4){0.f, 0.f, 0.f, 0.f};
#pragma unroll
        for (int ai = 0; ai < 2; ++ai)
#pragma unroll
            for (int m = 0; m < 4; ++m) { bf16_t* rowp = base + (size_t)(row0 + ai * HALF + m * 16) * ldc + col0;
#pragma unroll
                for (int bj = 0; bj < 2; ++bj) { f32x4 v0 = acc[ai][bj][m][0] + bv[bj][0], v1 = acc[ai][bj][m][1] + bv[bj][1];
                    if (ACT == 1) { f32x2 a = gelu_pk((f32x2){v0[0], v0[1]}), b = gelu_pk((f32x2){v0[2], v0[3]}), c = gelu_pk((f32x2){v1[0], v1[1]}), d = gelu_pk((f32x2){v1[2], v1[3]});
                        v0 = (f32x4){a.x, a.y, b.x, b.y}; v1 = (f32x4){c.x, c.y, d.x, d.y}; }
                    if (ACT == 2) {
#pragma unroll
                        for (int j = 0; j < 4; ++j) { v0[j] = 0.5f * v0[j] * (1.0f + erff(v0[j] * 0.70710678f)); v1[j] = 0.5f * v1[j] * (1.0f + erff(v1[j] * 0.70710678f)); } }
                    u32x4 w; w.x = cvt_pk_bf16(v0[0], v0[1]); w.y = cvt_pk_bf16(v0[2], v0[3]); w.z = cvt_pk_bf16(v1[0], v1[1]); w.w = cvt_pk_bf16(v1[2], v1[3]);
                    *(u32x4*)(rowp + bj * HALF) = w; } }
    }
};

template <class Epi, class Sched, bool STAMP = false>
__device__ __forceinline__ void gemm_phase(PG8_LAS unsigned char* lds, const Gemm g, const Sched& S, const Epi& E, unsigned long long* stamps, int wid) {
    const int lane = lane_id_fresh(), tid = wid * 64 + lane, wr = wid >> 2, wc = wid & 3, fr = lane & 15, fq = lane >> 4;
    const int K = g.K, nt = K / BK;
    int ts_lo = 0, ts_hi = 0, nts = 0; const unsigned long long rt_entry = STAMP ? (unsigned long long)wall_clock64() : 0ull;
#define PG8_STAMP() do { if (STAMP && wid == 0 && nts < 64) { const unsigned long long _c = (unsigned long long)clock64(); \
        ts_lo = (lane == nts) ? (int)(unsigned)_c : ts_lo; ts_hi = (lane == nts) ? (int)(unsigned)(_c >> 32) : ts_hi; ++nts; } } while (0)
    PG8_STAMP();
    unsigned voffA[2], voffB[2];
#pragma unroll
    for (int i = 0; i < 2; ++i) { int R, C; stage_rc(tid * 16 + i * 8192, R, C); const int Rb = Epi::PERM ? ((R & ~31) + perm32(R & 31)) : R;
        voffA[i] = (unsigned)(R * K + C) * 2u; voffB[i] = (unsigned)(Rb * K + C) * 2u; }
    const size_t kstep = (size_t)(BK * 2);
    const size_t hstep = (size_t)HALF * K * 2;
    const size_t tstep = 2 * hstep;
    const unsigned ldsw = (unsigned)wid * 1024u;
    const int aoff = lds_byte(wr * 64 + fr, fq * 8), boff = lds_byte(wc * 32 + fr, fq * 8);
#define PG8_SA(b, h) (((b) * 2 + (h)) * HTB)
#define PG8_SB(b, h) ((4 + (b) * 2 + (h)) * HTB)
#define PG8_STAGE(bufoff, gbase, voff) do { _Pragma("unroll") for (int _i = 0; _i < 2; ++_i) \
        __builtin_amdgcn_global_load_lds((const unsigned*)((const char*)(gbase) + (voff)[_i]), (PG8_LAS unsigned*)(lds + (bufoff) + ldsw + _i * 8192), 16, 0, 0); } while (0)
#define PG8_LDA(dst, b, h) do { _Pragma("unroll") for (int m = 0; m < 4; ++m) _Pragma("unroll") for (int k = 0; k < 2; ++k) dst[m][k] = *(const PG8_LAS bf16x8*)(lds + PG8_SA(b, h) + aoff + m * 2048 + k * 1024); } while (0)
#define PG8_LDB(dst, b, h) do { _Pragma("unroll") for (int n = 0; n < 2; ++n) _Pragma("unroll") for (int k = 0; k < 2; ++k) dst[n][k] = *(const PG8_LAS bf16x8*)(lds + PG8_SB(b, h) + boff + n * 2048 + k * 1024); } while (0)
#define PG8_MMA(ai, bj, At, Bt) do { __builtin_amdgcn_s_setprio(1); _Pragma("unroll") for (int m = 0; m < 4; ++m) _Pragma("unroll") for (int n = 0; n < 2; ++n) _Pragma("unroll") for (int k = 0; k < 2; ++k) \
        acc[ai][bj][m][n] = __builtin_amdgcn_mfma_f32_16x16x32_bf16(Bt[n][k], At[m][k], acc[ai][bj][m][n], 0, 0, 0); __builtin_amdgcn_s_setprio(0); } while (0)
#define PG8_WAIT_V(n) asm volatile("s_waitcnt vmcnt(" #n ")" ::: "memory")
#define PG8_WAIT_L(n) asm volatile("s_waitcnt lgkmcnt(" #n ")" ::: "memory")
#define PG8_BAR __builtin_amdgcn_s_barrier()
#define PG8_SCHED __builtin_amdgcn_sched_barrier(0)
    Unit cur, nxt; int ui = 0;
    if (!S.next(0, cur)) return;
    f32x4 acc[2][2][4][2];
    bf16x8 At[4][2], B0[2][2], B1[2][2];
    const char* cA = (const char*)g.A + (size_t)cur.pm * tstep + S.kofs(cur); const char* cB = (const char*)g.Bt + (size_t)cur.pn * tstep + S.kofs(cur);
    S.a_ready(cur);
    { const char* p0 = cB; const char* p1 = cB + hstep; const char* p2 = cA; const char* p3 = cA + hstep; const char* p4 = cB + kstep; const char* p5 = cA + kstep; const char* p6 = cB + hstep + kstep;
      asm volatile("" : "+s"(p0), "+s"(p1), "+s"(p2), "+s"(p3), "+s"(p4), "+s"(p5), "+s"(p6));
      PG8_STAGE(PG8_SB(0, 0), p0, voffB); PG8_STAGE(PG8_SB(0, 1), p1, voffB); PG8_STAGE(PG8_SA(0, 0), p2, voffA); PG8_STAGE(PG8_SA(0, 1), p3, voffA);
      if (wr == 1) PG8_BAR;
      PG8_WAIT_V(2); PG8_BAR;
      PG8_STAGE(PG8_SB(1, 0), p4, voffB); PG8_STAGE(PG8_SA(1, 0), p5, voffA); PG8_STAGE(PG8_SB(1, 1), p6, voffB);
      PG8_WAIT_V(6); PG8_BAR; }
#pragma unroll
    for (int a = 0; a < 2; ++a)
#pragma unroll
        for (int b = 0; b < 2; ++b)
#pragma unroll
            for (int m = 0; m < 4; ++m)
#pragma unroll
                for (int n = 0; n < 2; ++n) acc[a][b][m][n] = (f32x4){0.f, 0.f, 0.f, 0.f};
    PG8_STAMP();
    for (;;) {
        const bool has_next = S.next(ui + 1, nxt);
        const char* nA = has_next ? (const char*)g.A + (size_t)nxt.pm * tstep + S.kofs(nxt) : cA; const char* nB = has_next ? (const char*)g.Bt + (size_t)nxt.pn * tstep + S.kofs(nxt) : cB;
        const int ntc = S.ntiles(cur, nt);
#pragma unroll 1
        for (int t = 0; t < ntc; t += 2) {
            const bool last = (t == ntc - 2);
            const char* a1 = cA + (size_t)(t + 1) * kstep;
            const char* a2 = last ? nA : cA + (size_t)(t + 2) * kstep; const char* b2 = last ? nB : cB + (size_t)(t + 2) * kstep;
            const char* a3 = a2 + kstep; const char* b3 = b2 + kstep;
            if (last && has_next) S.a_ready(nxt);
            PG8_LDB(B0, 0, 0); PG8_LDB(B1, 0, 1); PG8_SCHED; PG8_LDA(At, 0, 0); PG8_STAGE(PG8_SA(1, 1), a1 + hstep, voffA);
            PG8_WAIT_V(8); PG8_WAIT_L(0); PG8_BAR; PG8_MMA(0, 0, At, B0); PG8_MMA(0, 1, At, B1); PG8_BAR; PG8_SCHED;
            PG8_LDA(At, 0, 1); PG8_STAGE(PG8_SB(0, 0), b2, voffB); PG8_STAGE(PG8_SB(0, 1), b2 + hstep, voffB); PG8_STAGE(PG8_SA(0, 0), a2, voffA);
            PG8_WAIT_V(8); PG8_WAIT_L(0); PG8_BAR; PG8_MMA(1, 0, At, B0); PG8_MMA(1, 1, At, B1); PG8_BAR; PG8_SCHED;
            PG8_LDB(B0, 1, 0); PG8_LDB(B1, 1, 1); PG8_SCHED; PG8_LDA(At, 1, 0); PG8_STAGE(PG8_SA(0, 1), a2 + hstep, voffA);
            PG8_WAIT_V(8); PG8_WAIT_L(0); PG8_BAR; PG8_MMA(0, 0, At, B0); PG8_MMA(0, 1, At, B1); PG8_BAR; PG8_SCHED;
            PG8_LDA(At, 1, 1); PG8_STAGE(PG8_SB(1, 0), b3, voffB); PG8_STAGE(PG8_SB(1, 1), b3 + hstep, voffB); PG8_STAGE(PG8_SA(1, 0), a3, voffA);
            PG8_WAIT_V(8); PG8_WAIT_L(0); PG8_BAR; PG8_MMA(1, 0, At, B0); PG8_MMA(1, 1, At, B1); PG8_BAR; PG8_SCHED;
        }
        PG8_STAMP();
        if (wr == 0) PG8_BAR;
        if constexpr (!Epi::AFTER_DRAIN) { const int l2 = lane_id_fresh(); E(acc, cur, wr, wc, l2 & 15, l2 >> 4); S.done(cur); }
        PG8_STAMP();
        if (!has_next) break;
#pragma unroll
        for (int a = 0; a < 2; ++a)
#pragma unroll
            for (int b = 0; b < 2; ++b)
#pragma unroll
                for (int m = 0; m < 4; ++m)
#pragma unroll
                    for (int n = 0; n < 2; ++n) acc[a][b][m][n] = (f32x4){0.f, 0.f, 0.f, 0.f};
        cur = nxt; cA = nA; cB = nB; ++ui;
        if (wr == 1) PG8_BAR;
    }
    PG8_WAIT_V(0);
    PG8_BAR;
    if constexpr (Epi::AFTER_DRAIN) { E.fused(acc, cur, wr, wc, fr, fq, lds, wid, lane); S.done(cur); }
    PG8_STAMP();
    if (STAMP && wid == 0) { stamps[lane] = lane < nts ? (((unsigned long long)(unsigned)ts_hi << 32) | (unsigned)ts_lo) : 0ull;
        if (lane == 62) stamps[62] = rt_entry; if (lane == 63) stamps[63] = (unsigned long long)wall_clock64(); }
#undef PG8_STAMP
#undef PG8_SA
#undef PG8_SB
#undef PG8_STAGE
#undef PG8_LDA
#undef PG8_LDB
#undef PG8_MMA
#undef PG8_WAIT_V
#undef PG8_WAIT_L
#undef PG8_BAR
#undef PG8_SCHED
}
struct GUnit { int pm, pn; const char* aBase; const char* bBase; const int* rows; int nvalid; };
struct EpiSwiGLU {
    static constexpr bool PERM = true, AFTER_DRAIN = false;
    bf16_t* O; int ldh;
    template <class U> __device__ __forceinline__ void operator()(const f32x4 (&acc)[2][2][4][2], const U& u, int wr, int wc, int fr, int fq) const {
        const int row0 = u.pm * BM + wr * 64 + fr, col0 = u.pn * (BM / 2) + wc * 32 + 8 * fq;
#pragma unroll
        for (int ai = 0; ai < 2; ++ai)
#pragma unroll
            for (int m = 0; m < 4; ++m) { bf16_t* rowp = O + (size_t)(row0 + ai * HALF + m * 16) * ldh + col0;
                float h[8];
#pragma unroll
                for (int n = 0; n < 2; ++n) { const f32x4 g = acc[ai][0][m][n], up = acc[ai][1][m][n];
#pragma unroll
                    for (int j = 0; j < 4; ++j) h[4 * n + j] = g[j] * __builtin_amdgcn_rcpf(1.0f + __expf(-g[j])) * up[j]; }
                u32x4 w; w.x = cvt_pk_bf16(h[0], h[1]); w.y = cvt_pk_bf16(h[2], h[3]); w.z = cvt_pk_bf16(h[4], h[5]); w.w = cvt_pk_bf16(h[6], h[7]);
                *(u32x4*)rowp = w; }
    }
};
struct EpiProj {
    static constexpr bool PERM = true, AFTER_DRAIN = false;
    bf16_t* GLU; bf16_t* P16;
    template <class U> __device__ __forceinline__ void operator()(const f32x4 (&acc)[2][2][4][2], const U& u, int wr, int wc, int fr, int fq) const {
        typedef unsigned u32x2 __attribute__((ext_vector_type(2)));
        const int row0 = u.pm * BM + wr * 64 + fr;
        if (u.pn < 8) {
            const int col0 = u.pn * (BM / 2) + wc * 32 + 8 * fq;
#pragma unroll
            for (int ai = 0; ai < 2; ++ai)
#pragma unroll
                for (int m = 0; m < 4; ++m) { bf16_t* rowp = GLU + (size_t)(row0 + ai * HALF + m * 16) * 1024 + col0;
                    float h[8];
#pragma unroll
                    for (int n = 0; n < 2; ++n) { const f32x4 v = acc[ai][0][m][n], g = acc[ai][1][m][n];
#pragma unroll
                        for (int j = 0; j < 4; ++j) h[4 * n + j] = v[j] * __builtin_amdgcn_rcpf(1.0f + __expf(-g[j])); }
                    u32x4 w; w.x = cvt_pk_bf16(h[0], h[1]); w.y = cvt_pk_bf16(h[2], h[3]); w.z = cvt_pk_bf16(h[4], h[5]); w.w = cvt_pk_bf16(h[6], h[7]);
                    *(u32x4*)rowp = w; }
        } else {
            const int col0 = (u.pn - 8) * BM + wc * 32 + 8 * fq;
#pragma unroll
            for (int ai = 0; ai < 2; ++ai)
#pragma unroll
                for (int m = 0; m < 4; ++m) { bf16_t* rowp = P16 + (size_t)(row0 + ai * HALF + m * 16) * 3584 + col0;
#pragma unroll
                    for (int bj = 0; bj < 2; ++bj) { const f32x4 v0 = acc[ai][bj][m][0], v1 = acc[ai][bj][m][1];
                        u32x4 w; w.x = cvt_pk_bf16(v0[0], v0[1]); w.y = cvt_pk_bf16(v0[2], v0[3]); w.z = cvt_pk_bf16(v1[0], v1[1]); w.w = cvt_pk_bf16(v1[2], v1[3]);
                        *(u32x4*)(rowp + bj * HALF) = w; } }
        }
    }
};
template <bool GATHER, class Epi, class Sched>
__device__ __forceinline__ void gemm_phase_g(PG8_LAS unsigned char* lds, const char* Agather, int K, const Sched& S, const Epi& E, int wid) {
    const int lane = lane_id_fresh(), tid = wid * 64 + lane, wr = wid >> 2, wc = wid & 3, fr = lane & 15, fq = lane >> 4;
    const int nt = K / BK;
    unsigned voffA[2], voffB[2]; int RA[2], CA[2];
#pragma unroll
    for (int i = 0; i < 2; ++i) { int R, C; stage_rc(tid * 16 + i * 8192, R, C); const int Rb = Epi::PERM ? ((R & ~31) + perm32(R & 31)) : R;
        voffA[i] = (unsigned)(R * K + C) * 2u; voffB[i] = (unsigned)(Rb * K + C) * 2u; RA[i] = R; CA[i] = C; }
    const size_t kstep = (size_t)(BK * 2);
    const size_t hstep = (size_t)HALF * K * 2;
    const unsigned ldsw = (unsigned)wid * 1024u;
    const int aoff = lds_byte(wr * 64 + fr, fq * 8), boff = lds_byte(wc * 32 + fr, fq * 8);
#define PG8_SA(b, h) (((b) * 2 + (h)) * HTB)
#define PG8_SB(b, h) ((4 + (b) * 2 + (h)) * HTB)
#define PG8_STAGE(bufoff, gbase, voff) do { _Pragma("unroll") for (int _i = 0; _i < 2; ++_i) \
        __builtin_amdgcn_global_load_lds((const unsigned*)((const char*)(gbase) + (voff)[_i]), (PG8_LAS unsigned*)(lds + (bufoff) + ldsw + _i * 8192), 16, 0, 0); } while (0)
#define PG8_STAGE_A(bufoff, ub, h, OFFS) do { if (GATHER) PG8_STAGE(bufoff, ub, OFFS[h]); else PG8_STAGE(bufoff, (ub) + (h) * hstep, voffA); } while (0)
#define PG8_GOFF(dst, un) do { _Pragma("unroll") for (int _h = 0; _h < 2; ++_h) _Pragma("unroll") for (int _i = 0; _i < 2; ++_i) { const int _r = _h * HALF + RA[_i]; \
        const int _tok = (un).rows[_r < (un).nvalid ? _r : 0]; dst[_h][_i] = (unsigned)(_tok * K + CA[_i]) * 2u; } asm volatile("s_waitcnt vmcnt(0)" ::: "memory"); } while (0)
#define PG8_LDA(dst, b, h) do { _Pragma("unroll") for (int m = 0; m < 4; ++m) _Pragma("unroll") for (int k = 0; k < 2; ++k) dst[m][k] = *(const PG8_LAS bf16x8*)(lds + PG8_SA(b, h) + aoff + m * 2048 + k * 1024); } while (0)
#define PG8_LDB(dst, b, h) do { _Pragma("unroll") for (int n = 0; n < 2; ++n) _Pragma("unroll") for (int k = 0; k < 2; ++k) dst[n][k] = *(const PG8_LAS bf16x8*)(lds + PG8_SB(b, h) + boff + n * 2048 + k * 1024); } while (0)
#define PG8_MMA(ai, bj, At, Bt) do { __builtin_amdgcn_s_setprio(1); _Pragma("unroll") for (int m = 0; m < 4; ++m) _Pragma("unroll") for (int n = 0; n < 2; ++n) _Pragma("unroll") for (int k = 0; k < 2; ++k) \
        acc[ai][bj][m][n] = __builtin_amdgcn_mfma_f32_16x16x32_bf16(Bt[n][k], At[m][k], acc[ai][bj][m][n], 0, 0, 0); __builtin_amdgcn_s_setprio(0); } while (0)
#define PG8_WAIT_V(n) asm volatile("s_waitcnt vmcnt(" #n ")" ::: "memory")
#define PG8_WAIT_L(n) asm volatile("s_waitcnt lgkmcnt(" #n ")" ::: "memory")
#define PG8_BAR __builtin_amdgcn_s_barrier()
#define PG8_SCHED __builtin_amdgcn_sched_barrier(0)
    GUnit cur, nxt; int ui = 0;
    if (!S.next(0, cur)) return;
    f32x4 acc[2][2][4][2];
    bf16x8 At[4][2], B0[2][2], B1[2][2];
    unsigned ga[2][2] = {{0u, 0u}, {0u, 0u}}, nga[2][2] = {{0u, 0u}, {0u, 0u}};
    const char* cA = GATHER ? Agather : cur.aBase; const char* cB = cur.bBase;
    if (GATHER) PG8_GOFF(ga, cur);
    PG8_STAGE(PG8_SB(0, 0), cB, voffB); PG8_STAGE(PG8_SB(0, 1), cB + hstep, voffB); PG8_STAGE_A(PG8_SA(0, 0), cA, 0, ga); PG8_STAGE_A(PG8_SA(0, 1), cA, 1, ga);
    if (wr == 1) PG8_BAR;
    PG8_WAIT_V(2); PG8_BAR;
    PG8_STAGE(PG8_SB(1, 0), cB + kstep, voffB); PG8_STAGE_A(PG8_SA(1, 0), cA + kstep, 0, ga); PG8_STAGE(PG8_SB(1, 1), cB + hstep + kstep, voffB);
    PG8_WAIT_V(6); PG8_BAR;
#pragma unroll
    for (int a = 0; a < 2; ++a)
#pragma unroll
        for (int b = 0; b < 2; ++b)
#pragma unroll
            for (int m = 0; m < 4; ++m)
#pragma unroll
                for (int n = 0; n < 2; ++n) acc[a][b][m][n] = (f32x4){0.f, 0.f, 0.f, 0.f};
    for (;;) {
        const bool has_next = S.next(ui + 1, nxt);
        if (GATHER) { if (has_next) PG8_GOFF(nga, nxt); else {
#pragma unroll
            for (int h = 0; h < 2; ++h)
#pragma unroll
                for (int i = 0; i < 2; ++i) nga[h][i] = ga[h][i]; } }
        const char* nA = GATHER ? Agather : (has_next ? nxt.aBase : cA); const char* nB = has_next ? nxt.bBase : cB;
#pragma unroll 1
        for (int t = 0; t < nt; t += 2) {
            const bool last = (t == nt - 2);
            const char* a1 = cA + (size_t)(t + 1) * kstep;
            const char* a2 = last ? nA : cA + (size_t)(t + 2) * kstep; const char* b2 = last ? nB : cB + (size_t)(t + 2) * kstep;
            const char* a3 = a2 + kstep; const char* b3 = b2 + kstep;
            unsigned o2[2][2];
#pragma unroll
            for (int h = 0; h < 2; ++h)
#pragma unroll
                for (int i = 0; i < 2; ++i) o2[h][i] = last ? nga[h][i] : ga[h][i];
            PG8_LDB(B0, 0, 0); PG8_LDB(B1, 0, 1); PG8_SCHED; PG8_LDA(At, 0, 0); PG8_STAGE_A(PG8_SA(1, 1), a1, 1, ga);
            PG8_WAIT_V(8); PG8_WAIT_L(0); PG8_BAR; PG8_MMA(0, 0, At, B0); PG8_MMA(0, 1, At, B1); PG8_BAR; PG8_SCHED;
            PG8_LDA(At, 0, 1); PG8_STAGE(PG8_SB(0, 0), b2, voffB); PG8_STAGE(PG8_SB(0, 1), b2 + hstep, voffB); PG8_STAGE_A(PG8_SA(0, 0), a2, 0, o2);
            PG8_WAIT_V(8); PG8_WAIT_L(0); PG8_BAR; PG8_MMA(1, 0, At, B0); PG8_MMA(1, 1, At, B1); PG8_BAR; PG8_SCHED;
            PG8_LDB(B0, 1, 0); PG8_LDB(B1, 1, 1); PG8_SCHED; PG8_LDA(At, 1, 0); PG8_STAGE_A(PG8_SA(0, 1), a2, 1, o2);
            PG8_WAIT_V(8); PG8_WAIT_L(0); PG8_BAR; PG8_MMA(0, 0, At, B0); PG8_MMA(0, 1, At, B1); PG8_BAR; PG8_SCHED;
            PG8_LDA(At, 1, 1); PG8_STAGE(PG8_SB(1, 0), b3, voffB); PG8_STAGE(PG8_SB(1, 1), b3 + hstep, voffB); PG8_STAGE_A(PG8_SA(1, 0), a3, 0, o2);
            PG8_WAIT_V(8); PG8_WAIT_L(0); PG8_BAR; PG8_MMA(1, 0, At, B0); PG8_MMA(1, 1, At, B1); PG8_BAR; PG8_SCHED;
        }
        if (wr == 0) PG8_BAR;
        { const int l2 = lane_id_fresh(); E(acc, cur, wr, wc, l2 & 15, l2 >> 4); }
        if (!has_next) break;
#pragma unroll
        for (int a = 0; a < 2; ++a)
#pragma unroll
            for (int b = 0; b < 2; ++b)
#pragma unroll
                for (int m = 0; m < 4; ++m)
#pragma unroll
                    for (int n = 0; n < 2; ++n) acc[a][b][m][n] = (f32x4){0.f, 0.f, 0.f, 0.f};
        cur = nxt; cA = nA; cB = nB; ++ui;
#pragma unroll
        for (int h = 0; h < 2; ++h)
#pragma unroll
            for (int i = 0; i < 2; ++i) ga[h][i] = nga[h][i];
        if (wr == 1) PG8_BAR;
    }
    PG8_WAIT_V(0);
    PG8_BAR;
#undef PG8_SA
#undef PG8_SB
#undef PG8_STAGE
#undef PG8_STAGE_A
#undef PG8_GOFF
#undef PG8_LDA
#undef PG8_LDB
#undef PG8_MMA
#undef PG8_WAIT_V
#undef PG8_WAIT_L
#undef PG8_BAR
#undef PG8_SCHED
}
}


#define XB_TMO      128
#define XB_XCNT(j)  (256  + 64 * (j))
#define XB_XSUB(j)  (1280 + 64 * (j))
#define XB_XGEN(j)  (2304 + 64 * (j))
#define XB_TOP      3328
#define XB_TOPGEN   3392
#define XCD_BAR_WORDS 3456
#define XB_SPIN_CAP (1u << 18)
#define LAS __attribute__((address_space(3)))

__device__ __forceinline__ unsigned xb_ld(unsigned* p)              { return __hip_atomic_load(p, __ATOMIC_RELAXED, __HIP_MEMORY_SCOPE_AGENT); }
__device__ __forceinline__ unsigned xb_add(unsigned* p, unsigned v) { return __hip_atomic_fetch_add(p, v, __ATOMIC_RELAXED, __HIP_MEMORY_SCOPE_AGENT); }
__device__ __forceinline__ unsigned xb_xcc_id() { return (unsigned)__builtin_amdgcn_s_getreg((3 << 11) | 20) & 0xFu; }
#define XB_SPIN(cond, bar) do { unsigned _sp = 0; while (cond) { __builtin_amdgcn_s_sleep(1); \
    if ((++_sp & 255u) == 0u) { if (xb_ld(&(bar)[XB_TMO])) break; if (_sp > XB_SPIN_CAP) { atomicAdd(&(bar)[XB_TMO], 1u); break; } } } } while (0)

struct XcdBarrier {
    unsigned* bar; unsigned x; unsigned w0;
    volatile LAS unsigned* st;
};

__device__ __forceinline__ XcdBarrier xcd_barrier_post(unsigned* bar, volatile LAS unsigned* st) {
    XcdBarrier b; b.bar = bar; b.x = xb_xcc_id(); b.st = st; b.w0 = (__builtin_amdgcn_readfirstlane(threadIdx.x >> 6) == 0) ? 1u : 0u;
    if (threadIdx.x == 0) (void)xb_add(&bar[XB_XCNT(b.x)], 1u);
    return b;
}
__device__ __forceinline__ void xcd_barrier_complete(unsigned* bar, unsigned x, unsigned& nloc, unsigned& nx) {
    const unsigned G = gridDim.x * gridDim.y * gridDim.z;
    unsigned sum, cnt, mine, sp = 0u;
    for (;;) {
        sum = 0u; cnt = 0u; mine = 0u;
#pragma unroll
        for (unsigned j = 0; j < 16; ++j) { const unsigned c = xb_ld(&bar[XB_XCNT(j)]); sum += c; cnt += (c > 0u) ? 1u : 0u; mine = (j == x) ? c : mine; }
        if (sum == G) break;
        __builtin_amdgcn_s_sleep(1);
        if ((++sp & 255u) == 0u) { if (xb_ld(&bar[XB_TMO])) break; if (sp > XB_SPIN_CAP) { atomicAdd(&bar[XB_TMO], 1u); break; } }
    }
    nloc = mine > 0u ? mine : 1u; nx = cnt > 0u ? cnt : 1u;
}

__device__ __forceinline__ void xcd_barrier(const XcdBarrier& b) {
    asm volatile("s_waitcnt vmcnt(0)" ::: "memory");
    __syncthreads();
    if (b.w0 != 0u && lane_id_fresh() == 0) {
        unsigned* bar = b.bar;
        __builtin_amdgcn_s_waitcnt(0);
        unsigned nloc = b.st[0], nx = b.st[1];
        if (nloc == 0u) { xcd_barrier_complete(bar, b.x, nloc, nx); b.st[0] = nloc; b.st[1] = nx; }
        const unsigned old = xb_add(&bar[XB_XSUB(b.x)], 1u);
        const unsigned gen = old / nloc;
        if (old + 1u == (gen + 1u) * nloc) {
            __builtin_amdgcn_fence(__ATOMIC_RELEASE, "agent");
            asm volatile("s_waitcnt vmcnt(0)" ::: "memory");
            const unsigned og = xb_add(&bar[XB_TOP], 1u);
            const unsigned tg = og / nx;
            if (og + 1u == (tg + 1u) * nx) xb_add(&bar[XB_TOPGEN], 1u);
            else XB_SPIN(xb_ld(&bar[XB_TOPGEN]) == tg, bar);
            __builtin_amdgcn_fence(__ATOMIC_ACQUIRE, "agent");
            xb_add(&bar[XB_XGEN(b.x)], 1u);
            asm volatile("s_waitcnt vmcnt(0)" ::: "memory");
        } else {
            XB_SPIN(xb_ld(&bar[XB_XGEN(b.x)]) == gen, bar);
            __builtin_amdgcn_fence(__ATOMIC_ACQUIRE, "agent");
            asm volatile("s_waitcnt vmcnt(0)" ::: "memory");
        }
    }
    __syncthreads();
}


#define GAS __attribute__((address_space(1)))
typedef unsigned short bf16;
typedef unsigned v4u __attribute__((ext_vector_type(4)));
typedef float f32x4 __attribute__((ext_vector_type(4)));
#define LDS_WAIT() asm volatile("s_waitcnt lgkmcnt(0)" ::: "memory")
#define VM_WAIT() asm volatile("s_waitcnt vmcnt(0)" ::: "memory")
__device__ __forceinline__ unsigned f2bf(float f) { unsigned u = __builtin_bit_cast(unsigned, f); return (u + 0x7fffu + ((u >> 16) & 1u)) >> 16; }
__device__ __forceinline__ unsigned pk2(float lo, float hi) { return f2bf(lo) | (f2bf(hi) << 16); }
__device__ __forceinline__ float bf2f(unsigned short b) { return __builtin_bit_cast(float, (unsigned)b << 16); }

constexpr int NWAVES = 8, NTHR = NWAVES * 64;
constexpr int RING_OFF = 0, RING_BYTES = 131072;
constexpr int LDSCTL_OFF = 148480, MISC_OFF = LDSCTL_OFF + 320;
constexpr int LDS_BYTES = LDSCTL_OFF + 1024;
constexpr int DINP = 5632;
constexpr int CW_BAR = 4096;

struct Frame {
    LAS unsigned char* lds;
    volatile LAS unsigned* MISC;
    unsigned* ctl;
    int tid, lane, wave, vcu, G;
};

template <class RowMap>
__device__ __forceinline__ void transpose_item(const float* __restrict__ W, int K, int N, bf16* __restrict__ WT, int ldt, const RowMap& rm, LAS float* scr, int item, int lane) {
    const int nblk = N / 32, kb = item / nblk, nb = item % nblk, k0 = 64 * kb, n0 = 32 * nb;
    f32x4 tv[8];
#pragma unroll
    for (int i = 0; i < 8; ++i) tv[i] = __builtin_nontemporal_load((const f32x4*)(W + (size_t)(k0 + 8 * i + (lane >> 3)) * N + n0 + 4 * (lane & 7)));
#pragma unroll
    for (int i = 0; i < 8; ++i) { LAS float* d = scr + (8 * i + (lane >> 3)) * 33 + 4 * (lane & 7); d[0] = tv[i].x; d[1] = tv[i].y; d[2] = tv[i].z; d[3] = tv[i].w; }
    LDS_WAIT(); asm volatile("" ::: "memory");
    const int c = lane & 7;
#pragma unroll
    for (int j = 0; j < 4; ++j) { const int n = (lane >> 3) + 8 * j; const LAS float* s = scr + (8 * c) * 33 + n;
        v4u o; o.x = pk2(s[0 * 33], s[1 * 33]); o.y = pk2(s[2 * 33], s[3 * 33]); o.z = pk2(s[4 * 33], s[5 * 33]); o.w = pk2(s[6 * 33], s[7 * 33]);
        *(v4u*)(WT + (size_t)rm(n0 + n) * ldt + k0 + 8 * c) = o; }
    LDS_WAIT(); asm volatile("" ::: "memory");
}
struct RowId { int off; __device__ __forceinline__ int operator()(int n) const { return off + n; } };

__device__ __forceinline__ float wave_sum_x(float v) {
    v += __builtin_bit_cast(float, __builtin_amdgcn_update_dpp(0, __builtin_bit_cast(int, v), 0xB1, 0xF, 0xF, true));
    v += __builtin_bit_cast(float, __builtin_amdgcn_update_dpp(0, __builtin_bit_cast(int, v), 0x4E, 0xF, 0xF, true));
    v += __builtin_bit_cast(float, __builtin_amdgcn_update_dpp(0, __builtin_bit_cast(int, v), 0x141, 0xF, 0xF, true));
    v += __builtin_bit_cast(float, __builtin_amdgcn_update_dpp(0, __builtin_bit_cast(int, v), 0x140, 0xF, 0xF, true));
    const int iv = __builtin_bit_cast(int, v);
    const float s0 = __builtin_bit_cast(float, __builtin_amdgcn_readlane(iv, 0)), s1 = __builtin_bit_cast(float, __builtin_amdgcn_readlane(iv, 16));
    const float s2 = __builtin_bit_cast(float, __builtin_amdgcn_readlane(iv, 32)), s3 = __builtin_bit_cast(float, __builtin_amdgcn_readlane(iv, 48));
    return (s0 + s1) + (s2 + s3);
}
__device__ __forceinline__ void rms_row_to_bf16(const float* __restrict__ xrow, const float* __restrict__ g, bf16* __restrict__ orow, int lane) {
    const f32x4* xr = (const f32x4*)xrow + 2 * lane;
    f32x4 v[8]; float s = 0.f;
#pragma unroll
    for (int j = 0; j < 4; ++j) { v[2 * j] = __builtin_nontemporal_load(xr + 128 * j); v[2 * j + 1] = __builtin_nontemporal_load(xr + 128 * j + 1);
        s += (v[2 * j].x * v[2 * j].x + v[2 * j].y * v[2 * j].y) + (v[2 * j].z * v[2 * j].z + v[2 * j].w * v[2 * j].w);
        s += (v[2 * j + 1].x * v[2 * j + 1].x + v[2 * j + 1].y * v[2 * j + 1].y) + (v[2 * j + 1].z * v[2 * j + 1].z + v[2 * j + 1].w * v[2 * j + 1].w); }
    const float rs = rsqrtf(wave_sum_x(s) * (1.0f / D) + 1e-6f);
    const f32x4* g4 = (const f32x4*)g + 2 * lane;
    v4u* o16 = (v4u*)orow + lane;
#pragma unroll
    for (int j = 0; j < 4; ++j) { const f32x4 ga = g4[128 * j], gb = g4[128 * j + 1];
        v4u o; o.x = pk2(v[2 * j].x * rs * ga.x, v[2 * j].y * rs * ga.y); o.y = pk2(v[2 * j].z * rs * ga.z, v[2 * j].w * rs * ga.w);
        o.z = pk2(v[2 * j + 1].x * rs * gb.x, v[2 * j + 1].y * rs * gb.y); o.w = pk2(v[2 * j + 1].z * rs * gb.z, v[2 * j + 1].w * rs * gb.w);
        o16[64 * j] = o; }
}

struct MoeOrder {
    const LAS int* tp; const int* cnt; const int* list;
    int nN, G, c;
    const char* Abase; size_t a_tile_bytes;
    const char* Bbase; size_t b_exp_bytes, b_tile_bytes;
    __device__ __forceinline__ bool next(int i, pg8::GUnit& u) const {
        const int L0 = i * G + c, total = tp[NE] * nN; if (L0 >= total) return false;
        const int q = total >> 3, r = total & 7, xcd = L0 & 7, off = L0 >> 3;
        const int L = (xcd < r ? xcd * (q + 1) : r * (q + 1) + (xcd - r) * q) + off;
        const int mt = L / nN, pn = L - mt * nN;
        const int e = tp[40 + mt];
        const int lt = mt - tp[e];
        u.pm = mt; u.pn = pn;
        u.aBase = Abase + (size_t)mt * a_tile_bytes;
        u.bBase = Bbase + (size_t)e * b_exp_bytes + (size_t)pn * b_tile_bytes;
        u.rows = list + (size_t)e * NT + lt * 256;
        const int rem = cnt[e] - lt * 256; u.nvalid = rem < 256 ? rem : 256;
        return true;
    }
};
struct RowVG { __device__ __forceinline__ int operator()(int n) const { const int c = n < 1024 ? n : n - 1024; return n >= 2048 ? n : 256 * (c >> 7) + (c & 127) + (n < 1024 ? 0 : 128); } };
struct RowGU { int up; __device__ __forceinline__ int operator()(int j) const { return 32 * (j >> 4) + (j & 15) + up; } };

__device__ __forceinline__ void router_token(const float* __restrict__ hrow, const float* __restrict__ nf, const float* __restrict__ rgw, const float* __restrict__ rgb,
                                             const float* __restrict__ rew, const float* __restrict__ reb, bf16* __restrict__ vrow, int m, int lane,
                                             int* __restrict__ cnt, int* __restrict__ list, int* __restrict__ asg_e, int* __restrict__ asg_pos, float* __restrict__ gate) {
    const f32x4* xr = (const f32x4*)hrow + lane;
    float s = 0.f;
#pragma unroll
    for (int j = 0; j < 8; ++j) { const f32x4 t = xr[64 * j]; s += (t.x * t.x + t.y * t.y) + (t.z * t.z + t.w * t.w); }
    const float rs = rsqrtf(wave_sum_x(s) * (1.0f / D) + 1e-6f);
    const f32x4* g4 = (const f32x4*)nf + lane;
    unsigned long long* o8 = (unsigned long long*)vrow + lane;
    float lg[NG + NE];
#pragma unroll
    for (int i = 0; i < NG + NE; ++i) lg[i] = 0.f;
#pragma unroll 1
    for (int j = 0; j < 8; ++j) {
        const f32x4 gg = g4[64 * j], hv = xr[64 * j];
        f32x4 vv; vv.x = hv.x * rs * gg.x; vv.y = hv.y * rs * gg.y; vv.z = hv.z * rs * gg.z; vv.w = hv.w * rs * gg.w;
        o8[64 * j] = (unsigned long long)pk2(vv.x, vv.y) | ((unsigned long long)pk2(vv.z, vv.w) << 32);
        const int d0 = 4 * (lane + 64 * j);
#pragma unroll
        for (int q = 0; q < 4; ++q) {
            const float x = vv[q];
            const f32x4 rg = *(const f32x4*)(rgw + (size_t)(d0 + q) * NG);
            lg[0] += x * rg.x; lg[1] += x * rg.y; lg[2] += x * rg.z; lg[3] += x * rg.w;
            const f32x4* re = (const f32x4*)(rew + (size_t)(d0 + q) * NE);
#pragma unroll
            for (int e4 = 0; e4 < 8; ++e4) { const f32x4 w = re[e4]; lg[4 + 4 * e4] += x * w.x; lg[5 + 4 * e4] += x * w.y; lg[6 + 4 * e4] += x * w.z; lg[7 + 4 * e4] += x * w.w; }
        }
    }
    const float* rgb_o = rgb; const float* reb_o = reb;
    asm volatile("" : "+s"(rgb_o), "+s"(reb_o));
#pragma unroll
    for (int i = 0; i < NG + NE; ++i) lg[i] = wave_sum_x(lg[i]) + (i < NG ? rgb_o[i] : reb_o[i - NG]);
    int grp = 0; float gm = lg[0];
#pragma unroll
    for (int j = 1; j < NG; ++j) if (lg[j] > gm) { gm = lg[j]; grp = j; }
    float den = 0.f;
#pragma unroll
    for (int j = 0; j < NG; ++j) den += expf(lg[j] - gm);
    const float pg = 1.0f / den;
    int i1 = 0, i2 = 0; float v1 = 0.f, v2 = 0.f;
#pragma unroll
    for (int g = 0; g < NG; ++g) {
        int a1 = 0; float w1 = lg[NG + g * EPG];
#pragma unroll
        for (int j = 1; j < EPG; ++j) if (lg[NG + g * EPG + j] > w1) { w1 = lg[NG + g * EPG + j]; a1 = j; }
        int a2 = 0; float w2 = -3.0e38f;
#pragma unroll
        for (int j = 0; j < EPG; ++j) if (j != a1 && lg[NG + g * EPG + j] > w2) { w2 = lg[NG + g * EPG + j]; a2 = j; }
        if (g == 0 || grp == g) { i1 = a1; i2 = a2; v1 = w1; v2 = w2; }
    }
    const float e2 = expf(v2 - v1);
    if (lane == 0) {
        const int ea = grp * EPG + i1, eb = grp * EPG + i2;
        gate[2 * m] = pg / (1.0f + e2); gate[2 * m + 1] = pg * e2 / (1.0f + e2);
        const int pa = atomicAdd(&cnt[ea], 1); list[(size_t)ea * NT + pa] = m; asg_e[2 * m] = ea; asg_pos[2 * m] = pa;
        const int pb = atomicAdd(&cnt[eb], 1); list[(size_t)eb * NT + pb] = m; asg_e[2 * m + 1] = eb; asg_pos[2 * m + 1] = pb;
    }
}
__device__ __forceinline__ void final_token(const bf16* __restrict__ hrow, const bf16* __restrict__ y1, const bf16* __restrict__ y2, float g1, float g2,
                                            const float* __restrict__ nf, float* __restrict__ orow, int lane) {
    f32x4 v[8]; float s = 0.f;
#pragma unroll
    for (int j = 0; j < 4; ++j) {
        const int c = lane + 64 * j;
        const v4u hq = __builtin_nontemporal_load((const v4u*)hrow + c); f32x4 ha, hb;
        ha.x = __builtin_bit_cast(float, hq.x << 16); ha.y = __builtin_bit_cast(float, hq.x & 0xffff0000u); ha.z = __builtin_bit_cast(float, hq.y << 16); ha.w = __builtin_bit_cast(float, hq.y & 0xffff0000u);
        hb.x = __builtin_bit_cast(float, hq.z << 16); hb.y = __builtin_bit_cast(float, hq.z & 0xffff0000u); hb.z = __builtin_bit_cast(float, hq.w << 16); hb.w = __builtin_bit_cast(float, hq.w & 0xffff0000u);
        const v4u a = __builtin_nontemporal_load((const v4u*)y1 + c), b = __builtin_nontemporal_load((const v4u*)y2 + c);
        f32x4 ya, yb, za, zb;
        ya.x = __builtin_bit_cast(float, a.x << 16); ya.y = __builtin_bit_cast(float, a.x & 0xffff0000u); ya.z = __builtin_bit_cast(float, a.y << 16); ya.w = __builtin_bit_cast(float, a.y & 0xffff0000u);
        yb.x = __builtin_bit_cast(float, a.z << 16); yb.y = __builtin_bit_cast(float, a.z & 0xffff0000u); yb.z = __builtin_bit_cast(float, a.w << 16); yb.w = __builtin_bit_cast(float, a.w & 0xffff0000u);
        za.x = __builtin_bit_cast(float, b.x << 16); za.y = __builtin_bit_cast(float, b.x & 0xffff0000u); za.z = __builtin_bit_cast(float, b.y << 16); za.w = __builtin_bit_cast(float, b.y & 0xffff0000u);
        zb.x = __builtin_bit_cast(float, b.z << 16); zb.y = __builtin_bit_cast(float, b.z & 0xffff0000u); zb.z = __builtin_bit_cast(float, b.w << 16); zb.w = __builtin_bit_cast(float, b.w & 0xffff0000u);
        v[2 * j] = ha + g1 * ya + g2 * za; v[2 * j + 1] = hb + g1 * yb + g2 * zb;
        s += (v[2 * j].x * v[2 * j].x + v[2 * j].y * v[2 * j].y) + (v[2 * j].z * v[2 * j].z + v[2 * j].w * v[2 * j].w);
        s += (v[2 * j + 1].x * v[2 * j + 1].x + v[2 * j + 1].y * v[2 * j + 1].y) + (v[2 * j + 1].z * v[2 * j + 1].z + v[2 * j + 1].w * v[2 * j + 1].w);
    }
    const float rs = rsqrtf(wave_sum_x(s) * (1.0f / D) + 1e-6f);
#pragma unroll
    for (int j = 0; j < 4; ++j) {
        const int c = lane + 64 * j;
        const f32x4 ga = ((const f32x4*)nf)[2 * c], gb = ((const f32x4*)nf)[2 * c + 1];
        __builtin_nontemporal_store(v[2 * j] * rs * ga, (f32x4*)orow + 2 * c); __builtin_nontemporal_store(v[2 * j + 1] * rs * gb, (f32x4*)orow + 2 * c + 1);
    }
}
typedef short bf16x8_t __attribute__((ext_vector_type(8)));
typedef float f32x16 __attribute__((ext_vector_type(16)));
constexpr int TS = 144;
constexpr int FS = 68;
constexpr int SX_AT = 0, SX_RT = 9216, SX_BT = 18432, SX_KT = 27648, SX_VT = 36864, SX_BHT = 46080, SX_KHT = 55296,
              SX_AAK = 64512, SX_ARB = 73728, SX_ARK = 82944, SX_WT = 92160, SX_U0T = 101376, SX_AABT = 110592, SX_XU = SX_BT,
              SX_XW = 128000, SX_TOT = 145408, SX_PC = 147456;
static_assert(SX_AABT + 64 * FS * 4 <= SX_XW && SX_XW + 64 * FS * 4 <= SX_TOT && SX_TOT + 2048 <= SX_PC && SX_PC + 256 <= LDSCTL_OFF && 64 * FS * 4 <= 2 * 9216, "scan X LDS map");
constexpr int NUNITS = BATCH * NH * (T / 64);

__device__ __forceinline__ f32x16 mma_nt(const LAS unsigned char* X, int rx, const LAS unsigned char* Y, int ry, f32x16 acc, int lane) {
    const int r = lane & 31, h = lane >> 5;
#pragma unroll
    for (int s = 0; s < 4; ++s) {
        const bf16x8_t a = *(const LAS bf16x8_t*)(X + (rx + r) * TS + (16 * s + 8 * h) * 2);
        const bf16x8_t b = *(const LAS bf16x8_t*)(Y + (ry + r) * TS + (16 * s + 8 * h) * 2);
        acc = __builtin_amdgcn_mfma_f32_32x32x16_bf16(a, b, acc, 0, 0, 0);
    }
    return acc;
}
#define CROW(reg, lane) (((reg) & 3) + 8 * ((reg) >> 2) + 4 * ((lane) >> 5))
__device__ __forceinline__ f32x16 zero16() { f32x16 z;
#pragma unroll
    for (int i = 0; i < 16; ++i) z[i] = 0.f; return z; }

struct PrepIn { const bf16* proj; const bf16* lin; const bf16* lorat; const float* mu; const float* w0; const float* a0; const float* k_k; const float* k_a; const float* r_k; bf16* bonus; bf16* g16; };
__device__ __forceinline__ float wave_sum_dpp(float v) {
    v += __builtin_bit_cast(float, __builtin_amdgcn_update_dpp(0, __builtin_bit_cast(int, v), 0xB1, 0xF, 0xF, true));
    v += __builtin_bit_cast(float, __builtin_amdgcn_update_dpp(0, __builtin_bit_cast(int, v), 0x4E, 0xF, 0xF, true));
    v += __builtin_bit_cast(float, __builtin_amdgcn_update_dpp(0, __builtin_bit_cast(int, v), 0x141, 0xF, 0xF, true));
    v += __builtin_bit_cast(float, __builtin_amdgcn_update_dpp(0, __builtin_bit_cast(int, v), 0x140, 0xF, 0xF, true));
    const int iv = __builtin_bit_cast(int, v);
    const float s0 = __builtin_bit_cast(float, __builtin_amdgcn_readlane(iv, 0)), s1 = __builtin_bit_cast(float, __builtin_amdgcn_readlane(iv, 16));
    const float s2 = __builtin_bit_cast(float, __builtin_amdgcn_readlane(iv, 32)), s3 = __builtin_bit_cast(float, __builtin_amdgcn_readlane(iv, 48));
    return (s0 + s1) + (s2 + s3);
}
__device__ __forceinline__ unsigned cvt_pk(float lo, float hi) { unsigned r; asm volatile("v_cvt_pk_bf16_f32 %0, %1, %2" : "=v"(r) : "v"(lo), "v"(hi)); return r; }
#define LDS_BARRIER() do { asm volatile("s_waitcnt lgkmcnt(0)" ::: "memory"); __builtin_amdgcn_s_barrier(); asm volatile("" ::: "memory"); } while (0)
struct XRaw { unsigned r[9], k[9], v[9]; v4u lin[2], ltw, lta; float par[8]; };
__device__ __forceinline__ void scan_x_load(const PrepIn& P, int u, int w, int lane, XRaw& X) {
    const int bh = u >> 6, c = u & 63, b = bh >> 4, h = bh & 15, tq = w, col = h * HN + lane;
    const size_t mrow0 = (size_t)b * T + (size_t)c * 64 + tq * 8;
    const bf16* pr = P.proj + mrow0 * LDP;
    const bool hasprev = (c * 64 + tq * 8) > 0;
    const bf16* pp = pr - (hasprev ? LDP : 0);
    X.par[0] = P.mu[col]; X.par[1] = P.mu[DR + col]; X.par[2] = P.mu[2 * DR + col]; X.par[3] = P.w0[col]; X.par[4] = P.a0[col]; X.par[5] = P.k_k[col]; X.par[6] = P.k_a[col]; X.par[7] = P.r_k[col];
    X.r[0] = pp[col]; X.k[0] = pp[DR + col]; X.v[0] = pp[2 * DR + col];
#pragma unroll
    for (int i = 0; i < 8; ++i) {
        const bf16* ri = pr + (size_t)i * LDP;
        X.r[i + 1] = ri[col]; X.k[i + 1] = ri[DR + col]; X.v[i + 1] = ri[2 * DR + col];
    }
    const int tid = w * 64 + lane; const size_t m0 = (size_t)b * T + (size_t)c * 64;
#pragma unroll
    for (int i = 0; i < 2; ++i) { const int ck = tid + 512 * i; X.lin[i] = *(const v4u*)(P.lin + (m0 + (ck >> 4)) * 384 + (ck & 15) * 8); }
    X.ltw = *(const v4u*)(P.lorat + (size_t)(h * HN + (tid >> 3)) * 384 + (tid & 7) * 8);
    X.lta = *(const v4u*)(P.lorat + (size_t)(1024 + h * HN + (tid >> 3)) * 384 + 64 + (tid & 7) * 8);
}

constexpr int CV_ITEMS = 3 * NE * 256, CV_SCR = 64 * 64 * 4;
static_assert(8 * CV_SCR <= LDSCTL_OFF, "conversion LDS");
struct CvIn { const float* const* in; bf16* WguT; bf16* WdT; };
struct CvRegs { f32x4 v[16]; };
__device__ __forceinline__ void cv_load64(const CvIn& C, int item, int lane, CvRegs& R) {
    const int m = item / (NE * 256), r = item - m * (NE * 256), e = r >> 8, blk = r & 255;
    const int N = (m == 2) ? D : DE, nb = (m == 2) ? 32 : 8, kb = blk / nb, n0 = (blk - kb * nb) * 64;
    const float* W = C.in[24 + m] + (size_t)e * D * DE + (size_t)(64 * kb) * N + n0;
#pragma unroll
    for (int i = 0; i < 16; ++i) R.v[i] = __builtin_nontemporal_load((const f32x4*)(W + (size_t)(4 * i + (lane >> 4)) * N + 4 * (lane & 15)));
}
__device__ __forceinline__ void cv_finish64(const CvIn& C, int item, LAS float* scr, int lane, const CvRegs& R) {
    const int m = item / (NE * 256), r = item - m * (NE * 256), e = r >> 8, blk = r & 255;
    const int K = (m == 2) ? DE : D, nb = (m == 2) ? 32 : 8, kb = blk / nb, n0 = (blk - kb * nb) * 64;
#pragma unroll
    for (int i = 0; i < 16; ++i) { LAS float* d = scr + (4 * i + (lane >> 4)) * 65 + 4 * (lane & 15); d[0] = R.v[i].x; d[1] = R.v[i].y; d[2] = R.v[i].z; d[3] = R.v[i].w; }
    asm volatile("s_waitcnt lgkmcnt(0)" ::: "memory");
    const int c = lane & 7, nl = lane >> 3;
    bf16* WT = (m == 2) ? C.WdT + (size_t)e * D * DE : C.WguT + (size_t)e * 1024 * D;
#pragma unroll
    for (int i = 0; i < 8; ++i) {
        const int n = n0 + 8 * i + nl, row = (m == 2) ? n : 256 * (n >> 7) + (n & 127) + 128 * m;
        const LAS float* sp = scr + (8 * c) * 65 + 8 * i + nl;
        v4u o; o.x = cvt_pk(sp[0], sp[65]); o.y = cvt_pk(sp[2 * 65], sp[3 * 65]); o.z = cvt_pk(sp[4 * 65], sp[5 * 65]); o.w = cvt_pk(sp[6 * 65], sp[7 * 65]);
        __builtin_nontemporal_store(o, (v4u*)(WT + (size_t)row * K + 64 * kb + 8 * c));
    }
    asm volatile("s_waitcnt lgkmcnt(0)" ::: "memory");
}
__device__ __forceinline__ void cv_item_dma(const CvIn& C, int item, LAS float* tile, int lane) {
    const int m = item / (NE * 256), r = item - m * (NE * 256), e = r >> 8, blk = r & 255;
    const int N = (m == 2) ? D : DE, K = (m == 2) ? DE : D, nb = (m == 2) ? 32 : 8, kb = blk / nb, n0 = (blk - kb * nb) * 64;
    const float* W = C.in[24 + m] + (size_t)e * D * DE + (size_t)(64 * kb) * N + n0;
    asm volatile("" ::: "memory");
#pragma unroll
    for (int i = 0; i < 16; ++i) { const int k = 4 * i + (lane >> 4), q = (lane & 15) ^ ((k >> 3) & 7);
        __builtin_amdgcn_global_load_lds((const unsigned*)(W + (size_t)k * N + 4 * q), (LAS unsigned*)(tile + 256 * i), 16, 0, 2); }
    asm volatile("s_waitcnt vmcnt(0)" ::: "memory");
    const int c = lane & 7, nl = lane >> 3;
    bf16* WT = (m == 2) ? C.WdT + (size_t)e * D * DE : C.WguT + (size_t)e * 1024 * D;
#pragma unroll
    for (int i = 0; i < 8; ++i) {
        const int nn = 8 * i + nl, n = n0 + nn, row = (m == 2) ? n : 256 * (n >> 7) + (n & 127) + 128 * m;
        const LAS float* sp = tile + 512 * c + 4 * ((nn >> 2) ^ c) + (nn & 3);
        v4u o; o.x = cvt_pk(sp[0], sp[64]); o.y = cvt_pk(sp[128], sp[192]); o.z = cvt_pk(sp[256], sp[320]); o.w = cvt_pk(sp[384], sp[448]);
        *(v4u*)(WT + (size_t)row * K + 64 * kb + 8 * c) = o;
    }
    asm volatile("s_waitcnt lgkmcnt(0)" ::: "memory");
}
__device__ __forceinline__ void cv_half_issue(const CvIn& C, int item, int s, LAS float* tile, int lane) {
    const int m = item / (NE * 256), r = item - m * (NE * 256), e = r >> 8, blk = r & 255;
    const int N = (m == 2) ? D : DE, nb = (m == 2) ? 32 : 8, kb = blk / nb, n0 = (blk - kb * nb) * 64 + 32 * s;
    const float* W = C.in[24 + m] + (size_t)e * D * DE + (size_t)(64 * kb) * N + n0;
#pragma unroll
    for (int i = 0; i < 8; ++i) { const int k = 8 * i + (lane >> 3), q = (lane & 7) ^ (i & 7);
        __builtin_amdgcn_global_load_lds((const unsigned*)(W + (size_t)k * N + 4 * q), (LAS unsigned*)(tile + 2048 * s + 256 * i), 16, 0, 2); }
}
__device__ __forceinline__ void cv_half_emit(const CvIn& C, int item, int s, const LAS float* tile, int lane) {
    const int m = item / (NE * 256), r = item - m * (NE * 256), e = r >> 8, blk = r & 255;
    const int K = (m == 2) ? DE : D, nb = (m == 2) ? 32 : 8, kb = blk / nb, n0 = (blk - kb * nb) * 64 + 32 * s;
    const int c = lane & 7, nl = lane >> 3;
    bf16* WT = (m == 2) ? C.WdT + (size_t)e * D * DE : C.WguT + (size_t)e * 1024 * D;
#pragma unroll
    for (int i = 0; i < 4; ++i) {
        const int nn = 8 * i + nl, n = n0 + nn, row = (m == 2) ? n : 256 * (n >> 7) + (n & 127) + 128 * m;
        const LAS float* sp = tile + 2048 * s + 256 * c + 4 * ((nn >> 2) ^ c) + (nn & 3);
        v4u o; o.x = cvt_pk(sp[0], sp[32]); o.y = cvt_pk(sp[64], sp[96]); o.z = cvt_pk(sp[128], sp[160]); o.w = cvt_pk(sp[192], sp[224]);
        *(v4u*)(WT + (size_t)row * K + 64 * kb + 8 * c) = o;
    }
}
__device__ __forceinline__ void cv_chunk_dma(const CvIn& C, int it0, int nit, LAS float* tile, int lane) {
    const int H = 2 * nit;
    asm volatile("" ::: "memory");
    cv_half_issue(C, it0, 0, tile, lane); cv_half_issue(C, it0, 1, tile, lane);
#pragma unroll 1
    for (int g = 0; g < H; ++g) {
        if (g + 1 < H) asm volatile("s_waitcnt vmcnt(8)" ::: "memory"); else asm volatile("s_waitcnt vmcnt(0)" ::: "memory");
        cv_half_emit(C, it0 + (g >> 1), g & 1, tile, lane);
        asm volatile("s_waitcnt lgkmcnt(0)" ::: "memory");
        if (g + 2 < H) cv_half_issue(C, it0 + ((g + 2) >> 1), g & 1, tile, lane);
    }
}
constexpr int CV_CHUNK = 8;
__device__ __forceinline__ void cv_queue_run(const CvIn& C, unsigned* qword, int lo, int hi, LAS float* scr, int lane, int max_items = 1 << 30) {
    const int per = (hi - lo) >> 3, x0 = (int)(xb_xcc_id() & 7u);
    int done = 0;
    for (int att = 0; att < 8 && done < max_items; ++att) {
        const int sh = (x0 + att) & 7, slo = lo + sh * per, shi = slo + per;
        while (done < max_items) {
            const int want = (max_items - done) < CV_CHUNK ? (max_items - done) : CV_CHUNK;
            unsigned first = 0u;
            if (lane == 0) first = __hip_atomic_fetch_add(qword + 64 * sh, (unsigned)want, __ATOMIC_RELAXED, __HIP_MEMORY_SCOPE_AGENT);
            const int it0 = slo + (int)__builtin_amdgcn_readfirstlane(first);
            if (it0 >= shi) break;
            { const int nit = (shi - it0) < want ? (shi - it0) : want; cv_chunk_dma(C, it0, nit, scr, lane); }
            done += want;
        }
    }
}
template <int MODE>
__device__ __forceinline__ void scan_x_phase(Frame& F, const PrepIn& P, bf16* __restrict__ QH, bf16* __restrict__ Y0, bf16* __restrict__ Mc, bf16* __restrict__ Nc, int nsx) {
    LAS unsigned char* L = F.lds + RING_OFF;
    const int w = F.wave;
    int u = blockIdx.x;
    if (u >= NUNITS) return;
    XRaw X; scan_x_load(P, u, w, lane_id_fresh(), X);
#pragma unroll 1
    for (; u < NUNITS; u += nsx) {
    const int lane = lane_id_fresh(), tid = w * 64 + lane;
    const int bh = u >> 6, c = u & 63, b = bh >> 4, h = bh & 15;
    const size_t m0 = (size_t)b * T + (size_t)c * 64;
    {
        const int ch = lane, tq = w, col = h * HN + ch;
        const size_t mrow0 = m0 + tq * 8;
        constexpr int XR_S = 136;
        {
#pragma unroll
            for (int i = 0; i < 2; ++i) { const int ck = tid + 512 * i, row = ck >> 4, c8 = (ck & 15) * 8;
                *(LAS v4u*)(L + (c8 < 64 ? SX_AAK : SX_ARB) + row * TS + (c8 & 63) * 2) = X.lin[i]; }
            *(LAS v4u*)(L + SX_ARK + (tid >> 3) * TS + (tid & 7) * 16) = X.ltw;
            *(LAS v4u*)(L + SX_U0T + (tid >> 3) * TS + (tid & 7) * 16) = X.lta;
            LDS_BARRIER();
            const int mt = w >> 2, ib = (w >> 1) & 1, jb = w & 1, r = lane & 31;
            const f32x16 acc = mma_nt(L + (mt ? SX_ARB : SX_AAK), 32 * ib, L + (mt ? SX_U0T : SX_ARK), 32 * jb, zero16(), lane);
            LAS unsigned char* R = L + SX_AABT + mt * (64 * XR_S);
#pragma unroll
            for (int reg = 0; reg < 16; reg += 2) { const unsigned pkv = pk2(acc[reg], acc[reg + 1]); const int t = 32 * ib + CROW(reg, lane), j = 32 * jb + r;
                *(LAS unsigned short*)(R + t * XR_S + j * 2) = (unsigned short)(pkv & 0xffffu); *(LAS unsigned short*)(R + (t + 1) * XR_S + j * 2) = (unsigned short)(pkv >> 16); }
            LDS_BARRIER();
        }
        const float mur = X.par[0], muk = X.par[1], muv = X.par[2], w0c = X.par[3], a0c = X.par[4], kkc_ = X.par[5], kac = X.par[6], rkc = X.par[7];
        float cum[8], rr_[8], kk2[8], vv_[8], al_[8], be_[8]; float run = 1.f;
        unsigned short wlr[8], alr[8];
#pragma unroll
        for (int i = 0; i < 8; ++i) { wlr[i] = *(const LAS unsigned short*)(L + SX_AABT + (tq * 8 + i) * XR_S + ch * 2); alr[i] = *(const LAS unsigned short*)(L + SX_AABT + 64 * XR_S + (tq * 8 + i) * XR_S + ch * 2); }
#pragma unroll
        for (int i = 0; i < 8; ++i) {
#define XF(x) __builtin_bit_cast(float, (x) << 16)
            const float cr = XF(X.r[i + 1]), ck = XF(X.k[i + 1]), cv = XF(X.v[i + 1]);
            const bool zp = (i == 0) && (c * 64 + tq * 8 == 0);
            const float pr_ = zp ? 0.f : XF(X.r[i]), pk_ = zp ? 0.f : XF(X.k[i]), pv_ = zp ? 0.f : XF(X.v[i]);
            const float r = cr + (pr_ - cr) * mur, k = ck + (pk_ - ck) * muk, v = cv + (pv_ - cv) * muv;
            const float wl = w0c + bf2f(wlr[i]), al = a0c + bf2f(alr[i]);
            const float dec = __expf(-0.60653066f * __builtin_amdgcn_rcpf(1.0f + __expf(-wl)));
            const float a = __builtin_amdgcn_rcpf(1.0f + __expf(-al));
            const float kkc = k * kkc_;
            const float kk = kkc * __builtin_amdgcn_rsqf(fmaxf(wave_sum_dpp(kkc * kkc), 1e-24f));
            const float k2 = k * (1.0f + (a - 1.0f) * kac);
            const float bs = wave_sum_dpp(r * k2 * rkc);
            *(LAS unsigned short*)(L + SX_WT + tq * 1024 + i * 128 + ch * 2) = (unsigned short)(cvt_pk(bs * v, 0.f) & 0xffffu);
            rr_[i] = r; kk2[i] = k2; vv_[i] = v; al_[i] = -kk; be_[i] = kk * a;
            run *= dec; cum[i] = run;
        }
        if (MODE == 0) { asm volatile("s_waitcnt lgkmcnt(0)" ::: "memory");
            const v4u bo = *(const LAS v4u*)(L + SX_WT + tq * 1024 + lane * 16);
            *(v4u*)(P.bonus + (size_t)u * 4096 + (tq * 8 + (lane >> 3)) * 64 + 8 * (lane & 7)) = bo; }
        { const int un = u + nsx; if (un < NUNITS) scan_x_load(P, un, w, lane, X); }
        LAS float* tot = (LAS float*)(L + SX_TOT);
        tot[tq * 64 + ch] = run;
        LDS_BARRIER();
        float off = 1.f, pc = 1.f;
#pragma unroll
        for (int q = 0; q < 8; ++q) { const float x = tot[q * 64 + ch]; off *= (q < tq) ? x : 1.f; pc *= x; }
        if (tq == 0) ((LAS float*)(L + SX_PC))[ch] = pc;
        unsigned vt[4], bht[4], kht[4]; float atf[8]; float Pc_last = 0.f;
#pragma unroll
        for (int i = 0; i < 8; ++i) {
            const float Pp = off * cum[i], Pex = (i == 0) ? off : off * cum[i > 0 ? i - 1 : 0], Pi = __builtin_amdgcn_rcpf(Pp), Pc = pc * Pi;
            const float r = rr_[i], k = kk2[i], v = vv_[i], al = al_[i], be = be_[i];
            const int t = tq * 8 + i;
            atf[i] = al * Pex;
            const unsigned ar = cvt_pk(atf[i], r * Pp), bk = cvt_pk(be * Pi, k * Pi);
            *(LAS unsigned short*)(L + SX_AT + t * TS + ch * 2) = (unsigned short)(ar & 0xffffu);
            *(LAS unsigned short*)(L + SX_RT + t * TS + ch * 2) = (unsigned short)(ar >> 16);
            *(LAS unsigned short*)(L + SX_BT + t * TS + ch * 2) = (unsigned short)(bk & 0xffffu);
            *(LAS unsigned short*)(L + SX_KT + t * TS + ch * 2) = (unsigned short)(bk >> 16);
            if (i & 1) { vt[i >> 1] = cvt_pk(vv_[i - 1], v); bht[i >> 1] = cvt_pk(be_[i - 1] * Pc_last, be * Pc); kht[i >> 1] = cvt_pk(kk2[i - 1] * Pc_last, k * Pc); }
            Pc_last = Pc;
        }
        { LAS float* xw = (LAS float*)(L + SX_XW) + ch * FS + tq * 8; *(LAS f32x4*)xw = (f32x4){atf[0], atf[1], atf[2], atf[3]}; *(LAS f32x4*)(xw + 4) = (f32x4){atf[4], atf[5], atf[6], atf[7]}; }
        v4u o; o.x = vt[0]; o.y = vt[1]; o.z = vt[2]; o.w = vt[3]; *(LAS v4u*)(L + SX_VT + ch * TS + tq * 16) = o;
        o.x = bht[0]; o.y = bht[1]; o.z = bht[2]; o.w = bht[3]; *(LAS v4u*)(L + SX_BHT + ch * TS + tq * 16) = o;
        o.x = kht[0]; o.y = kht[1]; o.z = kht[2]; o.w = kht[3]; *(LAS v4u*)(L + SX_KHT + ch * TS + tq * 16) = o;
    }
    LDS_BARRIER();
    if (MODE == 1) continue;
    {
        const int mat = w >> 1, ib = w & 1, r = lane & 31;
        const LAS unsigned char* Xp = L + ((mat < 2) ? SX_AT : SX_RT);
        const LAS unsigned char* Yp = L + ((mat & 1) ? SX_KT : SX_BT);
        const int incl = (mat >= 2) ? 1 : 0;
#pragma unroll
        for (int jb = 0; jb < 2; ++jb) {
            f32x16 acc = zero16();
            if (jb <= ib) acc = mma_nt(Xp, 32 * ib, Yp, 32 * jb, acc, lane);
#pragma unroll
            for (int reg = 0; reg < 16; ++reg) {
                const int t = 32 * ib + CROW(reg, lane), j = 32 * jb + r;
                acc[reg] = (j < t + incl) ? acc[reg] : 0.f;
            }
            if (mat == 0) {
#pragma unroll
                for (int rg = 0; rg < 4; ++rg)
                    *(LAS f32x4*)((LAS float*)(L + SX_AABT) + (32 * jb + r) * FS + 32 * ib + 8 * rg + 4 * (lane >> 5)) = (f32x4){acc[4 * rg], acc[4 * rg + 1], acc[4 * rg + 2], acc[4 * rg + 3]};
            } else {
                LAS unsigned char* dstm = L + (mat == 1 ? SX_AAK : mat == 2 ? SX_ARB : SX_ARK);
#pragma unroll
                for (int reg = 0; reg < 16; reg += 2) { const unsigned pkv = cvt_pk(acc[reg], acc[reg + 1]); const int t = 32 * ib + CROW(reg, lane), j = 32 * jb + r;
                    *(LAS unsigned short*)(dstm + t * TS + j * 2) = (unsigned short)(pkv & 0xffffu); *(LAS unsigned short*)(dstm + (t + 1) * TS + j * 2) = (unsigned short)(pkv >> 16); }
            }
        }
    }
    LDS_BARRIER();
    if (w < 4) {
        const int ib = w >> 1, vb = w & 1, r = lane & 31;
        f32x16 acc = mma_nt(L + SX_AAK, 32 * ib, L + SX_VT, 32 * vb, zero16(), lane);
#pragma unroll
        for (int rg = 0; rg < 4; ++rg)
            *(LAS f32x4*)((LAS float*)(L + SX_XU) + (32 * vb + r) * FS + 32 * ib + 8 * rg + 4 * (lane >> 5)) = (f32x4){acc[4 * rg], acc[4 * rg + 1], acc[4 * rg + 2], acc[4 * rg + 3]};
    } else if (w == 4) {
        const LAS float* ATm = (const LAS float*)(L + SX_AABT);
        const int bb = lane >> 4, j = lane & 15;
        float t[16];
#pragma unroll
        for (int i = 0; i < 16; ++i) t[i] = (i == j) ? 1.f : 0.f;
#pragma unroll
        for (int m = 0; m < 15; ++m) {
            const LAS float* cp = ATm + (16 * bb + m) * FS + 16 * bb;
#pragma unroll
            for (int i4 = (m + 1) / 4; i4 < 4; ++i4) {
                const f32x4 l = *(const LAS f32x4*)(cp + 4 * i4);
                if (4 * i4 + 0 > m) t[4 * i4 + 0] += l.x * t[m];
                if (4 * i4 + 1 > m) t[4 * i4 + 1] += l.y * t[m];
                if (4 * i4 + 2 > m) t[4 * i4 + 2] += l.z * t[m];
                if (4 * i4 + 3 > m) t[4 * i4 + 3] += l.w * t[m];
            }
        }
        LAS float* TBw = (LAS float*)(L + SX_AT) + bb * 320 + j;
#pragma unroll
        for (int i = 0; i < 16; ++i) TBw[i * 20] = t[i];
    }
    LDS_BARRIER();
    {
        const LAS float* AT = (const LAS float*)(L + SX_AABT);
        const LAS float* TB = (const LAS float*)(L + SX_AT);
        LAS float* xb = (LAS float*)(L + (w < 4 ? SX_XW : SX_XU)) + (16 * (w & 3)) * FS;
        const int n = lane & 15, q = lane >> 4;
        LAS float* xcol = xb + n * FS;
#pragma unroll
        for (int b = 0; b < 4; ++b) {
            f32x4 acc0 = (f32x4){0.f, 0.f, 0.f, 0.f}, acc1 = acc0, acc2 = acc0, acc3 = acc0;
#pragma unroll
            for (int k0 = 0; k0 < 16 * b; k0 += 16) {
                const int k = k0 + q;
                const float a0 = AT[k * FS + 16 * b + n], a1 = AT[(k + 4) * FS + 16 * b + n], a2 = AT[(k + 8) * FS + 16 * b + n], a3 = AT[(k + 12) * FS + 16 * b + n];
                const float x0 = xcol[k], x1 = xcol[k + 4], x2 = xcol[k + 8], x3 = xcol[k + 12];
                acc0 = __builtin_amdgcn_mfma_f32_16x16x4f32(a0, x0, acc0, 0, 0, 0); acc1 = __builtin_amdgcn_mfma_f32_16x16x4f32(a1, x1, acc1, 0, 0, 0);
                acc2 = __builtin_amdgcn_mfma_f32_16x16x4f32(a2, x2, acc2, 0, 0, 0); acc3 = __builtin_amdgcn_mfma_f32_16x16x4f32(a3, x3, acc3, 0, 0, 0);
            }
            const f32x4 rhs = *(const LAS f32x4*)(xcol + 16 * b + 4 * q);
            const f32x4 z = (rhs + acc0) + (acc1 + acc2) + acc3;
            const f32x4 tb = *(const LAS f32x4*)(TB + b * 320 + n * 20 + 4 * q);
            f32x4 c = (f32x4){0.f, 0.f, 0.f, 0.f};
            c = __builtin_amdgcn_mfma_f32_16x16x4f32(z.x, tb.x, c, 0, 0, 0); c = __builtin_amdgcn_mfma_f32_16x16x4f32(z.y, tb.y, c, 0, 0, 0);
            c = __builtin_amdgcn_mfma_f32_16x16x4f32(z.z, tb.z, c, 0, 0, 0); c = __builtin_amdgcn_mfma_f32_16x16x4f32(z.w, tb.w, c, 0, 0, 0);
            LAS float* xo = xb + (4 * q) * FS + 16 * b + n;
            xo[0] = c.x; xo[FS] = c.y; xo[2 * FS] = c.z; xo[3 * FS] = c.w;
        }
        LAS unsigned char* dst = L + (w < 4 ? SX_WT : SX_U0T) + (16 * (w & 3) + n) * TS + q * 32;
        const f32x4 p0 = *(const LAS f32x4*)(xcol + 16 * q), p1 = *(const LAS f32x4*)(xcol + 16 * q + 4), p2 = *(const LAS f32x4*)(xcol + 16 * q + 8), p3 = *(const LAS f32x4*)(xcol + 16 * q + 12);
        v4u o; o.x = cvt_pk(p0.x, p0.y); o.y = cvt_pk(p0.z, p0.w); o.z = cvt_pk(p1.x, p1.y); o.w = cvt_pk(p1.z, p1.w); *(LAS v4u*)dst = o;
        o.x = cvt_pk(p2.x, p2.y); o.y = cvt_pk(p2.z, p2.w); o.z = cvt_pk(p3.x, p3.y); o.w = cvt_pk(p3.z, p3.w); *(LAS v4u*)(dst + 16) = o;
    }
    LDS_BARRIER();
    if (MODE == 2) continue;
    asm volatile("" :: "v"(X.r[0]), "v"(X.r[1]), "v"(X.r[2]), "v"(X.r[3]), "v"(X.r[4]), "v"(X.r[5]), "v"(X.r[6]), "v"(X.r[7]), "v"(X.r[8]), "v"(X.k[0]), "v"(X.k[1]), "v"(X.k[2]), "v"(X.k[3]), "v"(X.k[4]), "v"(X.k[5]), "v"(X.k[6]), "v"(X.k[7]), "v"(X.k[8]));
    asm volatile("" :: "v"(X.v[0]), "v"(X.v[1]), "v"(X.v[2]), "v"(X.v[3]), "v"(X.v[4]), "v"(X.v[5]), "v"(X.v[6]), "v"(X.v[7]), "v"(X.v[8]));
    asm volatile("" :: "v"(X.lin[0]), "v"(X.lin[1]), "v"(X.ltw), "v"(X.lta));
    {
        const int mat = w >> 1, ib = w & 1, r = lane & 31;
        LAS float* stg = (LAS float*)(L + (w == 0 ? SX_AT : w == 1 ? SX_AAK : w == 2 ? SX_BT : w == 3 ? SX_KT : SX_AABT + (w - 4) * 8704));
        const LAS unsigned char* XA = L + (mat < 2 ? SX_ARB : SX_BHT);
        const LAS unsigned char* YA = L + ((mat & 1) ? SX_U0T : SX_WT);
        const LAS unsigned char* XB = L + (mat < 2 ? SX_ARK : SX_KHT);
#pragma unroll
        for (int jb = 0; jb < 2; ++jb) {
            f32x16 acc = mma_nt(XA, 32 * ib, YA, 32 * jb, zero16(), lane);
            if (mat & 1) acc = mma_nt(XB, 32 * ib, L + SX_VT, 32 * jb, acc, lane);
#pragma unroll
            for (int reg = 0; reg < 16; ++reg) stg[CROW(reg, lane) * FS + 32 * jb + r] = acc[reg];
        }
        asm volatile("s_waitcnt lgkmcnt(0)" ::: "memory");
        if (MODE != 0) { if (stg[lane] == 123.456f) ((LAS float*)(L + SX_TOT))[lane] = 1.f; }
        else {
            bf16* O = (mat == 0 ? QH : mat == 1 ? Y0 : mat == 2 ? Mc : Nc) + (size_t)u * 4096 + (32 * ib) * 64 + 8 * (lane & 7);
            f32x4 a[4], b[4]; v4u rt[4]; float pcv[4];
#pragma unroll
            for (int it = 0; it < 4; ++it) { const int rl = 8 * it + (lane >> 3);
                a[it] = *(const LAS f32x4*)(stg + rl * FS + 8 * (lane & 7)); b[it] = *(const LAS f32x4*)(stg + rl * FS + 8 * (lane & 7) + 4);
                rt[it] = *(const LAS v4u*)(L + SX_RT + (32 * ib + rl) * TS + 16 * (lane & 7)); pcv[it] = ((const LAS float*)(L + SX_PC))[32 * ib + rl]; }
#pragma unroll
            for (int it = 0; it < 4; ++it) { const int rl = 8 * it + (lane >> 3);
                f32x4 x = a[it], y = b[it];
                if (mat == 0) { x.x += __builtin_bit_cast(float, rt[it].x << 16); x.y += __builtin_bit_cast(float, rt[it].x & 0xffff0000u); x.z += __builtin_bit_cast(float, rt[it].y << 16); x.w += __builtin_bit_cast(float, rt[it].y & 0xffff0000u);
                                y.x += __builtin_bit_cast(float, rt[it].z << 16); y.y += __builtin_bit_cast(float, rt[it].z & 0xffff0000u); y.z += __builtin_bit_cast(float, rt[it].w << 16); y.w += __builtin_bit_cast(float, rt[it].w & 0xffff0000u); }
                if (mat == 2) { const int d = 32 * ib + rl - 8 * (lane & 7); const float p = pcv[it];
                    x.x += (d == 0) ? p : 0.f; x.y += (d == 1) ? p : 0.f; x.z += (d == 2) ? p : 0.f; x.w += (d == 3) ? p : 0.f;
                    y.x += (d == 4) ? p : 0.f; y.y += (d == 5) ? p : 0.f; y.z += (d == 6) ? p : 0.f; y.w += (d == 7) ? p : 0.f; }
                v4u o; o.x = cvt_pk(x.x, x.y); o.y = cvt_pk(x.z, x.w); o.z = cvt_pk(y.x, y.y); o.w = cvt_pk(y.z, y.w);
                *(v4u*)(O + rl * 64) = o; }
        }
    }
    LDS_BARRIER();
    }
}

constexpr int SY_M = 0, SY_S = 64 * 65 * 4, SY_P = SY_S + 64 * FS * 4;
__device__ __forceinline__ void scan_y_chain(Frame& F, int bh, const float* __restrict__ Mc, const float* __restrict__ Nc, float* __restrict__ SS) {
    LAS unsigned char* L = F.lds + RING_OFF;
    LAS float* Ms = (LAS float*)(L + SY_M); LAS float* Ss = (LAS float*)(L + SY_S); LAS float* Ps = (LAS float*)(L + SY_P);
    const int tid = F.tid, lane = F.lane, w = F.wave, r = lane & 31, hh = lane >> 5;
    const int tile = w & 3, ti = tile >> 1, tj = tile & 1, kh = w >> 2;
    f32x16 S = zero16();
    for (int i = tid; i < 64 * FS; i += NTHR) Ss[i] = 0.f;
    f32x4 mA, mB; f32x16 nn = zero16();
    { const float* Mg = Mc + (size_t)(bh * 64) * 4096; mA = *(const f32x4*)(Mg + tid * 8); mB = *(const f32x4*)(Mg + tid * 8 + 4);
      if (kh == 0) { const float* Ng = Nc + (size_t)(bh * 64) * 4096;
#pragma unroll
          for (int reg = 0; reg < 16; ++reg) nn[reg] = Ng[(32 * ti + CROW(reg, lane)) * 64 + 32 * tj + r]; } }
    for (int c = 0; c < 64; ++c) {
        const size_t u = (size_t)bh * 64 + c;
        { const int e0 = tid * 8, row = e0 >> 6, col = e0 & 63; LAS float* d = Ms + row * 65 + col;
          d[0] = mA.x; d[1] = mA.y; d[2] = mA.z; d[3] = mA.w; d[4] = mB.x; d[5] = mB.y; d[6] = mB.z; d[7] = mB.w; }
        const f32x16 ncur = nn;
        if (kh == 0) {
#pragma unroll
            for (int reg = 0; reg < 16; ++reg) SS[u * 4096 + (32 * ti + CROW(reg, lane)) * 64 + 32 * tj + r] = S[reg];
        }
        if (c + 1 < 64) {
            const float* Mg = Mc + (u + 1) * 4096; mA = *(const f32x4*)(Mg + tid * 8); mB = *(const f32x4*)(Mg + tid * 8 + 4);
            if (kh == 0) { const float* Ng = Nc + (u + 1) * 4096;
#pragma unroll
                for (int reg = 0; reg < 16; ++reg) nn[reg] = Ng[(32 * ti + CROW(reg, lane)) * 64 + 32 * tj + r]; }
        }
        __syncthreads();
        f32x16 acc = zero16();
#pragma unroll
        for (int s = 0; s < 16; ++s) {
            const int k = 32 * kh + 2 * s + hh;
            acc = __builtin_amdgcn_mfma_f32_32x32x2f32(Ms[(32 * ti + r) * 65 + k], Ss[k * FS + 32 * tj + r], acc, 0, 0, 0);
        }
        if (kh == 1) {
#pragma unroll
            for (int reg = 0; reg < 16; ++reg) Ps[(tile * 16 + reg) * 64 + lane] = acc[reg];
        }
        __syncthreads();
        if (kh == 0) {
#pragma unroll
            for (int reg = 0; reg < 16; ++reg) { S[reg] = acc[reg] + Ps[(tile * 16 + reg) * 64 + lane] + ncur[reg]; Ss[(32 * ti + CROW(reg, lane)) * FS + 32 * tj + r] = S[reg]; }
        }
    }
    __syncthreads();
}

typedef unsigned SyU2 __attribute__((ext_vector_type(2)));
struct SyRaw { v4u m[2]; SyU2 n; };
constexpr int SY4_MS = 68, SY4_MB = 64 * SY4_MS * 4, SY4_SB = 16 * SY4_MS * 4, SY4_M = 0, SY4_S = 2 * SY4_MB, SY4_N = SY4_S + 2 * SY4_SB;
__device__ __forceinline__ void scan_y_chain4(Frame& F, int job, const bf16* __restrict__ Mc, const bf16* __restrict__ Nc, bf16* __restrict__ SS) {
    LAS unsigned char* L = F.lds + RING_OFF;
    const int tid = F.tid, lane = F.lane, w = F.wave, bh = job >> 2, cq = job & 3;
    const int li = lane & 15, lq = lane >> 4;
    const size_t u0 = (size_t)bh * 64;
    for (int i = tid; i < 16 * SY4_MS; i += NTHR) ((LAS float*)(L + SY4_S))[i] = 0.f;
    constexpr int PD = 4;
    if (w >= 4) {
        const int lt = tid - 256, row = lt >> 2, col = (lt & 3) * 16, nrow = lt >> 2, ncol = (lt & 3) * 4;
        const unsigned mo = (unsigned)(16 * lt) * 2u, no = (unsigned)(nrow * 64 + ncol) * 2u;
#define SY4_LDM(cc, q) (*(const v4u*)((const char*)(Mc + (u0 + (cc)) * 4096 + 8 * (q)) + mo))
#define SY4_LDN(cc) (*(const SyU2*)((const char*)(Nc + (u0 + (cc)) * 4096 + 16 * cq) + no))
#define SY4_W(u_) (f32x4){__builtin_bit_cast(float, (u_).x << 16), __builtin_bit_cast(float, (u_).x & 0xffff0000u), __builtin_bit_cast(float, (u_).y << 16), __builtin_bit_cast(float, (u_).y & 0xffff0000u)}
#define SY4_W2(u_) (f32x4){__builtin_bit_cast(float, (u_).z << 16), __builtin_bit_cast(float, (u_).z & 0xffff0000u), __builtin_bit_cast(float, (u_).w << 16), __builtin_bit_cast(float, (u_).w & 0xffff0000u)}
#define SY4_PUT(buf, r) do { LAS float* d_ = (LAS float*)(L + SY4_M + (buf) * SY4_MB) + row * SY4_MS + col; \
            *(LAS f32x4*)d_ = SY4_W((r).m[0]); *(LAS f32x4*)(d_ + 4) = SY4_W2((r).m[0]); *(LAS f32x4*)(d_ + 8) = SY4_W((r).m[1]); *(LAS f32x4*)(d_ + 12) = SY4_W2((r).m[1]); \
            LAS float* n_ = (LAS float*)(L + SY4_N + (buf) * SY4_SB) + ncol * SY4_MS + nrow; n_[0] = __builtin_bit_cast(float, (r).n.x << 16); n_[SY4_MS] = __builtin_bit_cast(float, (r).n.x & 0xffff0000u); \
            n_[2 * SY4_MS] = __builtin_bit_cast(float, (r).n.y << 16); n_[3 * SY4_MS] = __builtin_bit_cast(float, (r).n.y & 0xffff0000u); } while (0)
        SyRaw b[PD];
        { SyRaw a; a.m[0] = SY4_LDM(0, 0); a.m[1] = SY4_LDM(0, 1); a.n = SY4_LDN(0);
#pragma unroll
          for (int j = 0; j < PD; ++j) { b[j].m[0] = SY4_LDM(1 + j, 0); b[j].m[1] = SY4_LDM(1 + j, 1); b[j].n = SY4_LDN(1 + j); }
          SY4_PUT(0, a); }
        LDS_BARRIER();
#pragma unroll 1
        for (int c8 = 0; c8 < 64; c8 += PD) {
#pragma unroll
            for (int j = 0; j < PD; ++j) { const int c = c8 + j;
                SY4_PUT((c + 1) & 1, b[j]);
                { const int cn = (c + 1 + PD < 64) ? c + 1 + PD : 63;
                  b[j].m[0] = SY4_LDM(cn, 0); b[j].m[1] = SY4_LDM(cn, 1); b[j].n = SY4_LDN(cn); }
                LDS_BARRIER();
            }
        }
#undef SY4_LDM
#undef SY4_LDN
#undef SY4_PUT
#undef SY4_W
#undef SY4_W2
    } else {
        const int rb = w;
        f32x4 S = (f32x4){0.f, 0.f, 0.f, 0.f};
        LDS_BARRIER();
#pragma unroll 1
        for (int c = 0; c < 64; ++c) {
            const size_t u = u0 + c;
            const LAS float* Ms = (const LAS float*)(L + SY4_M + (c & 1) * SY4_MB) + (16 * rb + li) * SY4_MS + 16 * lq;
            const LAS float* Ss = (const LAS float*)(L + SY4_S + (c & 1) * SY4_SB) + li * SY4_MS + 16 * lq;
            const LAS float* Ns = (const LAS float*)(L + SY4_N + (c & 1) * SY4_SB) + li * SY4_MS + 16 * rb + 4 * lq;
            LAS float* Sn = (LAS float*)(L + SY4_S + ((c + 1) & 1) * SY4_SB) + li * SY4_MS + 16 * rb + 4 * lq;
            { typedef unsigned u32x2 __attribute__((ext_vector_type(2)));
              *(u32x2*)(SS + u * 4096 + (size_t)(16 * cq + li) * 64 + 16 * rb + 4 * lq) = (u32x2){cvt_pk(S[0], S[1]), cvt_pk(S[2], S[3])}; }
            f32x4 am[4], bs[4];
#pragma unroll
            for (int q = 0; q < 4; ++q) { am[q] = *(const LAS f32x4*)(Ms + 4 * q); bs[q] = *(const LAS f32x4*)(Ss + 4 * q); }
            f32x4 acc0 = *(const LAS f32x4*)Ns, acc1 = (f32x4){0.f, 0.f, 0.f, 0.f}, acc2 = acc1, acc3 = acc1;
#pragma unroll
            for (int q = 0; q < 4; ++q) {
                acc0 = __builtin_amdgcn_mfma_f32_16x16x4f32(am[q].x, bs[q].x, acc0, 0, 0, 0); acc1 = __builtin_amdgcn_mfma_f32_16x16x4f32(am[q].y, bs[q].y, acc1, 0, 0, 0);
                acc2 = __builtin_amdgcn_mfma_f32_16x16x4f32(am[q].z, bs[q].z, acc2, 0, 0, 0); acc3 = __builtin_amdgcn_mfma_f32_16x16x4f32(am[q].w, bs[q].w, acc3, 0, 0, 0);
            }
            S = (acc0 + acc1) + (acc2 + acc3);
            *(LAS f32x4*)Sn = S;
            LDS_BARRIER();
        }
    }
    LDS_BARRIER();
}

constexpr int SZ_Q = 0, SZ_S = 64 * TS, SZ_Y = 2 * 64 * TS, SZ_UNIT = SZ_Y + 64 * 65 * 4;
struct PostIn { const float* gn_g; const float* gn_b; const bf16* bonus; const bf16* lout; bf16* mixed; };
struct ZRaw { v4u q[2], s[2]; v4u y0r[2], bo[2], gt[2]; };
__device__ __forceinline__ void scan_z_load(int u, int w, int lane, const bf16* __restrict__ QH, const bf16* __restrict__ Y0, const bf16* __restrict__ SS, const bf16* __restrict__ bonus, const bf16* __restrict__ lout, ZRaw& R) {
    const int bh = u >> 6, c = u & 63, b = bh >> 4, h = bh & 15, lt = (w & 3) * 64 + lane, r = lane & 31;
    const size_t m0 = (size_t)b * T + (size_t)c * 64;
#pragma unroll
    for (int i = 0; i < 2; ++i) { const int ck = lt + 256 * i, row = ck >> 3, c8 = (ck & 7) * 8;
        R.q[i] = *(const v4u*)(QH + (size_t)u * 4096 + row * 64 + c8);
        R.s[i] = *(const v4u*)(SS + (size_t)u * 4096 + row * 64 + c8); }
    { const int t = lt >> 2, q = lt & 3;
      const bf16* bp = bonus + (size_t)u * 4096 + t * 64 + 16 * q; R.bo[0] = *(const v4u*)bp; R.bo[1] = *(const v4u*)(bp + 8);
      const bf16* yp = Y0 + (size_t)u * 4096 + t * 64 + 16 * q; R.y0r[0] = *(const v4u*)yp; R.y0r[1] = *(const v4u*)(yp + 8);
      const bf16* gp = lout + (m0 + t) * 1024 + h * HN + 16 * q; R.gt[0] = *(const v4u*)gp; R.gt[1] = *(const v4u*)(gp + 8); }
}
__device__ __forceinline__ void scan_z_phase(Frame& F, const bf16* __restrict__ QH, const bf16* __restrict__ Y0, const bf16* __restrict__ SS, const PostIn& Z) {
    typedef unsigned u32x2 __attribute__((ext_vector_type(2)));
    const int w = F.wave, half = w >> 2;
    LAS unsigned char* L = F.lds + RING_OFF + half * SZ_UNIT;
    LAS float* Qs = (LAS float*)(L + SZ_Y);
    int u = half * (int)F.G + (int)blockIdx.x;
    ZRaw R;
    if (u < NUNITS) scan_z_load(u, w, lane_id_fresh(), QH, Y0, SS, Z.bonus, Z.lout, R);
#pragma unroll 1
    for (int base = 0; base < NUNITS; base += 2 * (int)F.G, u += 2 * (int)F.G) {
        const bool valid = u < NUNITS;
        const int lane = lane_id_fresh(), lt = (w & 3) * 64 + lane, r = lane & 31, hh = lane >> 5;
        const int uu = valid ? u : 0, bh = uu >> 6, c = uu & 63, b = bh >> 4, h = bh & 15;
        const size_t m0 = (size_t)b * T + (size_t)c * 64;
        const int tile = w & 3, ti = tile >> 1, tj = tile & 1;
        f32x16 acc = zero16();
        if (valid) {
#pragma unroll
            for (int i = 0; i < 2; ++i) { const int ck = lt + 256 * i, row = ck >> 3, c8 = (ck & 7) * 8;
                *(LAS v4u*)(L + SZ_Q + row * TS + c8 * 2) = R.q[i]; *(LAS v4u*)(L + SZ_S + row * TS + c8 * 2) = R.s[i]; }
        }
        v4u bo0 = (v4u){0u, 0u, 0u, 0u}, bo1 = bo0, gt0 = bo0, gt1 = bo0;
        v4u yr0 = bo0, yr1 = bo0;
        if (valid) { bo0 = R.bo[0]; bo1 = R.bo[1]; gt0 = R.gt[0]; gt1 = R.gt[1]; yr0 = R.y0r[0]; yr1 = R.y0r[1]; }
        if (u + 2 * (int)F.G < NUNITS) scan_z_load(u + 2 * (int)F.G, w, lane, QH, Y0, SS, Z.bonus, Z.lout, R);
        const int t = lt >> 2, q = lt & 3, col = h * HN + 16 * q;
        const size_t o = (m0 + t) * DR + col;
        f32x4 gnG[4], gnB[4];
#pragma unroll
        for (int i4 = 0; i4 < 4; ++i4) { gnG[i4] = *(const f32x4*)(Z.gn_g + col + 4 * i4); gnB[i4] = *(const f32x4*)(Z.gn_b + col + 4 * i4); }
        LDS_BARRIER();
        if (valid) {
            acc = mma_nt(L + SZ_Q, 32 * ti, L + SZ_S, 32 * tj, acc, lane);
        }
        if (valid) {
#pragma unroll
            for (int reg = 0; reg < 16; ++reg) Qs[(32 * ti + CROW(reg, lane)) * 65 + 32 * tj + r] = acc[reg];
        }
        LDS_BARRIER();
        if (valid) {
            float y[16]; float sm = 0.f;
#pragma unroll
            for (int i = 0; i < 16; ++i) { const unsigned yw = (i < 8) ? ((i >> 1) == 0 ? yr0.x : (i >> 1) == 1 ? yr0.y : (i >> 1) == 2 ? yr0.z : yr0.w) : ((i >> 1) == 4 ? yr1.x : (i >> 1) == 5 ? yr1.y : (i >> 1) == 6 ? yr1.z : yr1.w);
                y[i] = Qs[t * 65 + 16 * q + i] + ((i & 1) ? __builtin_bit_cast(float, yw & 0xffff0000u) : __builtin_bit_cast(float, yw << 16)); sm += y[i]; }
            sm += __builtin_bit_cast(float, __builtin_amdgcn_update_dpp(0, __builtin_bit_cast(int, sm), 0xB1, 0xF, 0xF, true));
            sm += __builtin_bit_cast(float, __builtin_amdgcn_update_dpp(0, __builtin_bit_cast(int, sm), 0x4E, 0xF, 0xF, true));
            const float mean = sm * (1.0f / 64.0f); float qv = 0.f;
#pragma unroll
            for (int i = 0; i < 16; ++i) { y[i] -= mean; qv += y[i] * y[i]; }
            qv += __builtin_bit_cast(float, __builtin_amdgcn_update_dpp(0, __builtin_bit_cast(int, qv), 0xB1, 0xF, 0xF, true));
            qv += __builtin_bit_cast(float, __builtin_amdgcn_update_dpp(0, __builtin_bit_cast(int, qv), 0x4E, 0xF, 0xF, true));
            const float rs = rsqrtf(qv * (1.0f / 64.0f) + 64e-5f);
            const unsigned bw[8] = {bo0.x, bo0.y, bo0.z, bo0.w, bo1.x, bo1.y, bo1.z, bo1.w}, gw8[8] = {gt0.x, gt0.y, gt0.z, gt0.w, gt1.x, gt1.y, gt1.z, gt1.w};
            unsigned pk[8];
#pragma unroll
            for (int i4 = 0; i4 < 4; ++i4) {
                const f32x4 gg = gnG[i4], gb = gnB[i4];
                const unsigned bA = bw[2 * i4], bB = bw[2 * i4 + 1], gA = gw8[2 * i4], gB = gw8[2 * i4 + 1];
                pk[2 * i4] = cvt_pk((y[4 * i4] * rs * gg.x + gb.x + __builtin_bit_cast(float, bA << 16)) * __builtin_bit_cast(float, gA << 16),
                                    (y[4 * i4 + 1] * rs * gg.y + gb.y + __builtin_bit_cast(float, bA & 0xffff0000u)) * __builtin_bit_cast(float, gA & 0xffff0000u));
                pk[2 * i4 + 1] = cvt_pk((y[4 * i4 + 2] * rs * gg.z + gb.z + __builtin_bit_cast(float, bB << 16)) * __builtin_bit_cast(float, gB << 16),
                                        (y[4 * i4 + 3] * rs * gg.w + gb.w + __builtin_bit_cast(float, bB & 0xffff0000u)) * __builtin_bit_cast(float, gB & 0xffff0000u));
            }
            bf16* dst = Z.mixed + (m0 + t) * D + DC + col;
            *(v4u*)dst = (v4u){pk[0], pk[1], pk[2], pk[3]}; *(v4u*)(dst + 8) = (v4u){pk[4], pk[5], pk[6], pk[7]};
        }
        LDS_BARRIER();
    }
}
__device__ __forceinline__ void lora_in_token(const bf16* __restrict__ proj, const float* __restrict__ mu, bf16* __restrict__ lin, int m, int lane) {
    const bf16* p = proj + (size_t)m * LDP + 3 * DR;
    const bool hasprev = (m % T) > 0;
#pragma unroll
    for (int i = 0; i < 6; ++i) {
        const int j = lane + 64 * i;
        float o = 0.f;
        if (j < LW + LA + LG) {
            const float cur = bf2f(p[j]), prv = hasprev ? bf2f(p[j - LDP]) : 0.f;
            const float x = cur + (prv - cur) * mu[3 * DR + j];
            o = (j < LW) ? (1.0f - 2.0f * __builtin_amdgcn_rcpf(1.0f + __expf(2.0f * x))) : (j < LW + LA) ? x : __builtin_amdgcn_rcpf(1.0f + __expf(-x));
        }
        lin[(size_t)m * 384 + j] = (bf16)f2bf(o);
    }
}
__device__ __forceinline__ void lora_in_flat3(const bf16* __restrict__ proj, const float* __restrict__ mu, bf16* __restrict__ lin, int g0, int gstride) {
    constexpr int NCH = NT * 48;
    v4u cu[3], pv[3]; f32x4 ma[3], mb[3];
#pragma unroll
    for (int k = 0; k < 3; ++k) { const int g = g0 + k * gstride, m = g / 48, jc = (g - 48 * m) * 8;
        cu[k] = (v4u){0u, 0u, 0u, 0u}; pv[k] = cu[k]; ma[k] = (f32x4){0.f, 0.f, 0.f, 0.f}; mb[k] = ma[k];
        if (g < NCH && jc < LW + LA + LG) { const bf16* p = proj + (size_t)m * LDP + 3 * DR + jc;
            cu[k] = *(const v4u*)p; if ((m % T) > 0) pv[k] = *(const v4u*)(p - LDP);
            ma[k] = *(const f32x4*)(mu + 3 * DR + jc); mb[k] = *(const f32x4*)(mu + 3 * DR + jc + 4); } }
#pragma unroll
    for (int k = 0; k < 3; ++k) { const int g = g0 + k * gstride, m = g / 48, jc = (g - 48 * m) * 8;
        if (g >= NCH) break;
        const unsigned cw[4] = {cu[k].x, cu[k].y, cu[k].z, cu[k].w}, pw[4] = {pv[k].x, pv[k].y, pv[k].z, pv[k].w};
        const float mv[8] = {ma[k].x, ma[k].y, ma[k].z, ma[k].w, mb[k].x, mb[k].y, mb[k].z, mb[k].w};
        float o[8];
#pragma unroll
        for (int i = 0; i < 8; ++i) {
            const float c = (i & 1) ? __builtin_bit_cast(float, cw[i >> 1] & 0xffff0000u) : __builtin_bit_cast(float, cw[i >> 1] << 16);
            const float p = (i & 1) ? __builtin_bit_cast(float, pw[i >> 1] & 0xffff0000u) : __builtin_bit_cast(float, pw[i >> 1] << 16);
            const float x = c + (p - c) * mv[i];
            o[i] = (jc >= LW + LA + LG) ? 0.f : (jc < LW) ? (1.0f - 2.0f * __builtin_amdgcn_rcpf(1.0f + __expf(2.0f * x))) : (jc < LW + LA) ? x : __builtin_amdgcn_rcpf(1.0f + __expf(-x)); }
        *(v4u*)(lin + (size_t)m * 384 + jc) = (v4u){pk2(o[0], o[1]), pk2(o[2], o[3]), pk2(o[4], o[5]), pk2(o[6], o[7])}; }
}
constexpr int CV_TT = 32, CV_ROWS = CV_TT + CW - 1, CV_RH = CV_ROWS / 2;
constexpr int CV_RED = CV_ROWS * DC * 2;
static_assert(CV_ROWS % 2 == 0 && CV_RED + 8 * 2 * CV_TT * 4 + 2 * CV_TT * 4 <= LDSCTL_OFF, "conv LDS");
__device__ __forceinline__ void conv_unit(Frame& F, int unit, const bf16* __restrict__ glu, const float* __restrict__ dw, const float* __restrict__ cb,
                                          const float* __restrict__ lng, const float* __restrict__ lnb, bf16* __restrict__ mixed) {
    LAS unsigned char* L = F.lds + RING_OFF;
    const int w = F.wave, lane = lane_id_fresh(), tid = w * 64 + lane;
    const int m0 = unit * CV_TT, tseq0 = m0 % T;
    {
#pragma unroll
        for (int q = 0; q < (2 * CV_ROWS + 7) / 8; ++q) {
            const int e = w + 8 * q;
            if (e < 2 * CV_ROWS) {
                const int rr = e >> 1, hf = e & 1, ts = tseq0 - (CW - 1) + rr;
                LAS unsigned char* dst = L + rr * (DC * 2) + hf * 1024;
                if (ts >= 0) __builtin_amdgcn_global_load_lds((const unsigned*)(glu + (size_t)(m0 - (CW - 1) + rr) * DC + hf * 512 + lane * 8), (LAS unsigned*)dst, 16, 0, 0);
                else *(LAS v4u*)(dst + lane * 16) = (v4u){0u, 0u, 0u, 0u};
            }
        }
        asm volatile("s_waitcnt vmcnt(0)" ::: "memory");
    }
    __syncthreads();
    const int c0 = 2 * tid;
    float g0[CV_ROWS], g1[CV_ROWS];
#pragma unroll
    for (int rr = 0; rr < CV_ROWS; ++rr) { const unsigned x = *(const LAS unsigned*)(L + rr * (DC * 2) + c0 * 2); g0[rr] = __builtin_bit_cast(float, x << 16); g1[rr] = __builtin_bit_cast(float, x & 0xffff0000u); }
    float a0[CV_TT], a1[CV_TT];
    { const float b0 = cb[c0], b1 = cb[c0 + 1];
#pragma unroll
      for (int t = 0; t < CV_TT; ++t) { a0[t] = b0; a1[t] = b1; } }
    typedef float f32x2_t __attribute__((ext_vector_type(2)));
    f32x2_t wA[8], wB[8];
#pragma unroll
    for (int q = 0; q < 8; ++q) wA[q] = *(const f32x2_t*)(dw + q * DC + c0);
#pragma unroll
    for (int g = 0; g < 4; ++g) {
        if (g + 1 < 4) {
#pragma unroll
            for (int q = 0; q < 8; ++q) { const int j = 8 * (g + 1) + q; if (j < CW) { if (g & 1) wA[q] = *(const f32x2_t*)(dw + j * DC + c0); else wB[q] = *(const f32x2_t*)(dw + j * DC + c0); } }
        }
        asm volatile("" ::: "memory");
#pragma unroll
        for (int q = 0; q < 8; ++q) { const int j = 8 * g + q;
            if (j < CW) { const f32x2_t wv = (g & 1) ? wB[q] : wA[q];
#pragma unroll
                for (int t = 0; t < CV_TT; ++t) { a0[t] += wv.x * g0[t + j]; a1[t] += wv.y * g1[t + j]; } } }
        asm volatile("" ::: "memory");
    }
    LAS float* red = (LAS float*)(L + CV_RED);
#pragma unroll
    for (int t = 0; t < CV_TT; ++t) {
        float s = a0[t] + a1[t], q = a0[t] * a0[t] + a1[t] * a1[t];
        s = wave_sum_dpp(s); q = wave_sum_dpp(q);
        if (lane == 0) { red[w * 2 * CV_TT + t] = s; red[w * 2 * CV_TT + CV_TT + t] = q; }
    }
    __syncthreads();
    if (tid < 2 * CV_TT) { float s = 0.f;
#pragma unroll
        for (int k = 0; k < 8; ++k) s += red[k * 2 * CV_TT + tid];
        red[8 * 2 * CV_TT + tid] = s; }
    __syncthreads();
    const float lg0 = lng[c0], lg1 = lng[c0 + 1], lb0 = lnb[c0], lb1 = lnb[c0 + 1];
#pragma unroll
    for (int t = 0; t < CV_TT; ++t) {
        const float mu = red[8 * 2 * CV_TT + t] * (1.0f / DC), var = red[8 * 2 * CV_TT + CV_TT + t] * (1.0f / DC) - mu * mu;
        const float rs = rsqrtf(fmaxf(var, 0.f) + 1e-5f);
        const float z0 = (a0[t] - mu) * rs * lg0 + lb0, z1 = (a1[t] - mu) * rs * lg1 + lb1;
        *(LAS unsigned*)(L + t * (DC * 2) + c0 * 2) = cvt_pk(z0 * __builtin_amdgcn_rcpf(1.0f + __expf(-z0)), z1 * __builtin_amdgcn_rcpf(1.0f + __expf(-z1)));
    }
    __syncthreads();
#pragma unroll
    for (int q = 0; q < 8; ++q) { const int ck = tid + 512 * q, t = ck >> 7, c8 = (ck & 127) * 8;
        *(v4u*)(mixed + (size_t)(m0 + t) * D + c8) = *(const LAS v4u*)(L + t * (DC * 2) + c8 * 2); }
    __syncthreads();
}

__device__ __forceinline__ void rms_row16_to_bf16(const bf16* __restrict__ hrow, const float* __restrict__ g, bf16* __restrict__ orow, int lane) {
    float v[32]; float s = 0.f;
#pragma unroll
    for (int j = 0; j < 4; ++j) { const v4u a = ((const v4u*)hrow)[lane + 64 * j];
        v[8 * j] = __builtin_bit_cast(float, a.x << 16); v[8 * j + 1] = __builtin_bit_cast(float, a.x & 0xffff0000u); v[8 * j + 2] = __builtin_bit_cast(float, a.y << 16); v[8 * j + 3] = __builtin_bit_cast(float, a.y & 0xffff0000u);
        v[8 * j + 4] = __builtin_bit_cast(float, a.z << 16); v[8 * j + 5] = __builtin_bit_cast(float, a.z & 0xffff0000u); v[8 * j + 6] = __builtin_bit_cast(float, a.w << 16); v[8 * j + 7] = __builtin_bit_cast(float, a.w & 0xffff0000u);
#pragma unroll
        for (int q = 0; q < 8; ++q) s += v[8 * j + q] * v[8 * j + q]; }
    const float rs = rsqrtf(wave_sum_x(s) * (1.0f / D) + 1e-6f);
#pragma unroll
    for (int j = 0; j < 4; ++j) { const int c = lane + 64 * j; const f32x4 ga = ((const f32x4*)g)[2 * c], gb = ((const f32x4*)g)[2 * c + 1];
        v4u o; o.x = pk2(v[8 * j] * rs * ga.x, v[8 * j + 1] * rs * ga.y); o.y = pk2(v[8 * j + 2] * rs * ga.z, v[8 * j + 3] * rs * ga.w);
        o.z = pk2(v[8 * j + 4] * rs * gb.x, v[8 * j + 5] * rs * gb.y); o.w = pk2(v[8 * j + 6] * rs * gb.z, v[8 * j + 7] * rs * gb.w);
        ((v4u*)orow)[c] = o; }
}

__device__ __forceinline__ void rms_raw16_to_bf16(const v4u (&a)[4], const float* __restrict__ g, bf16* __restrict__ orow, int lane) {
    float s = 0.f;
#pragma unroll
    for (int j = 0; j < 4; ++j) {
        const unsigned wv[4] = {a[j].x, a[j].y, a[j].z, a[j].w};
#pragma unroll
        for (int q = 0; q < 4; ++q) { const float lo = __builtin_bit_cast(float, wv[q] << 16), hi = __builtin_bit_cast(float, wv[q] & 0xffff0000u); s += lo * lo + hi * hi; } }
    const float rs = rsqrtf(wave_sum_x(s) * (1.0f / D) + 1e-6f);
#pragma unroll
    for (int j = 0; j < 4; ++j) { const int c = lane + 64 * j; const f32x4 ga = ((const f32x4*)g)[2 * c], gb = ((const f32x4*)g)[2 * c + 1];
        v4u o;
        o.x = pk2(__builtin_bit_cast(float, a[j].x << 16) * rs * ga.x, __builtin_bit_cast(float, a[j].x & 0xffff0000u) * rs * ga.y);
        o.y = pk2(__builtin_bit_cast(float, a[j].y << 16) * rs * ga.z, __builtin_bit_cast(float, a[j].y & 0xffff0000u) * rs * ga.w);
        o.z = pk2(__builtin_bit_cast(float, a[j].z << 16) * rs * gb.x, __builtin_bit_cast(float, a[j].z & 0xffff0000u) * rs * gb.y);
        o.w = pk2(__builtin_bit_cast(float, a[j].w << 16) * rs * gb.z, __builtin_bit_cast(float, a[j].w & 0xffff0000u) * rs * gb.w);
        ((v4u*)orow)[c] = o; }
}
constexpr int RT_PC = 0, RT_PG = RT_PC + 8 * 16 * 64 * 4, RT_PSS = RT_PG + 8 * 16 * 64 * 4, RT_LG = RT_PSS + 8 * 64 * 4, RT_SS = RT_LG + 32 * 40 * 4, RT_HIST = RT_SS + 128, RT_BASE = RT_HIST + 128, RT_END = RT_BASE + 128;
static_assert(RT_END <= LDSCTL_OFF, "router LDS");
__device__ __forceinline__ void router_block(Frame& F, int blk, const bf16* __restrict__ H, const bf16* __restrict__ RW, const float* __restrict__ nf, const float* __restrict__ rgb,
                                             const float* __restrict__ reb, bf16* __restrict__ VN, int* __restrict__ cnt, int* __restrict__ list,
                                             int* __restrict__ asg_e, int* __restrict__ asg_pos, float* __restrict__ gate) {
    LAS unsigned char* L = F.lds + RING_OFF;
    const int tid = F.tid, lane = F.lane, w = F.wave, r = lane & 31, hh = lane >> 5;
    const int m0 = blk * 32;
    LAS float* Pc = (LAS float*)(L + RT_PC); LAS float* Pg = (LAS float*)(L + RT_PG); LAS float* Pss = (LAS float*)(L + RT_PSS); LAS float* Lg = (LAS float*)(L + RT_LG); LAS float* Ssq = (LAS float*)(L + RT_SS);
    LAS int* hist = (LAS int*)(L + RT_HIST); LAS int* base = (LAS int*)(L + RT_BASE);
    if (tid < 32) hist[tid] = 0;
    f32x16 acce = zero16(), accg = zero16(); float ss = 0.f;
    const bf16* arow = H + (size_t)(m0 + r) * D + 256 * w + 8 * hh;
    const bf16* bhi = RW + (size_t)r * D + 256 * w + 8 * hh; const bf16* blo = bhi + 64 * D;
#pragma unroll 4
    for (int s2 = 0; s2 < 16; ++s2) {
        const bf16x8_t av = *(const bf16x8_t*)(arow + 16 * s2);
        const bf16x8_t b0 = *(const bf16x8_t*)(bhi + 16 * s2), b1 = *(const bf16x8_t*)(blo + 16 * s2);
        bf16x8_t b2 = (bf16x8_t){0, 0, 0, 0, 0, 0, 0, 0}, b3 = b2;
        if (r < NG) { b2 = *(const bf16x8_t*)(bhi + 32 * D + 16 * s2); b3 = *(const bf16x8_t*)(blo + 32 * D + 16 * s2); }
#pragma unroll
        for (int j = 0; j < 8; ++j) { const float x = __builtin_bit_cast(float, (unsigned)(unsigned short)av[j] << 16); ss += x * x; }
        acce = __builtin_amdgcn_mfma_f32_32x32x16_bf16(av, b0, acce, 0, 0, 0); acce = __builtin_amdgcn_mfma_f32_32x32x16_bf16(av, b1, acce, 0, 0, 0);
        accg = __builtin_amdgcn_mfma_f32_32x32x16_bf16(av, b2, accg, 0, 0, 0); accg = __builtin_amdgcn_mfma_f32_32x32x16_bf16(av, b3, accg, 0, 0, 0);
    }
#pragma unroll
    for (int reg = 0; reg < 16; ++reg) { Pc[(w * 16 + reg) * 64 + lane] = acce[reg]; Pg[(w * 16 + reg) * 64 + lane] = accg[reg]; }
    Pss[w * 64 + lane] = ss;
    v4u hr0[4], hr1[4], hr2[4], hr3[4];
#pragma unroll
    for (int j = 0; j < 4; ++j) { hr0[j] = ((const v4u*)(H + (size_t)(m0 + 4 * w + 0) * D))[lane + 64 * j]; hr1[j] = ((const v4u*)(H + (size_t)(m0 + 4 * w + 1) * D))[lane + 64 * j];
                                  hr2[j] = ((const v4u*)(H + (size_t)(m0 + 4 * w + 2) * D))[lane + 64 * j]; hr3[j] = ((const v4u*)(H + (size_t)(m0 + 4 * w + 3) * D))[lane + 64 * j]; }
    __syncthreads();
#pragma unroll
    for (int i = 0; i < 2; ++i) {
        const int slot = tid + 512 * i, reg = slot >> 6, ln = slot & 63;
        float sum = 0.f;
#pragma unroll
        for (int ww = 0; ww < 8; ++ww) sum += Pc[(ww * 16 + reg) * 64 + ln];
        Lg[CROW(reg, ln) * 40 + NG + (ln & 31)] = sum;
    }
    if (tid < 128) {
        const int t = tid & 31, c = tid >> 5, ln = c + 32 * ((t >> 2) & 1), reg = (t & 3) + 4 * (t >> 3); float sum = 0.f;
#pragma unroll
        for (int ww = 0; ww < 8; ++ww) sum += Pg[(ww * 16 + reg) * 64 + ln];
        Lg[t * 40 + c] = sum;
    } else if (tid < 160) {
        const int t = tid - 128; float sum = 0.f;
#pragma unroll
        for (int ww = 0; ww < 8; ++ww) sum += Pss[ww * 64 + t] + Pss[ww * 64 + 32 + t];
        Ssq[t] = sum;
    }
    __syncthreads();
    int ea = 0, eb = 0, pa = 0, pb = 0;
    if (tid < 32) {
        const int m = m0 + tid;
        const float rs = rsqrtf(Ssq[tid] * (1.0f / D) + 1e-6f);
        float lg[NG + NE];
#pragma unroll
        for (int i = 0; i < NG + NE; ++i) lg[i] = Lg[tid * 40 + i] * rs + (i < NG ? rgb[i] : reb[i - NG]);
        int grp = 0; float gm = lg[0];
#pragma unroll
        for (int j = 1; j < NG; ++j) if (lg[j] > gm) { gm = lg[j]; grp = j; }
        float den = 0.f;
#pragma unroll
        for (int j = 0; j < NG; ++j) den += expf(lg[j] - gm);
        const float pg = 1.0f / den;
        int i1 = 0, i2 = 0; float v1 = 0.f, v2 = 0.f;
#pragma unroll
        for (int g = 0; g < NG; ++g) {
            int a1 = 0; float w1 = lg[NG + g * EPG];
#pragma unroll
            for (int j = 1; j < EPG; ++j) if (lg[NG + g * EPG + j] > w1) { w1 = lg[NG + g * EPG + j]; a1 = j; }
            int a2 = 0; float w2 = -3.0e38f;
#pragma unroll
            for (int j = 0; j < EPG; ++j) if (j != a1 && lg[NG + g * EPG + j] > w2) { w2 = lg[NG + g * EPG + j]; a2 = j; }
            if (g == 0 || grp == g) { i1 = a1; i2 = a2; v1 = w1; v2 = w2; }
        }
        const float e2 = expf(v2 - v1);
        ea = grp * EPG + i1; eb = grp * EPG + i2;
        gate[2 * m] = pg / (1.0f + e2); gate[2 * m + 1] = pg * e2 / (1.0f + e2);
        pa = atomicAdd((int*)&hist[ea], 1); pb = atomicAdd((int*)&hist[eb], 1);
    }
    __syncthreads();
    if (tid < 32) { const int c = hist[tid]; base[tid] = c > 0 ? atomicAdd(&cnt[tid], c) : 0; }
    __syncthreads();
    if (tid < 32) {
        const int m = m0 + tid; pa += base[ea]; pb += base[eb];
        list[(size_t)ea * NT + pa] = m; asg_e[2 * m] = ea; asg_pos[2 * m] = pa;
        list[(size_t)eb * NT + pb] = m; asg_e[2 * m + 1] = eb; asg_pos[2 * m + 1] = pb;
    }
    rms_raw16_to_bf16(hr0, nf, VN + (size_t)(m0 + 4 * w + 0) * D, lane); rms_raw16_to_bf16(hr1, nf, VN + (size_t)(m0 + 4 * w + 1) * D, lane);
    rms_raw16_to_bf16(hr2, nf, VN + (size_t)(m0 + 4 * w + 2) * D, lane); rms_raw16_to_bf16(hr3, nf, VN + (size_t)(m0 + 4 * w + 3) * D, lane);
    __syncthreads();
}


struct Args { const float* in[28]; float* out; unsigned char* ws; int ph_lo, ph_hi; };

constexpr size_t FW_CTL = 0, CTL_ZERO_BYTES = 64 * 1024, FW_LIST = 1, FW_ASG = 2, FW_WOUT = 3;
constexpr size_t FW_WGU = 11, FW_WD = 139, FW_WINT = 364, FW_U16 = 386, FW_PROJ = 203, FW_SS = 203, FW_GLU = 259, FW_BONUS = 259, FW_LOUT = 275, FW_Y2 = 203;
constexpr size_t FW_LORAT = 323, FW_LIN = 326, FW_MIXED = 332, FW_QH = 364, FW_Y0 = 396, FW_H = 364, FW_MC = 428, FW_VN16 = 428, FW_NC = 460, FW_HID = 460, FW_G16 = 492, FW_END = 508;
static_assert(FW_WGU + 128 <= FW_WD && FW_WD + 64 <= FW_PROJ && FW_U16 + 32 <= FW_MC && FW_PROJ + 56 <= FW_GLU && FW_GLU + 16 <= FW_LOUT && FW_LOUT + 48 <= FW_LORAT && FW_Y2 + 96 <= FW_LORAT && FW_LIN + 6 <= FW_MIXED && FW_HID + 24 <= FW_G16, "d_ws map");
constexpr int CW_CNT = 8192, CW_CVQ = 8320, CW_CVQ2 = 8320 + 8 * 64;
constexpr int TP_OFF = MISC_OFF + 128;
constexpr int NPH = 12;
#ifndef DUPMASK
#define DUPMASK 0
#endif
#define NREP(k) (1 + ((DUPMASK >> (k)) & 1))

__global__ void __launch_bounds__(NTHR, 2) mk_fwd(Args args) {
    extern __shared__ __attribute__((aligned(16))) unsigned char lds_raw[];
    Frame F;
    F.lds = (LAS unsigned char*)lds_raw;
    F.MISC = (volatile LAS unsigned*)(F.lds + MISC_OFF);
    F.wave = __builtin_amdgcn_readfirstlane(threadIdx.x >> 6); F.lane = lane_id_fresh(); F.tid = F.wave * 64 + F.lane;
#define REFRESH() do { F.lane = lane_id_fresh(); F.tid = F.wave * 64 + F.lane; } while (0)
    F.G = gridDim.x; { const int bx = blockIdx.x; F.vcu = (F.G % 8 == 0) ? (bx % 8) * (F.G / 8) + bx / 8 : bx; }
    unsigned char* ws = args.ws;
    F.ctl = (unsigned*)(ws + FW_CTL * MiB);
    for (int u = F.tid; u < (LDS_BYTES - LDSCTL_OFF) / 4; u += NTHR) ((LAS unsigned*)(F.lds + LDSCTL_OFF))[u] = 0u;
    __syncthreads();
    XcdBarrier bar = xcd_barrier_post(F.ctl + CW_BAR, F.MISC + 8);
    const int lo = args.ph_lo, hi = args.ph_hi;
#define IN(k) (lo <= (k) && (k) < hi)
#define BOTH(k) (IN(k) && IN((k) + 1))
    const int gw = F.vcu * NWAVES + F.wave, NGW = F.G * NWAVES;
    bf16* P16 = (bf16*)(ws + FW_PROJ * MiB); bf16* GLUb = (bf16*)(ws + FW_GLU * MiB);
    bf16* WguT = (bf16*)(ws + FW_WGU * MiB); bf16* WdT = (bf16*)(ws + FW_WD * MiB); bf16* WoutT = (bf16*)(ws + FW_WOUT * MiB); bf16* LoraT = (bf16*)(ws + FW_LORAT * MiB);
    bf16* LIN = (bf16*)(ws + FW_LIN * MiB); bf16* WinT = (bf16*)(ws + FW_WINT * MiB); bf16* U16 = (bf16*)(ws + FW_U16 * MiB);
    bf16* BONUS = (bf16*)(ws + FW_BONUS * MiB); bf16* G16 = (bf16*)(ws + FW_G16 * MiB); bf16* Y2 = (bf16*)(ws + FW_Y2 * MiB);
    bf16* MIXED16 = (bf16*)(ws + FW_MIXED * MiB); bf16* LOUT = (bf16*)(ws + FW_LOUT * MiB); bf16* SSp = (bf16*)(ws + FW_SS * MiB);
    bf16* QHp = (bf16*)(ws + FW_QH * MiB); bf16* Y0p = (bf16*)(ws + FW_Y0 * MiB); bf16* Hh = (bf16*)(ws + FW_H * MiB);
    bf16* Mcp = (bf16*)(ws + FW_MC * MiB); bf16* VN16 = (bf16*)(ws + FW_VN16 * MiB); bf16* Ncp = (bf16*)(ws + FW_NC * MiB); bf16* HID = (bf16*)(ws + FW_HID * MiB);
    int* list = (int*)(ws + FW_LIST * MiB); int* asg_e = (int*)(ws + FW_ASG * MiB); int* asg_pos = asg_e + 2 * NT; float* gate = (float*)(asg_pos + 2 * NT);
    int* cnt = (int*)(F.ctl + CW_CNT);
    bf16* RWp = (bf16*)(ws + FW_ASG * MiB + 512 * 1024);
    LAS int* tp = (LAS int*)(F.lds + TP_OFF);
    LAS float* scr = (LAS float*)(F.lds + RING_OFF + F.wave * 16384);

    if (IN(0)) for (int rep = 0; rep < NREP(0); ++rep) {
        if (rep) xcd_barrier(bar);
        REFRESH();
        constexpr int I_IN = (D / 64) * (DIN / 32), I_O = (D / 64) * (D / 32);
        for (int it = gw; it < I_IN + I_O; it += NGW) {
            if (it < I_IN) transpose_item(args.in[2], D, DIN, WinT, D, RowVG{}, scr, it, F.lane);
            else transpose_item(args.in[18], D, D, WoutT, D, RowId{0}, scr, it - I_IN, F.lane);
        }
        { v4u z; z.x = 0u; z.y = 0u; z.z = 0u; z.w = 0u; v4u* p = (v4u*)(WinT + (size_t)DIN * D);
          const int nz = (DINP - DIN) * D / 8;
          for (int i = blockIdx.x * NTHR + F.tid; i < nz; i += F.G * NTHR) p[i] = z; }
        for (int i = blockIdx.x * NTHR + F.tid; i < 3072 * 48; i += F.G * NTHR) {
            const int n = i % 3072, j0 = (i / 3072) * 8;
            const int blk = n >> 10, nn = n & 1023;
            float v[8];
#pragma unroll
            for (int q = 0; q < 8; ++q) { const int j = j0 + q; float x = 0.f;
                if (blk == 0) { if (j < 64) x = args.in[9][(size_t)j * DR + nn]; }
                else if (blk == 1) { if (j >= 64 && j < 128) x = args.in[11][(size_t)(j - 64) * DR + nn]; }
                else { if (j >= 128 && j < 288) x = args.in[12][(size_t)(j - 128) * DR + nn]; }
                v[q] = x; }
            v4u o; o.x = pk2(v[0], v[1]); o.y = pk2(v[2], v[3]); o.z = pk2(v[4], v[5]); o.w = pk2(v[6], v[7]);
            *(v4u*)(LoraT + (size_t)n * 384 + j0) = o;
        }
        for (int i = blockIdx.x * NTHR + F.tid; i < 64 * (D / 8); i += F.G * NTHR) {
            const int row = i / (D / 8), k0 = (i % (D / 8)) * 8;
            unsigned hi[4], lo[4];
#pragma unroll
            for (int q = 0; q < 4; ++q) { float x[2];
#pragma unroll
                for (int e = 0; e < 2; ++e) { const int k = k0 + 2 * q + e; x[e] = (row < 32) ? args.in[19][k] * args.in[22][(size_t)k * NE + row] : (row < 36) ? args.in[19][k] * args.in[20][(size_t)k * NG + row - 32] : 0.f; }
                const unsigned h2 = pk2(x[0], x[1]); hi[q] = h2;
                lo[q] = pk2(x[0] - __builtin_bit_cast(float, h2 << 16), x[1] - __builtin_bit_cast(float, h2 & 0xffff0000u)); }
            *(v4u*)(RWp + (size_t)row * D + k0) = (v4u){hi[0], hi[1], hi[2], hi[3]}; *(v4u*)(RWp + (size_t)(64 + row) * D + k0) = (v4u){lo[0], lo[1], lo[2], lo[3]};
        }
        for (int m = gw; m < NT; m += NGW) rms_row_to_bf16(args.in[0] + (size_t)m * D, args.in[1], U16 + (size_t)m * D, F.lane);
    }
    if (BOTH(0)) xcd_barrier(bar);
    if (IN(1)) for (int rep = 0; rep < NREP(1); ++rep) {
        if (rep) xcd_barrier(bar);
        REFRESH();
        pg8::Gemm g{U16, WinT, NT, DINP, D}; pg8::StaticOrder S; S.init(NT, DINP, F.G, (int)blockIdx.x);
        pg8::EpiProj E{GLUb, P16};
        pg8::gemm_phase<pg8::EpiProj, pg8::StaticOrder>(F.lds + RING_OFF, g, S, E, nullptr, F.wave);
        { const int nwg = (NT / 256) * (DINP / 256), rounds = (nwg + (int)F.G - 1) / (int)F.G;
          if (rep == 0 && (int)blockIdx.x + (rounds - 1) * (int)F.G >= nwg) { const CvIn C{args.in, WguT, WdT}; cv_queue_run(C, F.ctl + CW_CVQ, 0, 2 * NE * 256, (LAS float*)(F.lds + RING_OFF + F.wave * CV_SCR), lane_id_fresh(), 8); } }
    }
    if (BOTH(1)) xcd_barrier(bar);
    if (IN(2)) for (int rep = 0; rep < NREP(2); ++rep) {
        if (rep) xcd_barrier(bar);
        REFRESH();
        for (int g = (int)blockIdx.x * NTHR + F.tid; g < NT * 48; g += 3 * (int)F.G * NTHR) lora_in_flat3(P16, args.in[7], LIN, g, (int)F.G * NTHR);
        for (int u = F.vcu; u < NT / CV_TT; u += F.G) conv_unit(F, u, GLUb, args.in[3], args.in[4], args.in[5], args.in[6], MIXED16);
    }
    if (BOTH(2)) xcd_barrier(bar);
    if (IN(3)) for (int rep = 0; rep < NREP(3); ++rep) {
        if (rep) xcd_barrier(bar);
        REFRESH();
        pg8::Gemm g{LIN, LoraT + (size_t)2048 * 384, NT, 1024, 384}; pg8::LoraOrder S; S.init(NT, 1024, F.G, (int)blockIdx.x);
        pg8::EpiBf16<0> E{LOUT, 1024, nullptr, 0, 0};
        pg8::gemm_phase<pg8::EpiBf16<0>, pg8::LoraOrder>(F.lds + RING_OFF, g, S, E, nullptr, F.wave);
        { const int nwg = (NT / 256) * (1024 / 256), rounds = (nwg + (int)F.G - 1) / (int)F.G;
          if (rep == 0 && (int)blockIdx.x + (rounds - 1) * (int)F.G >= nwg) { const CvIn C{args.in, WguT, WdT}; cv_queue_run(C, F.ctl + CW_CVQ, 0, 2 * NE * 256, (LAS float*)(F.lds + RING_OFF + F.wave * CV_SCR), lane_id_fresh(), 2); } }
    }
    if (BOTH(3)) xcd_barrier(bar);
    if (IN(4)) for (int rep = 0; rep < NREP(4); ++rep) {
        if (rep) xcd_barrier(bar);
        REFRESH();
        const PrepIn P{P16, LIN, LoraT, args.in[7], args.in[8], args.in[10], args.in[13], args.in[14], args.in[15], BONUS, G16};
        const int upw = (NUNITS + (int)F.G - 1) / (int)F.G + 1, nsx = (NUNITS + upw - 1) / upw;
        if ((int)blockIdx.x < nsx) scan_x_phase<0>(F, P, QHp, Y0p, Mcp, Ncp, nsx);
        else { const CvIn C{args.in, WguT, WdT}; cv_queue_run(C, F.ctl + CW_CVQ, 0, 2 * NE * 256, (LAS float*)(F.lds + RING_OFF + F.wave * CV_SCR), lane_id_fresh(), 20); }
#ifdef XMODE
        xcd_barrier(bar); scan_x_phase<XMODE>(F, P, QHp, Y0p, Mcp, Ncp, (int)F.G);
#endif
    }
    if (BOTH(4)) xcd_barrier(bar);
    if (IN(5)) {
        REFRESH();
        for (int rep = 0; rep < NREP(5); ++rep) { if (rep) xcd_barrier(bar);
        if (blockIdx.x < 4 * BATCH * NH) {
            const int bx = (int)blockIdx.x, x = bx & 7, j = bx >> 3;
            scan_y_chain4(F, ((x * 4 + (j >> 2)) << 2) | (j & 3), Mcp, Ncp, SSp); } }
        { const CvIn C{args.in, WguT, WdT}; cv_queue_run(C, F.ctl + CW_CVQ, 0, 2 * NE * 256, (LAS float*)(F.lds + RING_OFF + F.wave * CV_SCR), F.lane); }
        if (BOTH(5)) xcd_barrier(bar);
    }
    if (IN(6)) for (int rep = 0; rep < NREP(6); ++rep) {
        if (rep) xcd_barrier(bar);
        REFRESH();
        const PostIn Z{args.in[16], args.in[17], BONUS, LOUT, MIXED16};
        scan_z_phase(F, QHp, Y0p, SSp, Z);
    }
    if (BOTH(6)) xcd_barrier(bar);
    if (IN(7)) for (int rep = 0; rep < NREP(7); ++rep) {
        if (rep) xcd_barrier(bar);
        REFRESH();
        pg8::Gemm g{MIXED16, WoutT, NT, D, D}; pg8::StaticOrder S; S.init(NT, D, F.G, (int)blockIdx.x);
        pg8::EpiResBf16 E{Hh, D, args.in[0]};
        pg8::gemm_phase<pg8::EpiResBf16, pg8::StaticOrder>(F.lds + RING_OFF, g, S, E, nullptr, F.wave);
    }
    if (BOTH(7)) xcd_barrier(bar);
    if (IN(8)) {
        REFRESH();
        for (int blk = blockIdx.x; blk < NT / 32; blk += F.G)
            router_block(F, blk, Hh, RWp, args.in[19], args.in[21], args.in[23], VN16, cnt, list, asg_e, asg_pos, gate);
        if (BOTH(8)) xcd_barrier(bar);
    }
    if (IN(9) || IN(10) || IN(11)) {
        REFRESH();
        __syncthreads();
        if (F.wave == 0) {
            const int e = F.lane & 31; int c = (cnt[e] + 255) >> 8, inc = c;
#pragma unroll
            for (int d = 1; d < 32; d <<= 1) { const int o = __shfl_up(inc, d, 32); if (e >= d) inc += o; }
            if (F.lane < 32) { tp[e] = inc - c; if (e == 31) tp[NE] = inc; for (int mt = inc - c; mt < inc; ++mt) tp[40 + mt] = e; }
        }
        __syncthreads();
    }
    if (IN(9)) for (int rep = 0; rep < NREP(9); ++rep) {
        if (rep) xcd_barrier(bar);
        REFRESH();
        MoeOrder S{tp, cnt, list, 4, (int)F.G, (int)blockIdx.x, nullptr, 0, (const char*)WguT, (size_t)1024 * D * 2, (size_t)256 * D * 2};
        pg8::EpiSwiGLU E{HID, DE};
        pg8::gemm_phase_g<true, pg8::EpiSwiGLU, MoeOrder>(F.lds + RING_OFF, (const char*)VN16, D, S, E, F.wave);
        if (rep == 0) { const CvIn C{args.in, WguT, WdT}; cv_queue_run(C, F.ctl + CW_CVQ2, 2 * NE * 256, CV_ITEMS, (LAS float*)(F.lds + RING_OFF + F.wave * CV_SCR), lane_id_fresh()); }
    }
    if (BOTH(9)) xcd_barrier(bar);
    if (IN(10)) for (int rep = 0; rep < NREP(10); ++rep) {
        if (rep) xcd_barrier(bar);
        REFRESH();
        MoeOrder S{tp, cnt, list, 8, (int)F.G, (int)blockIdx.x, (const char*)HID, (size_t)256 * DE * 2, (const char*)WdT, (size_t)D * DE * 2, (size_t)256 * DE * 2};
        pg8::EpiBf16<0> E{Y2, D, nullptr, 0, 0};
        pg8::gemm_phase_g<false, pg8::EpiBf16<0>, MoeOrder>(F.lds + RING_OFF, nullptr, DE, S, E, F.wave);
    }
    if (BOTH(10)) xcd_barrier(bar);
    if (IN(11)) for (int rep = 0; rep < NREP(11); ++rep) {
        if (rep) xcd_barrier(bar);
        REFRESH();
        for (int m = gw; m < NT; m += NGW) {
            const int s1 = 256 * tp[asg_e[2 * m]] + asg_pos[2 * m], s2 = 256 * tp[asg_e[2 * m + 1]] + asg_pos[2 * m + 1];
            final_token(Hh + (size_t)m * D, Y2 + (size_t)s1 * D, Y2 + (size_t)s2 * D, gate[2 * m], gate[2 * m + 1], args.in[27], args.out + (size_t)m * D, F.lane);
        }
    }
#undef IN
#undef BOTH
}

extern "C" void kernel_launch(void* const* d_in, const int* in_sizes, int n_in, void* d_out, int out_size, void* d_ws, size_t ws_size, hipStream_t stream) {
    static int grid = 0;
    if (grid == 0) {
        if (n_in != 28 || in_sizes[0] != NT * D || out_size != NT * D || ws_size < FW_END * MiB) {
            fprintf(stderr, "kernel_launch: unexpected shapes (n_in %d, in0 %d, out %d, ws %zu)\n", n_in, n_in > 0 ? in_sizes[0] : -1, out_size, ws_size); grid = -1; return; }
        int dev = 0, cus = 0, per_cu = 0;
        if (hipGetDevice(&dev) != hipSuccess || hipDeviceGetAttribute(&cus, hipDeviceAttributeMultiprocessorCount, dev) != hipSuccess) { grid = -1; return; }
        if (hipFuncSetAttribute((const void*)mk_fwd, hipFuncAttributeMaxDynamicSharedMemorySize, LDS_BYTES) != hipSuccess) { fprintf(stderr, "hipFuncSetAttribute failed\n"); grid = -1; return; }
        if (hipOccupancyMaxActiveBlocksPerMultiprocessor(&per_cu, (const void*)mk_fwd, NTHR, LDS_BYTES) != hipSuccess || per_cu < 1) { fprintf(stderr, "occupancy query: %d\n", per_cu); (void)hipGetLastError(); }
        grid = cus;
    }
    if (grid < 0) return;
    if (hipMemsetAsync((char*)d_ws + FW_CTL * MiB, 0, CTL_ZERO_BYTES, stream) != hipSuccess) return;
    Args a{};
    for (int i = 0; i < 28; ++i) a.in[i] = (const float*)d_in[i];
    a.out = (float*)d_out; a.ws = (unsigned char*)d_ws; a.ph_lo = 0; a.ph_hi = NPH;
#ifdef PROBE_PH
#ifndef PROBE_HI
#define PROBE_HI PROBE_PH
#endif
    a.ph_hi = PROBE_HI + 1;
    hipLaunchKernelGGL(mk_fwd, dim3(grid), dim3(NTHR), LDS_BYTES, stream, a);
    if (hipMemsetAsync((char*)d_ws + FW_CTL * MiB + CW_BAR * 4, 0, XCD_BAR_WORDS * 4, stream) != hipSuccess) return;
    if (hipMemsetAsync((char*)d_ws + FW_CTL * MiB + CW_CVQ * 4, 0, 512, stream) != hipSuccess) return;
    a.ph_lo = PROBE_PH; a.ph_hi = NPH;
#endif
    hipLaunchKernelGGL(mk_fwd, dim3(grid), dim3(NTHR), LDS_BYTES, stream, a);
}
```
